# Optimizing an MI355X kernel written in HIP

```python
import math
import jax, jax.numpy as jnp
from jax import lax
import numpy as np

D_MODEL = 2048
BATCH = 4
SEQ = 2048
DEPTH = 4
DEC_BATCH = 32
DEC_SEQ = 1
PAST_LEN = 16384
PAGE_SIZE = 128

N_A_LAYERS = DEPTH // 2
N_B_LAYERS = DEPTH - N_A_LAYERS
DN_HEAD_DIM = 128
DN_QK_HEADS = D_MODEL // 128
DN_V_HEADS = 2 * DN_QK_HEADS
DN_KEY_DIM = DN_QK_HEADS * DN_HEAD_DIM
DN_VAL_DIM = DN_V_HEADS * DN_HEAD_DIM
DN_CONV_DIM = 2 * DN_KEY_DIM + DN_VAL_DIM
DN_CONV_W = 4
DN_CHUNK = 64
DN_IN_DIM = DN_CONV_DIM + DN_VAL_DIM + 2 * DN_V_HEADS
SWA_HEAD_DIM = 64
SWA_HEADS = D_MODEL // SWA_HEAD_DIM
SWA_KV_HEADS = SWA_HEADS // 8
SWA_GROUP = SWA_HEADS // SWA_KV_HEADS
SWA_Q_DIM = SWA_HEADS * SWA_HEAD_DIM
SWA_KV_DIM = SWA_KV_HEADS * SWA_HEAD_DIM
WINDOW = 128
ATTN_SCALE = SWA_HEAD_DIM ** -0.5
REL_BUCKETS = 32
REL_MAX_DIST = 128
D_FF = -(-8 * D_MODEL // (3 * 256)) * 256
EPS = 1e-6

kernel_name = 'yoco_gated_deltanet_swa_sink_step'


def rms_norm(x, g):
    x32 = x.astype(jnp.float32)
    y = x32 * lax.rsqrt(jnp.mean(x32 * x32, axis=-1, keepdims=True) + EPS)
    return (y * g.astype(jnp.float32)).astype(x.dtype)


def l2_normalize(x):
    x32 = x.astype(jnp.float32)
    return x32 * lax.rsqrt(jnp.sum(x32 * x32, axis=-1, keepdims=True) + EPS)


def swiglu_ffn(h, w_gate_up, w_down):
    gate, up = jnp.split(h @ w_gate_up, 2, axis=-1)
    return (jax.nn.silu(gate) * up) @ w_down


def gated_delta_chunked(q, k, v, g, beta):
    B, L, H, dk = q.shape
    dv = v.shape[-1]
    C = DN_CHUNK
    N = L // C
    def to_chunks(t):
        return jnp.moveaxis(t.reshape((B, N, C, H) + t.shape[3:]), 3, 1)
    q, k, v, g, beta = (to_chunks(t) for t in (q, k, v, g, beta))
    gc = jnp.cumsum(g, axis=-1)
    idx = jnp.arange(C)
    incl = idx[:, None] >= idx[None, :]
    strict = idx[:, None] > idx[None, :]
    diff = gc[..., :, None] - gc[..., None, :]
    decay = jnp.where(incl, jnp.exp(jnp.where(incl, diff, 0.0)), 0.0)
    kb = k * beta[..., None]
    a_mat = jnp.where(strict, jnp.einsum('bhnid,bhnjd->bhnij', kb, k) * decay, 0.0)
    eye = jnp.eye(C, dtype=jnp.float32)
    t_mat = lax.linalg.triangular_solve(a_mat + eye, jnp.broadcast_to(eye, a_mat.shape),
                                        left_side=True, lower=True)
    u = t_mat @ (v * beta[..., None])
    w = t_mat @ (kb * jnp.exp(gc)[..., None])
    intra = jnp.einsum('bhnid,bhnjd->bhnij', q, k) * decay
    g_last = gc[..., -1]
    q_dec = q * jnp.exp(gc)[..., None]
    k_dec = k * jnp.exp(g_last[..., None] - gc)[..., None]

    def chunk_step(S, xs):
        u_n, w_n, q_n, intra_n, k_n, gl_n = xs
        v_new = u_n - w_n @ S
        o_n = q_n @ S + intra_n @ v_new
        S = S * jnp.exp(gl_n)[..., None, None] + jnp.einsum('bhcd,bhce->bhde', k_n, v_new)
        return S, o_n

    xs = tuple(jnp.moveaxis(t, 2, 0) for t in (u, w, q_dec, intra, k_dec, g_last))
    S0 = jnp.zeros((B, H, dk, dv), jnp.float32)
    S, o = lax.scan(chunk_step, S0, xs)
    o = jnp.moveaxis(o, 0, 2).reshape(B, H, L, dv).transpose(0, 2, 1, 3)
    return o, S


def gated_delta_recurrent(q, k, v, g, beta, S0):
    def token_step(S, xs):
        q_t, k_t, v_t, g_t, b_t = xs
        S = S * jnp.exp(g_t)[..., None, None]
        kv_mem = jnp.einsum('bhde,bhd->bhe', S, k_t)
        S = S + jnp.einsum('bhd,bhe->bhde', k_t, (v_t - kv_mem) * b_t[..., None])
        return S, jnp.einsum('bhde,bhd->bhe', S, q_t)
    xs = tuple(jnp.moveaxis(t, 1, 0) for t in (q, k, v, g, beta))
    S, o = lax.scan(token_step, S0, xs)
    return jnp.moveaxis(o, 0, 1), S


def deltanet_mixer(h, conv_prev, S0, w_in, conv_w, a_log, dt_bias, gnorm, w_out):
    B, L, _ = h.shape
    proj = h @ w_in
    o1 = DN_CONV_DIM
    o2 = o1 + DN_VAL_DIM
    o3 = o2 + DN_V_HEADS
    qkv_raw, z, b_raw, a_raw = proj[..., :o1], proj[..., o1:o2], proj[..., o2:o3], proj[..., o3:]
    if conv_prev is None:
        prev = jnp.zeros((B, DN_CONV_W - 1, DN_CONV_DIM), qkv_raw.dtype)
    else:
        prev = conv_prev.astype(qkv_raw.dtype)
    x_ext = jnp.concatenate([prev, qkv_raw], axis=1)
    conv = x_ext[:, 0:L] * conv_w[0]
    for j in range(1, DN_CONV_W):
        conv = conv + x_ext[:, j:j + L] * conv_w[j]
    qkv = jax.nn.silu(conv)
    rep = DN_V_HEADS // DN_QK_HEADS
    q = qkv[..., :DN_KEY_DIM].reshape(B, L, DN_QK_HEADS, DN_HEAD_DIM)
    k = qkv[..., DN_KEY_DIM:2 * DN_KEY_DIM].reshape(B, L, DN_QK_HEADS, DN_HEAD_DIM)
    v = qkv[..., 2 * DN_KEY_DIM:].reshape(B, L, DN_V_HEADS, DN_HEAD_DIM).astype(jnp.float32)
    q = jnp.repeat(l2_normalize(q) * DN_HEAD_DIM ** -0.5, rep, axis=2)
    k = jnp.repeat(l2_normalize(k), rep, axis=2)
    beta = jax.nn.sigmoid(b_raw.astype(jnp.float32))
    g = -jnp.exp(a_log.astype(jnp.float32)) * jax.nn.softplus(a_raw.astype(jnp.float32) + dt_bias.astype(jnp.float32))
    if S0 is None:
        o, S = gated_delta_chunked(q, k, v, g, beta)
    else:
        o, S = gated_delta_recurrent(q, k, v, g, beta, S0.astype(jnp.float32))
    z = z.reshape(B, L, DN_V_HEADS, DN_HEAD_DIM).astype(jnp.float32)
    o = rms_norm(o, gnorm) * jax.nn.silu(z)
    y = o.astype(h.dtype).reshape(B, L, DN_VAL_DIM) @ w_out
    return y, x_ext[:, -(DN_CONV_W - 1):], S


def t5_bucket(dist):
    d = jnp.maximum(dist, 0)
    max_exact = REL_BUCKETS // 2
    large = max_exact + (jnp.log(jnp.maximum(d, max_exact).astype(jnp.float32) / max_exact)
                         / math.log(REL_MAX_DIST / max_exact)
                         * (REL_BUCKETS - max_exact)).astype(jnp.int32)
    return jnp.where(d < max_exact, d, jnp.minimum(large, REL_BUCKETS - 1))


def sink_attention(q, k, v, dist, valid, rel_bias, sinks):
    s = jnp.einsum('...qkgd,...ckd->...kgqc', q, k, preferred_element_type=jnp.float32) * ATTN_SCALE
    bias = jnp.moveaxis(rel_bias[t5_bucket(dist)], -1, 0).reshape((SWA_KV_HEADS, SWA_GROUP) + dist.shape)
    s = jnp.where(valid, s + bias.astype(jnp.float32), -jnp.inf)
    sink = sinks.astype(jnp.float32).reshape(SWA_KV_HEADS, SWA_GROUP)[:, :, None, None]
    m = jnp.maximum(jnp.max(s, axis=-1, keepdims=True), sink)
    p = jnp.exp(s - m)
    p = p / (jnp.sum(p, axis=-1, keepdims=True) + jnp.exp(sink - m))
    return jnp.einsum('...kgqc,...ckd->...qkgd', p.astype(v.dtype), v)


def swa_prompt(q, k, v, rel_bias, sinks):
    B, L = q.shape[:2]
    nb = L // WINDOW
    qb = q.reshape(B, nb, WINDOW, SWA_KV_HEADS, SWA_GROUP, SWA_HEAD_DIM)
    pad = ((0, 0), (WINDOW, 0), (0, 0), (0, 0))
    kp = jnp.pad(k, pad).reshape(B, nb + 1, WINDOW, SWA_KV_HEADS, SWA_HEAD_DIM)
    vp = jnp.pad(v, pad).reshape(B, nb + 1, WINDOW, SWA_KV_HEADS, SWA_HEAD_DIM)
    kb = jnp.concatenate([kp[:, :-1], kp[:, 1:]], axis=2)
    vb = jnp.concatenate([vp[:, :-1], vp[:, 1:]], axis=2)
    qi = jnp.arange(WINDOW)[:, None]
    ci = jnp.arange(2 * WINDOW)[None, :]
    dist = qi + WINDOW - ci
    key_pos = jnp.arange(nb)[:, None, None] * WINDOW - WINDOW + ci
    valid = (dist >= 0) & (dist < WINDOW) & (key_pos >= 0)
    o = sink_attention(qb, kb, vb, dist, valid[:, None, None], rel_bias, sinks)
    return o.reshape(B, L, SWA_Q_DIM)


def swa_sample(q, k_all, v_all, rel_bias, sinks):
    B, T = q.shape[:2]
    Tk = k_all.shape[1]
    qi = jnp.arange(T)[:, None]
    ci = jnp.arange(Tk)[None, :]
    dist = qi + (Tk - T) - ci
    valid = (dist >= 0) & (dist < WINDOW)
    o = sink_attention(q, k_all, v_all, dist, valid, rel_bias, sinks)
    return o.reshape(B, T, SWA_Q_DIM)


def trunk(x, prompt, state_delta, state_conv, cache_k_win, cache_v_win,
          norm_mix, norm_ffn, w_in_a, conv_w_a, a_log, dt_bias, gnorm_a, w_out_a,
          norm_kv, w_kv, w_q_b, w_o_b, sinks, rel_bias, w_gate_up, w_down, norm_final):
    B, L, _ = x.shape
    new_delta, new_conv = [], []
    for i in range(N_A_LAYERS):
        h = rms_norm(x, norm_mix[i])
        y, conv_buf, S = deltanet_mixer(h, None if prompt else state_conv[i],
                                        None if prompt else state_delta[i],
                                        w_in_a[i], conv_w_a[i], a_log[i], dt_bias[i],
                                        gnorm_a[i], w_out_a[i])
        x = x + y
        x = x + swiglu_ffn(rms_norm(x, norm_ffn[i]), w_gate_up[i], w_down[i])
        new_delta.append(S)
        new_conv.append(conv_buf)
    kv = rms_norm(x, norm_kv) @ w_kv
    k_new = kv[..., :SWA_KV_DIM].reshape(B, L, SWA_KV_HEADS, SWA_HEAD_DIM)
    v_new = kv[..., SWA_KV_DIM:].reshape(B, L, SWA_KV_HEADS, SWA_HEAD_DIM)
    if prompt:
        k_all, v_all = k_new, v_new
    else:
        k_all = jnp.concatenate([cache_k_win.astype(k_new.dtype), k_new], axis=1)
        v_all = jnp.concatenate([cache_v_win.astype(v_new.dtype), v_new], axis=1)
    for j in range(N_B_LAYERS):
        i = N_A_LAYERS + j
        h = rms_norm(x, norm_mix[i])
        q = (h @ w_q_b[j]).reshape(B, L, SWA_KV_HEADS, SWA_GROUP, SWA_HEAD_DIM)
        if prompt:
            o = swa_prompt(q, k_all, v_all, rel_bias, sinks[j])
        else:
            o = swa_sample(q, k_all, v_all, rel_bias, sinks[j])
        x = x + o @ w_o_b[j]
        x = x + swiglu_ffn(rms_norm(x, norm_ffn[i]), w_gate_up[i], w_down[i])
    y = rms_norm(x, norm_final)
    return y, jnp.stack(new_delta), jnp.stack(new_conv), k_all[:, -WINDOW:], v_all[:, -WINDOW:]


def setup_inputs(seed: int = 0) -> dict:
    key = jax.random.key(seed)
    ks = jax.random.split(key, 24)
    def nrm(k, shape, scale):
        return jax.random.normal(k, shape, jnp.float32) * scale
    D = D_MODEL
    dt = jnp.exp(jax.random.uniform(ks[11], (N_A_LAYERS, DN_V_HEADS), jnp.float32,
                                    minval=math.log(1e-3), maxval=math.log(1e-1)))
    return {
        'x_prompt': nrm(ks[0], (BATCH, SEQ, D), 1.0),
        'x_sample': nrm(ks[1], (DEC_BATCH, DEC_SEQ, D), 1.0),
        'state_delta': nrm(ks[2], (N_A_LAYERS, DEC_BATCH, DN_V_HEADS, DN_HEAD_DIM, DN_HEAD_DIM), 0.05),
        'state_conv': nrm(ks[3], (N_A_LAYERS, DEC_BATCH, DN_CONV_W - 1, DN_CONV_DIM), 1.0),
        'cache_k_win': nrm(ks[4], (DEC_BATCH, WINDOW, SWA_KV_HEADS, SWA_HEAD_DIM), 1.0),
        'cache_v_win': nrm(ks[5], (DEC_BATCH, WINDOW, SWA_KV_HEADS, SWA_HEAD_DIM), 1.0),
        'norm_mix': 1.0 + nrm(ks[6], (DEPTH, D), 0.05),
        'norm_ffn': 1.0 + nrm(ks[7], (DEPTH, D), 0.05),
        'w_in_a': nrm(ks[8], (N_A_LAYERS, D, DN_IN_DIM), D ** -0.5),
        'conv_w_a': nrm(ks[9], (N_A_LAYERS, DN_CONV_W, DN_CONV_DIM), DN_CONV_W ** -0.5),
        'a_log': jnp.log(jax.random.uniform(ks[10], (N_A_LAYERS, DN_V_HEADS), jnp.float32, minval=1.0, maxval=16.0)),
        'dt_bias': dt + jnp.log(-jnp.expm1(-dt)),
        'gnorm_a': 1.0 + nrm(ks[12], (N_A_LAYERS, DN_HEAD_DIM), 0.05),
        'w_out_a': nrm(ks[13], (N_A_LAYERS, DN_VAL_DIM, D), DN_VAL_DIM ** -0.5),
        'norm_kv': 1.0 + nrm(ks[14], (D,), 0.05),
        'w_kv': nrm(ks[15], (D, 2 * SWA_KV_DIM), D ** -0.5),
        'w_q_b': nrm(ks[16], (N_B_LAYERS, D, SWA_Q_DIM), D ** -0.5),
        'w_o_b': nrm(ks[17], (N_B_LAYERS, SWA_Q_DIM, D), SWA_Q_DIM ** -0.5),
        'sinks': nrm(ks[18], (N_B_LAYERS, SWA_HEADS), 0.5),
        'rel_bias': nrm(ks[19], (REL_BUCKETS, SWA_HEADS), 0.5),
        'w_gate_up': nrm(ks[20], (DEPTH, D, 2 * D_FF), D ** -0.5),
        'w_down': nrm(ks[21], (DEPTH, D_FF, D), D_FF ** -0.5),
        'norm_final': 1.0 + nrm(ks[22], (D,), 0.05),
    }


def reference(x_prompt, x_sample, state_delta, state_conv, cache_k_win, cache_v_win,
              norm_mix, norm_ffn, w_in_a, conv_w_a, a_log, dt_bias, gnorm_a, w_out_a,
              norm_kv, w_kv, w_q_b, w_o_b, sinks, rel_bias, w_gate_up, w_down, norm_final):
    y_prompt, delta_p, conv_p, k_win_p, v_win_p = trunk(
        x_prompt, True, None, None, None, None,
        norm_mix, norm_ffn, w_in_a, conv_w_a, a_log, dt_bias, gnorm_a, w_out_a,
        norm_kv, w_kv, w_q_b, w_o_b, sinks, rel_bias, w_gate_up, w_down, norm_final)
    y_sample, delta_s, conv_s, k_win_s, v_win_s = trunk(
        x_sample, False, state_delta, state_conv, cache_k_win, cache_v_win,
        norm_mix, norm_ffn, w_in_a, conv_w_a, a_log, dt_bias, gnorm_a, w_out_a,
        norm_kv, w_kv, w_q_b, w_o_b, sinks, rel_bias, w_gate_up, w_down, norm_final)
    return (y_prompt, y_sample, delta_p, conv_p, k_win_p, v_win_p, delta_s, conv_s, k_win_s, v_win_s)
```

```cpp
#include <hip/hip_runtime.h>
#include <cstdio>
#include <cstdint>
#include <cmath>
namespace pg8 {
#define PG8_LAS __attribute__((address_space(3)))
typedef unsigned short bf16_t;
typedef short bf16x8 __attribute__((ext_vector_type(8)));
typedef float f32x4 __attribute__((ext_vector_type(4)));
typedef unsigned u32x4 __attribute__((ext_vector_type(4)));
constexpr int BM = 256, BK = 64, HALF = 128, HTB = HALF * BK * 2  , STAGE_BYTES = 8 * HTB, NXCD = 8, WGM = 8;

__host__ __device__ __forceinline__ int lds_byte(int r, int c) { const int st = (r >> 4) * 2 + (c >> 5), rr = r & 15, cc = c & 31, ob = rr * 64 + cc * 2; return st * 1024 + (ob ^ (((ob >> 9) & 1) << 5)); }
__host__ __device__ __forceinline__ void stage_rc(int b, int& R, int& C) { const int st = b / 1024, sb = b % 1024, swz = sb ^ (((sb >> 9) & 1) << 5); R = (st >> 1) * 16 + swz / 64; C = (st & 1) * 32 + (swz % 64) / 2; }
__host__ __device__ __forceinline__ int perm32(int rho) { const int n = rho >> 4, i = rho & 15; return 8 * (i >> 2) + 4 * n + (i & 3); }

struct Unit { int pm, pn; };
struct Gemm { const bf16_t* A; const bf16_t* Bt; int M, N, K; };

struct StaticOrder {
    int nM, nN, nwg, G, c;
    __host__ __device__ void init(int M, int N, int G_, int c_) { nM = M / BM; nN = N / BM; nwg = nM * nN; G = G_; c = c_; }
    __host__ __device__ bool next(int i, Unit& u) const {
        const long L = (long)i * G + c; if (L >= nwg) return false;
        int wgid = (int)L; { const int q = nwg / NXCD, r = nwg % NXCD, xcd = wgid % NXCD, off = wgid / NXCD; wgid = (xcd < r ? xcd * (q + 1) : r * (q + 1) + (xcd - r) * q) + off; }
        const int nig = WGM * nN, gid = wgid / nig, fm = gid * WGM, gsz = (nM - fm) < WGM ? (nM - fm) : WGM;
        u.pm = fm + ((wgid % nig) % gsz); u.pn = (wgid % nig) / gsz; return true;
    }
    __device__ __forceinline__ void a_ready(const Unit&) const {}
    __device__ __forceinline__ void done(const Unit&) const {}
};

__device__ __forceinline__ unsigned cvt_pk_bf16(float lo, float hi) { unsigned r; asm volatile("v_cvt_pk_bf16_f32 %0, %1, %2" : "=v"(r) : "v"(lo), "v"(hi)); return r; }
typedef float f32x2 __attribute__((ext_vector_type(2)));
template <class Epi, class Sched, bool ALIGN_EPI = false, bool SP2 = false>
__device__ __forceinline__ void gemm_phase(PG8_LAS unsigned char* lds, const Gemm g, const Sched& S, const Epi& E) {
    int tid = threadIdx.x; asm volatile("" : "+v"(tid));
    const int wid = __builtin_amdgcn_readfirstlane(tid >> 6), lane = tid & 63, wr = wid >> 2, wc = wid & 3, fr = lane & 15, fq = lane >> 4;
    const int K = g.K, nt = K / BK;
    unsigned voffA[2], voffB[2];
#pragma unroll
    for (int i = 0; i < 2; ++i) { int R, C; stage_rc(tid * 16 + i * 8192, R, C); const int Rb = Epi::PERM ? ((R & ~31) + perm32(R & 31)) : R;
        voffA[i] = (unsigned)(R * K + C) * 2u; voffB[i] = (unsigned)(Rb * K + C) * 2u; }
    const size_t kstep = (size_t)(BK * 2);
    const size_t hstep = (size_t)HALF * K * 2;
    const size_t tstep = 2 * hstep;
    const unsigned ldsw = (unsigned)wid * 1024u;
    const int aoff = lds_byte(wr * 64 + fr, fq * 8), boff = lds_byte(wc * 32 + fr, fq * 8);
#define PG8_SA(b, h) (((b) * 2 + (h)) * HTB)
#define PG8_SB(b, h) ((4 + (b) * 2 + (h)) * HTB)
#define PG8_STAGE(bufoff, gbase, voff) do { _Pragma("unroll") for (int _i = 0; _i < 2; ++_i) \
        __builtin_amdgcn_global_load_lds((const unsigned*)((const char*)(gbase) + (voff)[_i]), (PG8_LAS unsigned*)(lds + (bufoff) + ldsw + _i * 8192), 16, 0, 0); } while (0)
#define PG8_LDA(dst, b, h) do { _Pragma("unroll") for (int m = 0; m < 4; ++m) _Pragma("unroll") for (int k = 0; k < 2; ++k) dst[m][k] = *(const PG8_LAS bf16x8*)(lds + PG8_SA(b, h) + aoff + m * 2048 + k * 1024); } while (0)
#define PG8_LDB(dst, b, h) do { _Pragma("unroll") for (int n = 0; n < 2; ++n) _Pragma("unroll") for (int k = 0; k < 2; ++k) dst[n][k] = *(const PG8_LAS bf16x8*)(lds + PG8_SB(b, h) + boff + n * 2048 + k * 1024); } while (0)
#define PG8_MMA(ai, bj, At, Bt) do { __builtin_amdgcn_s_setprio(1); _Pragma("unroll") for (int m = 0; m < 4; ++m) _Pragma("unroll") for (int n = 0; n < 2; ++n) _Pragma("unroll") for (int k = 0; k < 2; ++k) \
        acc[ai][bj][m][n] = __builtin_amdgcn_mfma_f32_16x16x32_bf16(Bt[n][k], At[m][k], acc[ai][bj][m][n], 0, 0, 0); __builtin_amdgcn_s_setprio(0); } while (0)
#define PG8_WAIT_V(n) asm volatile("s_waitcnt vmcnt(" #n ")" ::: "memory")
#define PG8_WAIT_L(n) asm volatile("s_waitcnt lgkmcnt(" #n ")" ::: "memory")
#define PG8_BAR __builtin_amdgcn_s_barrier()
#define PG8_SCHED __builtin_amdgcn_sched_barrier(0)
    Unit cur, nxt; int ui = 0;
    if (!S.next(0, cur)) return;
    f32x4 acc[2][2][4][2];
#pragma unroll
    for (int a = 0; a < 2; ++a)
#pragma unroll
        for (int b = 0; b < 2; ++b)
#pragma unroll
            for (int m = 0; m < 4; ++m)
#pragma unroll
                for (int n = 0; n < 2; ++n) acc[a][b][m][n] = (f32x4){0.f, 0.f, 0.f, 0.f};
    bf16x8 At[4][2], B0[2][2], B1[2][2];
    const char* cA = (const char*)g.A + (size_t)cur.pm * tstep; const char* cB = (const char*)g.Bt + (size_t)cur.pn * tstep;
    S.a_ready(cur);
    if constexpr (SP2) {
        PG8_STAGE(PG8_SB(0, 0), cB, voffB); PG8_STAGE(PG8_SB(0, 1), cB + hstep, voffB); PG8_STAGE(PG8_SA(0, 0), cA, voffA); PG8_STAGE(PG8_SA(0, 1), cA + hstep, voffA);
        if (wr == 1) PG8_BAR;
        PG8_WAIT_V(2); PG8_BAR;
        PG8_STAGE(PG8_SB(1, 0), cB + kstep, voffB); PG8_STAGE(PG8_SA(1, 0), cA + kstep, voffA); PG8_STAGE(PG8_SB(1, 1), cB + hstep + kstep, voffB);
        PG8_WAIT_V(6); PG8_BAR;
    } else {
        PG8_STAGE(PG8_SB(0, 0), cB, voffB); PG8_STAGE(PG8_SA(0, 0), cA, voffA); PG8_STAGE(PG8_SB(0, 1), cB + hstep, voffB); PG8_STAGE(PG8_SA(0, 1), cA + hstep, voffA);
        if (wr == 1) PG8_BAR;
        PG8_WAIT_V(4); PG8_BAR;
        PG8_STAGE(PG8_SB(1, 0), cB + kstep, voffB); PG8_STAGE(PG8_SA(1, 0), cA + kstep, voffA); PG8_STAGE(PG8_SB(1, 1), cB + hstep + kstep, voffB);
        PG8_WAIT_V(6); PG8_BAR;
    }
    for (;;) {
        const bool has_next = S.next(ui + 1, nxt);
        const char* nA = has_next ? (const char*)g.A + (size_t)nxt.pm * tstep : cA; const char* nB = has_next ? (const char*)g.Bt + (size_t)nxt.pn * tstep : cB;
        for (int t = 0; t < nt; t += 2) {
            const bool last = (t == nt - 2);
            const char* a1 = cA + (size_t)(t + 1) * kstep;
            const char* a2 = last ? nA : cA + (size_t)(t + 2) * kstep; const char* b2 = last ? nB : cB + (size_t)(t + 2) * kstep;
            const char* a3 = a2 + kstep; const char* b3 = b2 + kstep;
            if (last && has_next) S.a_ready(nxt);
            if constexpr (SP2) {
            PG8_LDB(B0, 0, 0); PG8_LDB(B1, 0, 1); PG8_SCHED; PG8_LDA(At, 0, 0); PG8_STAGE(PG8_SA(1, 1), a1 + hstep, voffA);
            PG8_WAIT_V(8); PG8_WAIT_L(0); PG8_BAR; PG8_MMA(0, 0, At, B0); PG8_MMA(0, 1, At, B1); PG8_BAR; PG8_SCHED;
            PG8_LDA(At, 0, 1); PG8_STAGE(PG8_SB(0, 0), b2, voffB); PG8_STAGE(PG8_SB(0, 1), b2 + hstep, voffB); PG8_STAGE(PG8_SA(0, 0), a2, voffA);
            PG8_WAIT_V(8); PG8_WAIT_L(0); PG8_BAR; PG8_MMA(1, 0, At, B0); PG8_MMA(1, 1, At, B1); PG8_BAR; PG8_SCHED;
            PG8_LDB(B0, 1, 0); PG8_LDB(B1, 1, 1); PG8_SCHED; PG8_LDA(At, 1, 0); PG8_STAGE(PG8_SA(0, 1), a2 + hstep, voffA);
            PG8_WAIT_V(8); PG8_WAIT_L(0); PG8_BAR; PG8_MMA(0, 0, At, B0); PG8_MMA(0, 1, At, B1); PG8_BAR; PG8_SCHED;
            PG8_LDA(At, 1, 1); PG8_STAGE(PG8_SB(1, 0), b3, voffB); PG8_STAGE(PG8_SB(1, 1), b3 + hstep, voffB); PG8_STAGE(PG8_SA(1, 0), a3, voffA);
            PG8_WAIT_V(8); PG8_WAIT_L(0); PG8_BAR; PG8_MMA(1, 0, At, B0); PG8_MMA(1, 1, At, B1); PG8_BAR; PG8_SCHED;
            } else {
            PG8_LDB(B0, 0, 0); PG8_SCHED; PG8_LDA(At, 0, 0); PG8_STAGE(PG8_SA(1, 1), a1 + hstep, voffA);
            PG8_WAIT_L(8); PG8_BAR; PG8_WAIT_L(0); PG8_MMA(0, 0, At, B0); PG8_BAR; PG8_SCHED;
            PG8_LDB(B1, 0, 1); PG8_STAGE(PG8_SB(0, 0), b2, voffB);
            PG8_BAR; PG8_WAIT_L(0); PG8_MMA(0, 1, At, B1); PG8_BAR;
            PG8_LDA(At, 0, 1); PG8_STAGE(PG8_SA(0, 0), a2, voffA);
            PG8_BAR; PG8_WAIT_L(0); PG8_MMA(1, 0, At, B0); PG8_BAR; PG8_SCHED;
            PG8_STAGE(PG8_SB(0, 1), b2 + hstep, voffB);
            PG8_WAIT_V(6); PG8_BAR; PG8_MMA(1, 1, At, B1); PG8_BAR;
            PG8_LDB(B0, 1, 0); PG8_SCHED; PG8_LDA(At, 1, 0); PG8_STAGE(PG8_SA(0, 1), a2 + hstep, voffA);
            PG8_WAIT_L(8); PG8_BAR; PG8_WAIT_L(0); PG8_MMA(0, 0, At, B0); PG8_BAR; PG8_SCHED;
            PG8_LDB(B1, 1, 1); PG8_STAGE(PG8_SB(1, 0), b3, voffB);
            PG8_BAR; PG8_WAIT_L(0); PG8_MMA(0, 1, At, B1); PG8_BAR;
            PG8_LDA(At, 1, 1); PG8_STAGE(PG8_SA(1, 0), a3, voffA);
            PG8_BAR; PG8_WAIT_L(0); PG8_MMA(1, 0, At, B0); PG8_BAR; PG8_SCHED;
            PG8_STAGE(PG8_SB(1, 1), b3 + hstep, voffB);
            PG8_WAIT_V(6); PG8_BAR; PG8_MMA(1, 1, At, B1); PG8_BAR;
            }
        }
        if constexpr (ALIGN_EPI) { if (wr == 0) PG8_BAR; }
        if constexpr (!Epi::AFTER_DRAIN) { E(acc, cur, wr, wc, fr, fq); S.done(cur); }
        if (!has_next) break;
#pragma unroll
        for (int a = 0; a < 2; ++a)
#pragma unroll
            for (int b = 0; b < 2; ++b)
#pragma unroll
                for (int m = 0; m < 4; ++m)
#pragma unroll
                    for (int n = 0; n < 2; ++n) acc[a][b][m][n] = (f32x4){0.f, 0.f, 0.f, 0.f};
        cur = nxt; cA = nA; cB = nB; ++ui;
        if constexpr (ALIGN_EPI) { if (wr == 1) PG8_BAR; }
    }
    PG8_WAIT_V(0);
    if constexpr (!ALIGN_EPI) { if (wr == 0) PG8_BAR; }
    PG8_BAR;
    if constexpr (Epi::AFTER_DRAIN) { E.fused(acc, cur, wr, wc, fr, fq, lds, wid, lane); S.done(cur); }
#undef PG8_SA
#undef PG8_SB
#undef PG8_STAGE
#undef PG8_LDA
#undef PG8_LDB
#undef PG8_MMA
#undef PG8_WAIT_V
#undef PG8_WAIT_L
#undef PG8_BAR
#undef PG8_SCHED
}
}

constexpr int D = 2048, BATCH = 4, SEQ = 2048, MP = BATCH * SEQ, SB = 32;
constexpr int INW = 12288, INDIM = 12352, CONVD = 8192, VALD = 4096, FF = 5632, GU = 2 * FF;
constexpr int NCH = 32;
constexpr float EPS = 1e-6f;
constexpr float LOG2E = 1.4426950408889634f;
constexpr float QSCALE = 0.125f * LOG2E;
constexpr int NWAVES = 8, NTHR = 512;

constexpr size_t MiB = 1u << 20;
constexpr size_t WS_CTL = 0, CTL_ZERO_BYTES = 4 * MiB;
constexpr size_t WS_WIN = 4 * MiB;
constexpr size_t WS_WBA = 100 * MiB;
constexpr size_t WS_WOUT = 101 * MiB;
constexpr size_t WS_WGU = 133 * MiB;
constexpr size_t WS_WDN = 309 * MiB;
constexpr size_t WS_WQKV = 397 * MiB;
constexpr size_t WS_WQ1 = 407 * MiB;
constexpr size_t WS_WO = 415 * MiB;
constexpr size_t WS_X = 431 * MiB;
constexpr size_t WS_XB = 495 * MiB;
constexpr size_t WS_PROJ = 527 * MiB;
constexpr size_t WS_BETA = 719 * MiB;
constexpr size_t WS_G = 720 * MiB;
constexpr size_t WS_PREPA = 721 * MiB;
constexpr size_t WS_PREPU = 945 * MiB;
constexpr size_t WS_EGL = 1009 * MiB;
constexpr size_t WS_OG = 1010 * MiB;
constexpr size_t WS_MID = 1074 * MiB;
constexpr size_t WS_Q = 1162 * MiB;
constexpr size_t WS_K = 1194 * MiB;
constexpr size_t WS_VT = 1198 * MiB;
constexpr size_t WS_AO = 1202 * MiB;
constexpr size_t WS_SMP = 1234 * MiB;
constexpr size_t WS_SSQP = 1242 * MiB;
constexpr size_t WS_SSQSP = 1251 * MiB;
constexpr size_t WS_END = 1252 * MiB;
constexpr size_t SM_XS = 0;
constexpr size_t SM_XSB = 262144;
constexpr size_t SM_PROJS = 393216;
constexpr size_t SM_QKVS = 2 * MiB;
constexpr size_t SM_BETAS = 3 * MiB;
constexpr size_t SM_GS = 3 * MiB + 4096;
constexpr size_t SM_OGS = 3 * MiB + 8192;
constexpr size_t SM_MIDS = 4 * MiB;
constexpr size_t SM_QS = 5 * MiB;
constexpr size_t SM_KVS = 5 * MiB + 262144;
constexpr size_t SM_AOS = 6 * MiB;
constexpr int CW_BAR = 4096;
constexpr int CW_SSQ = 16384;
constexpr int CW_SSQS = 16384 + 9 * 8192;
constexpr int PREPA_REC = 57344, PREPU_REC = 16384;

constexpr int LDS_BYTES = 147456, MISC_OFF = LDS_BYTES - 256;

#define GAS __attribute__((address_space(1)))
#define LAS __attribute__((address_space(3)))
typedef unsigned short bf16_t;
typedef unsigned u32x4 __attribute__((ext_vector_type(4)));
typedef unsigned u32x2 __attribute__((ext_vector_type(2)));
typedef float f32x4 __attribute__((ext_vector_type(4)));
typedef float f32x16 __attribute__((ext_vector_type(16)));
typedef short bf16x8 __attribute__((ext_vector_type(8)));
typedef short bf16x4 __attribute__((ext_vector_type(4)));
#define LDS_WAIT() asm volatile("s_waitcnt lgkmcnt(0)" ::: "memory")
#define VM_WAIT() asm volatile("s_waitcnt vmcnt(0)" ::: "memory")
#define MFMA16(a, b, c) __builtin_amdgcn_mfma_f32_16x16x32_bf16((a), (b), (c), 0, 0, 0)
#define MFMA32(a, b, c) __builtin_amdgcn_mfma_f32_32x32x16_bf16((a), (b), (c), 0, 0, 0)

__device__ __forceinline__ float bf2f(bf16_t v) { return __uint_as_float((unsigned)v << 16); }
typedef float f32x2_t __attribute__((ext_vector_type(2))); typedef __bf16 bf16x2_t __attribute__((ext_vector_type(2)));
__device__ __forceinline__ unsigned pk2(float lo, float hi) { const f32x2_t v = {lo, hi}; const bf16x2_t b = __builtin_convertvector(v, bf16x2_t); return __builtin_bit_cast(unsigned, b); }
__device__ __forceinline__ bf16_t f2bf(float f) { return (bf16_t)(pk2(f, 0.f) & 0xffffu); }
__device__ __forceinline__ float fast_exp2(float x) { return __builtin_amdgcn_exp2f(x); }
__device__ __forceinline__ float fast_exp(float x) { return __builtin_amdgcn_exp2f(x * LOG2E); }
__device__ __forceinline__ float fast_rcp(float x) { return __builtin_amdgcn_rcpf(x); }
__device__ __forceinline__ float silu_f(float x) { return x * fast_rcp(1.0f + fast_exp(-x)); }
__device__ __forceinline__ float rinv_of(float ssq) { return 1.0f / sqrtf(ssq * (1.0f / D) + EPS); }
__device__ __forceinline__ float wave_sum(float v) {
#pragma unroll
    for (int o = 1; o < 64; o <<= 1) v += __shfl_xor(v, o);
    return v;
}
__device__ __forceinline__ float rinv_row4(const float* ssqp, int row, int fq) {
    const f32x4* p = (const f32x4*)(ssqp + (size_t)row * 32 + 8 * fq); const f32x4 a = p[0], b = p[1];
    float s = ((a[0] + a[1]) + (a[2] + a[3])) + ((b[0] + b[1]) + (b[2] + b[3]));
    s += __shfl_xor(s, 16); s += __shfl_xor(s, 32);
    return rinv_of(s);
}
__device__ __forceinline__ float rinv_row_full(const float* ssqp, int row) {
    const f32x4* p = (const f32x4*)(ssqp + (size_t)row * 32); float s = 0.f;
#pragma unroll
    for (int i = 0; i < 8; ++i) { const f32x4 a = p[i]; s += (a[0] + a[1]) + (a[2] + a[3]); }
    return rinv_of(s);
}
__device__ __forceinline__ int crow32(int r, int hi) { return (r & 3) + 8 * (r >> 2) + 4 * hi; }

namespace pg8 {
struct EpiProj {
    static constexpr bool PERM = true, AFTER_DRAIN = false;
    bf16_t* O; int ldc; const float* ssq;
    __device__ __forceinline__ void operator()(const f32x4 (&acc)[2][2][4][2], const Unit& u, int wr, int wc, int fr, int fq) const {
        asm volatile("" : "+v"(fr), "+v"(fq));
        const int row0 = u.pm * BM + wr * 64 + fr, col0 = u.pn * BM + wc * 32 + 8 * fq;
#pragma unroll
        for (int ai = 0; ai < 2; ++ai)
#pragma unroll
            for (int m = 0; m < 4; ++m) { const int row = row0 + ai * HALF + m * 16; const float ri = rinv_row4(ssq, row, fq); bf16_t* rowp = O + (size_t)row * ldc + col0;
#pragma unroll
                for (int bj = 0; bj < 2; ++bj) { const f32x4 v0 = acc[ai][bj][m][0] * ri, v1 = acc[ai][bj][m][1] * ri;
                    u32x4 w; w.x = cvt_pk_bf16(v0[0], v0[1]); w.y = cvt_pk_bf16(v0[2], v0[3]); w.z = cvt_pk_bf16(v1[0], v1[1]); w.w = cvt_pk_bf16(v1[2], v1[3]);
                    *(u32x4*)(rowp + bj * HALF) = w; } }
    }
};
struct EpiRes {
    static constexpr bool PERM = true, AFTER_DRAIN = false;
    const float* base; float* X; bf16_t* XB; float* ssq;
    __device__ __forceinline__ void operator()(const f32x4 (&acc)[2][2][4][2], const Unit& u, int wr, int wc, int fr, int fq) const {
        asm volatile("" : "+v"(fr), "+v"(fq));
        const int row0 = u.pm * BM + wr * 64 + fr, col0 = u.pn * BM + wc * 32 + 8 * fq;
#pragma unroll
        for (int ai = 0; ai < 2; ++ai)
#pragma unroll
            for (int m = 0; m < 4; ++m) { const int row = row0 + ai * HALF + m * 16; const size_t off = (size_t)row * D + col0; float s = 0.f;
#pragma unroll
                for (int bj = 0; bj < 2; ++bj) { const f32x4 b0 = *(const f32x4*)(base + off + bj * HALF), b1 = *(const f32x4*)(base + off + bj * HALF + 4);
                    const f32x4 v0 = acc[ai][bj][m][0] + b0, v1 = acc[ai][bj][m][1] + b1;
                    *(f32x4*)(X + off + bj * HALF) = v0; *(f32x4*)(X + off + bj * HALF + 4) = v1;
                    u32x4 w; w.x = cvt_pk_bf16(v0[0], v0[1]); w.y = cvt_pk_bf16(v0[2], v0[3]); w.z = cvt_pk_bf16(v1[0], v1[1]); w.w = cvt_pk_bf16(v1[2], v1[3]);
                    *(u32x4*)(XB + off + bj * HALF) = w;
                    s += (v0[0] * v0[0] + v0[1] * v0[1]) + (v0[2] * v0[2] + v0[3] * v0[3]) + (v1[0] * v1[0] + v1[1] * v1[1]) + (v1[2] * v1[2] + v1[3] * v1[3]); }
                s += __shfl_xor(s, 16); s += __shfl_xor(s, 32);
                if (fq == 0) ssq[(size_t)row * 32 + u.pn * 4 + wc] = s; }
    }
};
struct EpiSwiglu {
    static constexpr bool PERM = true, AFTER_DRAIN = false;
    bf16_t* O; const float* ssq;
    __device__ __forceinline__ void operator()(const f32x4 (&acc)[2][2][4][2], const Unit& u, int wr, int wc, int fr, int fq) const {
        asm volatile("" : "+v"(fr), "+v"(fq));
        const int row0 = u.pm * BM + wr * 64 + fr, col0 = u.pn * HALF + wc * 32 + 8 * fq;
#pragma unroll
        for (int ai = 0; ai < 2; ++ai)
#pragma unroll
            for (int m = 0; m < 4; ++m) { const int row = row0 + ai * HALF + m * 16; const float ri = rinv_row4(ssq, row, fq); float o[8];
#pragma unroll
                for (int n = 0; n < 2; ++n)
#pragma unroll
                    for (int e = 0; e < 4; ++e) { const float g = acc[ai][0][m][n][e] * ri, up = acc[ai][1][m][n][e] * ri; o[4 * n + e] = silu_f(g) * up; }
                u32x4 w; w.x = cvt_pk_bf16(o[0], o[1]); w.y = cvt_pk_bf16(o[2], o[3]); w.z = cvt_pk_bf16(o[4], o[5]); w.w = cvt_pk_bf16(o[6], o[7]);
                *(u32x4*)(O + (size_t)row * FF + col0) = w; }
    }
};
struct EpiQKV {
    static constexpr bool PERM = true, AFTER_DRAIN = false;
    bf16_t* Q; bf16_t* KB; bf16_t* VT; float* kwin; float* vwin; const float* ssq;
    __device__ __forceinline__ void operator()(const f32x4 (&acc)[2][2][4][2], const Unit& u, int wr, int wc, int fr, int fq) const {
        asm volatile("" : "+v"(fr), "+v"(fq));
        const int row0 = u.pm * BM + wr * 64 + fr, cl0 = wc * 32 + 8 * fq;
#pragma unroll
        for (int ai = 0; ai < 2; ++ai)
#pragma unroll
            for (int m = 0; m < 4; ++m) { const int row = row0 + ai * HALF + m * 16; const float ri = rinv_row4(ssq, row, fq); const int b = row >> 11, t = row & 2047;
#pragma unroll
                for (int bj = 0; bj < 2; ++bj) { const f32x4 v0 = acc[ai][bj][m][0] * ri, v1 = acc[ai][bj][m][1] * ri; const int cl = cl0 + bj * HALF;
                    if (u.pn < 8) {
                        u32x4 w; w.x = cvt_pk_bf16(v0[0], v0[1]); w.y = cvt_pk_bf16(v0[2], v0[3]); w.z = cvt_pk_bf16(v1[0], v1[1]); w.w = cvt_pk_bf16(v1[2], v1[3]);
                        *(u32x4*)(Q + (size_t)row * D + u.pn * BM + cl) = w;
                    } else if (u.pn == 8) {
                        u32x4 w; w.x = cvt_pk_bf16(v0[0], v0[1]); w.y = cvt_pk_bf16(v0[2], v0[3]); w.z = cvt_pk_bf16(v1[0], v1[1]); w.w = cvt_pk_bf16(v1[2], v1[3]);
                        *(u32x4*)(KB + (size_t)row * 256 + cl) = w;
                        if (t >= SEQ - 128) { float* o = kwin + ((size_t)(b * 128 + t - (SEQ - 128))) * 256 + cl; *(f32x4*)o = v0; *(f32x4*)(o + 4) = v1; }
                    } else {
                        const float vv[8] = {v0[0], v0[1], v0[2], v0[3], v1[0], v1[1], v1[2], v1[3]};
#pragma unroll
                        for (int e = 0; e < 8; ++e) { const int c = cl + e; VT[((size_t)(b * 4 + (c >> 6)) * 64 + (c & 63)) * SEQ + t] = (bf16_t)(cvt_pk_bf16(vv[e], 0.f) & 0xffffu); }
                        if (t >= SEQ - 128) { float* o = vwin + ((size_t)(b * 128 + t - (SEQ - 128))) * 256 + cl; *(f32x4*)o = v0; *(f32x4*)(o + 4) = v1; }
                    } } }
    }
};
}

__device__ __forceinline__ void tr_item(const float* __restrict__ src, int ld, int col0, int K, int k0, bf16_t* __restrict__ dst, int drow0,
                                        const float* __restrict__ gain, float scale, LAS float* scr, int lane) {
#pragma unroll 4
    for (int i = 0; i < 16; ++i) {
        const int kk = 4 * i + (lane >> 4);
        const f32x4 v = *(const f32x4*)(src + (size_t)(k0 + kk) * ld + col0 + 4 * (lane & 15));
        const float g = gain ? gain[k0 + kk] * scale : scale;
        LAS float* p = scr + kk * 65 + 4 * (lane & 15);
        p[0] = v[0] * g; p[1] = v[1] * g; p[2] = v[2] * g; p[3] = v[3] * g;
    }
    LDS_WAIT();
#pragma unroll
    for (int j = 0; j < 8; ++j) {
        const int idx = j * 64 + lane, n = idx >> 3, kc = idx & 7;
        const LAS float* s = scr + (8 * kc) * 65 + n;
        u32x4 o; o.x = pk2(s[0], s[65]); o.y = pk2(s[2 * 65], s[3 * 65]); o.z = pk2(s[4 * 65], s[5 * 65]); o.w = pk2(s[6 * 65], s[7 * 65]);
        *(u32x4*)(dst + (size_t)(drow0 + n) * K + k0 + 8 * kc) = o;
    }
    LDS_WAIT();
}

__device__ __forceinline__ void row_to_bf16(const float* __restrict__ xrow, bf16_t* __restrict__ orow, float* ssq_out, int npart, int lane) {
    const f32x4* xr = (const f32x4*)xrow + lane;
    f32x4 v[8]; float s = 0.f;
#pragma unroll
    for (int j = 0; j < 8; ++j) { v[j] = xr[64 * j]; s += (v[j][0] * v[j][0] + v[j][1] * v[j][1]) + (v[j][2] * v[j][2] + v[j][3] * v[j][3]); }
    s = wave_sum(s);
    if (lane < npart) ssq_out[lane] = lane == 0 ? s : 0.f;
    u32x2* o8 = (u32x2*)orow + lane;
#pragma unroll
    for (int j = 0; j < 8; ++j) { u32x2 w; w.x = pk2(v[j][0], v[j][1]); w.y = pk2(v[j][2], v[j][3]); o8[64 * j] = w; }
}

template <bool PAIR, class F>
__device__ __forceinline__ void skinny_unit(const bf16_t* __restrict__ A, int lda, const bf16_t* __restrict__ B0, const bf16_t* __restrict__ B1, int ldb, int K,
                                            LAS float* red, int wid, int lane, int tid, F&& epi) {
    asm volatile("" : "+v"(tid), "+v"(lane));
    const int kw = K >> 3, kbeg = wid * kw;
    f32x16 acc0, acc1;
#pragma unroll
    for (int r = 0; r < 16; ++r) { acc0[r] = 0.f; acc1[r] = 0.f; }
    const bf16_t* ap = A + (size_t)(lane & 31) * lda + kbeg + 8 * (lane >> 5);
    const bf16_t* bp0 = B0 + (size_t)(lane & 31) * ldb + kbeg + 8 * (lane >> 5);
    const bf16_t* bp1 = (PAIR ? B1 : B0) + (size_t)(lane & 31) * ldb + kbeg + 8 * (lane >> 5);
#pragma unroll 4
    for (int k = 0; k < kw; k += 16) {
        const bf16x8 a = *(const bf16x8*)(ap + k);
        const bf16x8 b0 = *(const bf16x8*)(bp0 + k);
        acc0 = MFMA32(a, b0, acc0);
        if (PAIR) { const bf16x8 b1 = *(const bf16x8*)(bp1 + k); acc1 = MFMA32(a, b1, acc1); }
    }
#pragma unroll
    for (int r = 0; r < 16; ++r) { red[((wid * 2 + 0) * 16 + r) * 64 + lane] = acc0[r]; if (PAIR) red[((wid * 2 + 1) * 16 + r) * 64 + lane] = acc1[r]; }
    __syncthreads();
#pragma unroll
    for (int q = 0; q < 2; ++q) {
        const int e = tid + 512 * q, r = e >> 6, ln = e & 63;
        float v0 = 0.f, v1 = 0.f;
#pragma unroll
        for (int w = 0; w < 8; ++w) { v0 += red[((w * 2 + 0) * 16 + r) * 64 + ln]; if (PAIR) v1 += red[((w * 2 + 1) * 16 + r) * 64 + ln]; }
        epi(crow32(r, ln >> 5), ln & 31, v0, v1);
    }
    __syncthreads();
}

constexpr int PL_QN = 0, PL_KN = 18432, PL_KT = 36864, PL_VT = 55296, PL_AM = 92160, PL_TAB = 126976;
constexpr int PL_T = 0, PL_TP = 18432;
constexpr int NAT_LD = 136, TR_LD = 72, AM_LD = 68;

struct PrepArgs { const bf16_t* proj; const float* beta; const float* g; const float* convw; unsigned char* prepa; unsigned char* prepu; float* egl; float* conv_p; };

__device__ __forceinline__ void prep_unit(const PrepArgs& P, LAS unsigned char* lds, int b, int kh, int n, int tid, int wid, int lane) {
    asm volatile("" : "+v"(tid), "+v"(lane));
    LAS bf16_t* QN = (LAS bf16_t*)(lds + PL_QN); LAS bf16_t* KN = (LAS bf16_t*)(lds + PL_KN);
    LAS bf16_t* KT = (LAS bf16_t*)(lds + PL_KT); LAS bf16_t* VTt = (LAS bf16_t*)(lds + PL_VT);
    LAS float* AM = (LAS float*)(lds + PL_AM); LAS float* TAB = (LAS float*)(lds + PL_TAB);
    const int r0 = b * SEQ + n * 64;
    if (wid < 2) {
        const int hv = 2 * kh + wid;
        float gv = P.g[(size_t)(r0 + lane) * 32 + hv];
#pragma unroll
        for (int o = 1; o < 64; o <<= 1) { const float t = __shfl_up(gv, o); if (lane >= o) gv += t; }
        TAB[wid * 64 + lane] = gv;
        TAB[128 + wid * 64 + lane] = P.beta[(size_t)(r0 + lane) * 32 + hv];
    }
    __syncthreads();
    {
        const int t = tid;
        const int gcol = t < 128 ? kh * 128 + t : (t < 256 ? 2048 + kh * 128 + (t - 128) : 4096 + kh * 256 + (t - 256));
        const float c0 = P.convw[gcol], c1 = P.convw[CONVD + gcol], c2 = P.convw[2 * CONVD + gcol], c3 = P.convw[3 * CONVD + gcol];
        const bf16_t* pp = P.proj + (size_t)r0 * INW + gcol;
        float w0 = 0.f, w1 = 0.f, w2 = 0.f;
        if (n > 0) { w0 = bf2f(pp[-3 * (long)INW]); w1 = bf2f(pp[-2 * (long)INW]); w2 = bf2f(pp[-(long)INW]); }
        const int vh = (t - 256) >> 7;
        bf16_t rawb[64];
#pragma unroll
        for (int j = 0; j < 64; ++j) rawb[j] = pp[(size_t)j * INW];
#pragma unroll
        for (int jb = 0; jb < 8; ++jb) {
            float raw[8];
#pragma unroll
            for (int e = 0; e < 8; ++e) raw[e] = bf2f(rawb[jb * 8 + e]);
            float ov[8];
#pragma unroll
            for (int e = 0; e < 8; ++e) { const float cv = w0 * c0 + w1 * c1 + w2 * c2 + raw[e] * c3; ov[e] = silu_f(cv); w0 = w1; w1 = w2; w2 = raw[e]; }
            if (t < 256) {
                LAS bf16_t* nat = (t < 128 ? QN : KN) + (t & 127);
#pragma unroll
                for (int e = 0; e < 8; ++e) nat[(jb * 8 + e) * NAT_LD] = f2bf(ov[e]);
                if (t >= 128) { u32x4 w; w.x = pk2(ov[0], ov[1]); w.y = pk2(ov[2], ov[3]); w.z = pk2(ov[4], ov[5]); w.w = pk2(ov[6], ov[7]);
                    *(LAS u32x4*)(KT + (t - 128) * TR_LD + jb * 8) = w; }
            } else {
                const LAS float* bt = TAB + 128 + vh * 64 + jb * 8;
                u32x4 w; w.x = pk2(ov[0] * bt[0], ov[1] * bt[1]); w.y = pk2(ov[2] * bt[2], ov[3] * bt[3]); w.z = pk2(ov[4] * bt[4], ov[5] * bt[5]); w.w = pk2(ov[6] * bt[6], ov[7] * bt[7]);
                *(LAS u32x4*)(VTt + (t - 256) * TR_LD + jb * 8) = w;
            }
            if (n == NCH - 1 && jb == 7) {
#pragma unroll
                for (int e = 5; e < 8; ++e) P.conv_p[((size_t)b * 3 + (e - 5)) * CONVD + gcol] = raw[e];
            }
        }
    }
    __syncthreads();
    {
        const int arr = tid >> 8, row = (tid >> 2) & 63, part = tid & 3;
        const LAS bf16_t* p = (arr ? KN : QN) + row * NAT_LD + part * 32;
        float s = 0.f;
#pragma unroll
        for (int c = 0; c < 4; ++c) { const bf16x8 v = *(const LAS bf16x8*)(p + c * 8);
#pragma unroll
            for (int e = 0; e < 8; ++e) { const float f = bf2f((bf16_t)v[e]); s += f * f; } }
        s += __shfl_xor(s, 1); s += __shfl_xor(s, 2);
        if (part == 0) TAB[256 + arr * 64 + row] = 1.0f / sqrtf(s + EPS);
    }
    __syncthreads();
    const int m16 = lane & 15, q4 = lane >> 4;
    unsigned char* recA0 = P.prepa + (size_t)((b * 32 + 2 * kh) * NCH + n) * PREPA_REC;
    const size_t hstrideA = (size_t)NCH * PREPA_REC;
    {
        const int half = wid >> 2, it = wid & 3;
        f32x4 acc[4];
#pragma unroll
        for (int jt = 0; jt < 4; ++jt) acc[jt] = (f32x4){0.f, 0.f, 0.f, 0.f};
        if (half == 0) {
#pragma unroll
            for (int s = 0; s < 4; ++s) { const bf16x8 bq = *(const LAS bf16x8*)(QN + (16 * it + m16) * NAT_LD + 32 * s + 8 * q4);
#pragma unroll
                for (int jt = 0; jt < 4; ++jt) { const bf16x8 ak = *(const LAS bf16x8*)(KN + (16 * jt + m16) * NAT_LD + 32 * s + 8 * q4); acc[jt] = MFMA16(ak, bq, acc[jt]); } }
            const int i = 16 * it + m16; const float rqi = TAB[256 + i] * 0.08838834764831845f;
#pragma unroll
            for (int h = 0; h < 2; ++h) { const float gci = TAB[h * 64 + i];
#pragma unroll
                for (int s = 0; s < 2; ++s) { float o[8];
#pragma unroll
                    for (int e = 0; e < 8; ++e) { const int jt = 2 * s + (e >> 2), j = 16 * jt + 4 * q4 + (e & 3);
                        const float dec = fast_exp(gci - TAB[h * 64 + j]); o[e] = (i >= j) ? acc[jt][e & 3] * rqi * TAB[320 + j] * dec : 0.f; }
                    u32x4 w; w.x = pk2(o[0], o[1]); w.y = pk2(o[2], o[3]); w.z = pk2(o[4], o[5]); w.w = pk2(o[6], o[7]);
                    *(u32x4*)(recA0 + h * hstrideA + (48 + it * 2 + s) * 1024 + lane * 16) = w; } }
        } else {
#pragma unroll
            for (int s = 0; s < 4; ++s) { const bf16x8 ai = *(const LAS bf16x8*)(KN + (16 * it + m16) * NAT_LD + 32 * s + 8 * q4);
#pragma unroll
                for (int jt = 0; jt < 4; ++jt) { const bf16x8 bk = *(const LAS bf16x8*)(KN + (16 * jt + m16) * NAT_LD + 32 * s + 8 * q4); acc[jt] = MFMA16(ai, bk, acc[jt]); } }
#pragma unroll
            for (int jt = 0; jt < 4; ++jt) { const int j = 16 * jt + m16; const float rkj = TAB[320 + j];
#pragma unroll
                for (int e = 0; e < 4; ++e) { const int i = 16 * it + 4 * q4 + e; const float base = acc[jt][e] * rkj * TAB[320 + i];
#pragma unroll
                    for (int h = 0; h < 2; ++h) { const float dec = fast_exp(TAB[h * 64 + i] - TAB[h * 64 + j]);
                        AM[h * 64 * AM_LD + i * AM_LD + j] = (i > j) ? base * TAB[128 + h * 64 + i] * dec : 0.f; } } }
        }
        {
            const int h = wid >> 2, mt = wid & 3, i = 16 * mt + m16;
            const float sc = TAB[256 + i] * 0.08838834764831845f * fast_exp(TAB[h * 64 + i]);
#pragma unroll
            for (int s = 0; s < 4; ++s) {
                const bf16x4 lo = *(const LAS bf16x4*)(QN + i * NAT_LD + 32 * s + 4 * q4), hi = *(const LAS bf16x4*)(QN + i * NAT_LD + 32 * s + 16 + 4 * q4);
                u32x4 w; w.x = pk2(bf2f((bf16_t)lo[0]) * sc, bf2f((bf16_t)lo[1]) * sc); w.y = pk2(bf2f((bf16_t)lo[2]) * sc, bf2f((bf16_t)lo[3]) * sc);
                w.z = pk2(bf2f((bf16_t)hi[0]) * sc, bf2f((bf16_t)hi[1]) * sc); w.w = pk2(bf2f((bf16_t)hi[2]) * sc, bf2f((bf16_t)hi[3]) * sc);
                *(u32x4*)(recA0 + h * hstrideA + (16 + mt * 4 + s) * 1024 + lane * 16) = w;
            }
        }
    }
    __syncthreads();
    asm volatile("" : "+v"(lane));
    if (wid < 2) {
        const int h = wid, c = lane;
        const LAS float* A = AM + h * 64 * AM_LD;
        float t[64];
#pragma unroll
        for (int i = 0; i < 64; ++i) {
            float a = (c == i) ? 1.f : 0.f;
#pragma unroll
            for (int j4 = 0; j4 < (i + 3) / 4; ++j4) {
                const f32x4 av = *(const LAS f32x4*)(A + i * AM_LD + 4 * j4);
#pragma unroll
                for (int x = 0; x < 4; ++x) if (4 * j4 + x < i) a -= av[x] * t[4 * j4 + x];
            }
            t[i] = a;
        }
        const float scc = -TAB[320 + c] * TAB[128 + h * 64 + c] * fast_exp(TAB[h * 64 + c]);
        LAS bf16_t* T = (LAS bf16_t*)(lds + PL_T + h * 9216); LAS bf16_t* TP = (LAS bf16_t*)(lds + PL_TP + h * 9216);
#pragma unroll
        for (int i = 0; i < 64; ++i) { T[i * TR_LD + c] = f2bf(t[i]); TP[i * TR_LD + c] = f2bf(t[i] * scc); }
    } else {
        for (int f = wid - 2; f < 32; f += 6) {
            const int h = f >> 4, mt = (f >> 1) & 7, s = f & 1, d = 16 * mt + m16;
            const float glast = TAB[h * 64 + 63];
            const bf16x4 lo = *(const LAS bf16x4*)(KT + d * TR_LD + 32 * s + 4 * q4), hi = *(const LAS bf16x4*)(KT + d * TR_LD + 32 * s + 16 + 4 * q4);
            float o[8];
#pragma unroll
            for (int e = 0; e < 8; ++e) { const int j = 32 * s + 16 * (e >> 2) + 4 * q4 + (e & 3);
                o[e] = bf2f((bf16_t)(e < 4 ? lo[e & 3] : hi[e & 3])) * TAB[320 + j] * fast_exp(glast - TAB[h * 64 + j]); }
            u32x4 w; w.x = pk2(o[0], o[1]); w.y = pk2(o[2], o[3]); w.z = pk2(o[4], o[5]); w.w = pk2(o[6], o[7]);
            *(u32x4*)(recA0 + h * hstrideA + (32 + mt * 2 + s) * 1024 + lane * 16) = w;
        }
    }
    __syncthreads();
    {
        asm volatile("" : "+v"(lane)); const int m16 = lane & 15, q4 = lane >> 4;
        const int h = wid >> 2, it = wid & 3;
        const LAS bf16_t* T = (const LAS bf16_t*)(lds + PL_T + h * 9216); const LAS bf16_t* TP = (const LAS bf16_t*)(lds + PL_TP + h * 9216);
        bf16x8 tp[2], tt[2];
#pragma unroll
        for (int s = 0; s < 2; ++s) { tp[s] = *(const LAS bf16x8*)(TP + (16 * it + m16) * TR_LD + 32 * s + 8 * q4); tt[s] = *(const LAS bf16x8*)(T + (16 * it + m16) * TR_LD + 32 * s + 8 * q4); }
        unsigned char* recA = recA0 + h * hstrideA;
#pragma unroll
        for (int sp = 0; sp < 4; ++sp) {
            f32x4 a0 = (f32x4){0.f, 0.f, 0.f, 0.f}, a1 = a0;
#pragma unroll
            for (int s = 0; s < 2; ++s) {
                const bf16x8 k0 = *(const LAS bf16x8*)(KT + (32 * sp + m16) * TR_LD + 32 * s + 8 * q4), k1 = *(const LAS bf16x8*)(KT + (32 * sp + 16 + m16) * TR_LD + 32 * s + 8 * q4);
                a0 = MFMA16(k0, tp[s], a0); a1 = MFMA16(k1, tp[s], a1);
            }
            u32x4 w; w.x = pk2(a0[0], a0[1]); w.y = pk2(a0[2], a0[3]); w.z = pk2(a1[0], a1[1]); w.w = pk2(a1[2], a1[3]);
            *(u32x4*)(recA + (it * 4 + sp) * 1024 + lane * 16) = w;
        }
        unsigned char* recU = P.prepu + (size_t)((b * 32 + 2 * kh + h) * NCH + n) * PREPU_REC;
#pragma unroll
        for (int et = 0; et < 8; ++et) {
            f32x4 a = (f32x4){0.f, 0.f, 0.f, 0.f};
#pragma unroll
            for (int s = 0; s < 2; ++s) { const bf16x8 bv = *(const LAS bf16x8*)(VTt + (h * 128 + 16 * et + m16) * TR_LD + 32 * s + 8 * q4); a = MFMA16(tt[s], bv, a); }
            u32x2 w; w.x = pk2(a[0], a[1]); w.y = pk2(a[2], a[3]);
            *(u32x2*)(recU + (et * 4 + it) * 512 + lane * 8) = w;
        }
        if (tid < 2) P.egl[(b * 32 + 2 * kh + tid) * NCH + n] = fast_exp(TAB[tid * 64 + 63]);
    }
    __syncthreads();
}

#define BAR_LDS() do { asm volatile("s_waitcnt lgkmcnt(0)" ::: "memory"); __builtin_amdgcn_s_barrier(); asm volatile("" ::: "memory"); } while (0)

struct ScanArgs { const unsigned char* prepa; const unsigned char* prepu; const float* egl; const bf16_t* proj; const float* gnorm; bf16_t* og; float* delta_out; };

__device__ __forceinline__ void scan_unit(const ScanArgs& P, LAS unsigned char* lds, int b, int hv, int tid, int wid, int lane) {
    asm volatile("" : "+v"(tid), "+v"(lane));
    const int m16 = lane & 15, q4 = lane >> 4;
    const unsigned char* recA = P.prepa + (size_t)((b * 32 + hv) * NCH) * PREPA_REC;
    const unsigned char* recU = P.prepu + (size_t)((b * 32 + hv) * NCH) * PREPU_REC;
    const float* eglp = P.egl + (b * 32 + hv) * NCH;
    LAS float* part = (LAS float*)(lds + 114688);
    const float gn = P.gnorm[16 * wid + m16];
    const bf16_t* zbase = P.proj + (size_t)(b * SEQ) * INW + 8192 + hv * 128 + 16 * wid + m16;
    f32x4 S[8];
#pragma unroll
    for (int dt = 0; dt < 8; ++dt) S[dt] = (f32x4){0.f, 0.f, 0.f, 0.f};
#define SCAN_DMA(n_, stage_) do { _Pragma("unroll") for (int k_ = 0; k_ < 7; ++k_) \
        __builtin_amdgcn_global_load_lds((const unsigned*)(recA + (size_t)(n_) * PREPA_REC + (k_ * 8 + wid) * 1024 + lane * 16), \
                                         (LAS unsigned*)(lds + (stage_) * PREPA_REC + (k_ * 8 + wid) * 1024), 16, 0, 0); } while (0)
    SCAN_DMA(0, 0);
    u32x2 un[4]; float egn;
#pragma unroll
    for (int mt = 0; mt < 4; ++mt) un[mt] = *(const u32x2*)(recU + (wid * 4 + mt) * 512 + lane * 8);
    egn = eglp[0];
#pragma unroll 1
    for (int n = 0; n < NCH; ++n) {
        VM_WAIT(); BAR_LDS();
        u32x2 uc[4]; bf16_t zc[16]; const float egl = egn;
#pragma unroll
        for (int mt = 0; mt < 4; ++mt) uc[mt] = un[mt];
#pragma unroll
        for (int mt = 0; mt < 4; ++mt)
#pragma unroll
            for (int jj = 0; jj < 4; ++jj) zc[mt * 4 + jj] = zbase[(size_t)(n * 64 + 16 * mt + 4 * q4 + jj) * INW];
        if (n + 1 < NCH) {
            SCAN_DMA(n + 1, (n + 1) & 1);
#pragma unroll
            for (int mt = 0; mt < 4; ++mt) un[mt] = *(const u32x2*)(recU + (size_t)(n + 1) * PREPU_REC + (wid * 4 + mt) * 512 + lane * 8);
            egn = eglp[n + 1];
        }
        const LAS unsigned char* st = lds + (n & 1) * PREPA_REC + lane * 16;
        bf16x8 sb[4];
#pragma unroll
        for (int s = 0; s < 4; ++s) { u32x4 w; w.x = pk2(S[2 * s][0], S[2 * s][1]); w.y = pk2(S[2 * s][2], S[2 * s][3]); w.z = pk2(S[2 * s + 1][0], S[2 * s + 1][1]); w.w = pk2(S[2 * s + 1][2], S[2 * s + 1][3]);
            sb[s] = __builtin_bit_cast(bf16x8, w); }
        f32x4 vn[4], o[4];
#pragma unroll
        for (int mt = 0; mt < 4; ++mt) {
            vn[mt] = (f32x4){__uint_as_float(uc[mt].x << 16), __uint_as_float(uc[mt].x & 0xffff0000u), __uint_as_float(uc[mt].y << 16), __uint_as_float(uc[mt].y & 0xffff0000u)};
            o[mt] = (f32x4){0.f, 0.f, 0.f, 0.f};
#pragma unroll
            for (int s = 0; s < 4; ++s) {
                const bf16x8 aw = *(const LAS bf16x8*)(st + (mt * 4 + s) * 1024), aq = *(const LAS bf16x8*)(st + (16 + mt * 4 + s) * 1024);
                vn[mt] = MFMA16(aw, sb[s], vn[mt]); o[mt] = MFMA16(aq, sb[s], o[mt]);
            }
        }
        bf16x8 vb[2];
#pragma unroll
        for (int sp = 0; sp < 2; ++sp) { u32x4 w; w.x = pk2(vn[2 * sp][0], vn[2 * sp][1]); w.y = pk2(vn[2 * sp][2], vn[2 * sp][3]); w.z = pk2(vn[2 * sp + 1][0], vn[2 * sp + 1][1]); w.w = pk2(vn[2 * sp + 1][2], vn[2 * sp + 1][3]);
            vb[sp] = __builtin_bit_cast(bf16x8, w); }
#pragma unroll
        for (int mt = 0; mt < 4; ++mt)
#pragma unroll
            for (int sp = 0; sp < 2; ++sp) { const bf16x8 ai = *(const LAS bf16x8*)(st + (48 + mt * 2 + sp) * 1024); o[mt] = MFMA16(ai, vb[sp], o[mt]); }
#pragma unroll
        for (int dt = 0; dt < 8; ++dt) { S[dt] = S[dt] * egl;
#pragma unroll
            for (int sp = 0; sp < 2; ++sp) { const bf16x8 ak = *(const LAS bf16x8*)(st + (32 + dt * 2 + sp) * 1024); S[dt] = MFMA16(ak, vb[sp], S[dt]); } }
#pragma unroll
        for (int mt = 0; mt < 4; ++mt)
#pragma unroll
            for (int jj = 0; jj < 4; ++jj) { float s = o[mt][jj] * o[mt][jj]; s += __shfl_xor(s, 1); s += __shfl_xor(s, 2); s += __shfl_xor(s, 4); s += __shfl_xor(s, 8);
                if (m16 == 0) part[(16 * mt + 4 * q4 + jj) * 8 + wid] = s; }
        BAR_LDS();
        bf16_t* ogp = P.og + (size_t)(b * SEQ + n * 64) * VALD + hv * 128 + 16 * wid + m16;
#pragma unroll
        for (int mt = 0; mt < 4; ++mt)
#pragma unroll
            for (int jj = 0; jj < 4; ++jj) { const int i = 16 * mt + 4 * q4 + jj;
                const f32x4 p0 = *(const LAS f32x4*)(part + i * 8), p1 = *(const LAS f32x4*)(part + i * 8 + 4);
                const float tot = ((p0[0] + p0[1]) + (p0[2] + p0[3])) + ((p1[0] + p1[1]) + (p1[2] + p1[3]));
                const float ri = 1.0f / sqrtf(tot * (1.0f / 128.0f) + EPS);
                ogp[(size_t)i * VALD] = f2bf(o[mt][jj] * ri * gn * silu_f(bf2f(zc[mt * 4 + jj]))); }
    }
#undef SCAN_DMA
    float* so = P.delta_out + ((size_t)(b * 32 + hv) * 128) * 128 + 16 * wid + m16;
#pragma unroll
    for (int dt = 0; dt < 8; ++dt)
#pragma unroll
        for (int jj = 0; jj < 4; ++jj) so[(size_t)(16 * dt + 4 * q4 + jj) * 128] = S[dt][jj];
    VM_WAIT(); BAR_LDS();
}

struct SConvArgs { const float* projs; const float* sconv; const float* convw; const float* a_log; const float* dt_bias; float* qkvs; float* betas; float* gs; float* conv_s; };
__device__ __forceinline__ void sconv_item(const SConvArgs& P, int b, int cg, int lane) {
    float v[2];
#pragma unroll
    for (int hh = 0; hh < 2; ++hh) {
        const int c = cg * 128 + lane + 64 * hh;
        const float raw = P.projs[(size_t)b * INDIM + c];
        const float p0 = P.sconv[((size_t)b * 3 + 0) * CONVD + c], p1 = P.sconv[((size_t)b * 3 + 1) * CONVD + c], p2 = P.sconv[((size_t)b * 3 + 2) * CONVD + c];
        const float acc = p0 * P.convw[c] + p1 * P.convw[CONVD + c] + p2 * P.convw[2 * CONVD + c] + raw * P.convw[3 * CONVD + c];
        P.conv_s[((size_t)b * 3 + 0) * CONVD + c] = p1; P.conv_s[((size_t)b * 3 + 1) * CONVD + c] = p2; P.conv_s[((size_t)b * 3 + 2) * CONVD + c] = raw;
        v[hh] = acc / (1.0f + expf(-acc));
    }
    if (cg < 32) {
        const float s = wave_sum(v[0] * v[0] + v[1] * v[1]);
        float r = 1.0f / sqrtf(s + EPS); if (cg < 16) r *= 0.08838834764831845f;
        v[0] *= r; v[1] *= r;
    }
    P.qkvs[(size_t)b * CONVD + cg * 128 + lane] = v[0]; P.qkvs[(size_t)b * CONVD + cg * 128 + lane + 64] = v[1];
    if (cg == 0 && lane < 32) {
        const float braw = P.projs[(size_t)b * INDIM + 12288 + lane], araw = P.projs[(size_t)b * INDIM + 12320 + lane];
        const float xx = araw + P.dt_bias[lane]; const float sp = xx > 20.f ? xx : log1pf(expf(xx));
        P.betas[b * 32 + lane] = 1.0f / (1.0f + expf(-braw)); P.gs[b * 32 + lane] = -expf(P.a_log[lane]) * sp;
    }
}

struct SRecArgs { const float* qkvs; const float* betas; const float* gs; const float* projs; const float* gnorm; const float* S0; float* Sout; bf16_t* ogs; };
__device__ __forceinline__ void srec_unit(const SRecArgs& P, LAS unsigned char* lds, int b, int hv, int tid) {
    asm volatile("" : "+v"(tid));
    LAS float* qs = (LAS float*)lds; LAS float* ks = qs + 128; LAS float* red = qs + 256; LAS float* wsm = qs + 768;
    const int e = tid & 127, dq = tid >> 7, hk = hv >> 1;
    if (tid < 128) qs[tid] = P.qkvs[(size_t)b * CONVD + hk * 128 + tid]; else if (tid < 256) ks[tid - 128] = P.qkvs[(size_t)b * CONVD + 2048 + hk * 128 + (tid - 128)];
    const float ve = P.qkvs[(size_t)b * CONVD + 4096 + hv * 128 + e], beta = P.betas[b * 32 + hv], dec = expf(P.gs[b * 32 + hv]);
    const size_t sbase = ((size_t)(b * 32 + hv) * 128 + 32 * dq) * 128 + e;
    float S[32];
#pragma unroll
    for (int d = 0; d < 32; ++d) S[d] = P.S0[sbase + (size_t)d * 128];
    __syncthreads();
    float kvp = 0.f;
#pragma unroll
    for (int d = 0; d < 32; ++d) { S[d] *= dec; kvp += S[d] * ks[32 * dq + d]; }
    red[dq * 128 + e] = kvp;
    __syncthreads();
    const float kv = (red[e] + red[128 + e]) + (red[256 + e] + red[384 + e]);
    const float dl = (ve - kv) * beta;
    float op = 0.f;
#pragma unroll
    for (int d = 0; d < 32; ++d) { S[d] += ks[32 * dq + d] * dl; op += S[d] * qs[32 * dq + d]; }
    __syncthreads();
    red[dq * 128 + e] = op;
#pragma unroll
    for (int d = 0; d < 32; ++d) P.Sout[sbase + (size_t)d * 128] = S[d];
    __syncthreads();
    const float o = (red[e] + red[128 + e]) + (red[256 + e] + red[384 + e]);
    if (tid < 128) { const float s = wave_sum(o * o); if ((tid & 63) == 0) wsm[tid >> 6] = s; }
    __syncthreads();
    if (tid < 128) {
        const float ri = 1.0f / sqrtf((wsm[0] + wsm[1]) * (1.0f / 128.0f) + EPS);
        const float z = P.projs[(size_t)b * INDIM + 8192 + hv * 128 + e];
        P.ogs[(size_t)b * VALD + hv * 128 + e] = f2bf(o * ri * P.gnorm[e] * (z / (1.0f + expf(-z))));
    }
    __syncthreads();
}

__device__ __forceinline__ int t5_bucket(int d) {
    if (d < 16) return d;
    const int v = 16 + (int)(logf((float)d / 16.0f) / logf(8.0f) * 16.0f);
    return v < 31 ? v : 31;
}
struct AttnArgs { const bf16_t* Q; const bf16_t* KB; const bf16_t* VT; bf16_t* AO; const float* sinks; };
__device__ __forceinline__ void attn_unit(const AttnArgs& P, const LAS float* bias2, int b, int h, int qb, int lane) {
    asm volatile("" : "+v"(lane));
    const int n32 = lane & 31, hi = lane >> 5, kvh = h >> 3, q0 = 32 * qb;
    const float sink2 = P.sinks[h] * LOG2E;
    bf16x8 qf[4];
    const bf16_t* qp = P.Q + (size_t)(b * SEQ + q0 + n32) * D + h * 64 + 8 * hi;
#pragma unroll
    for (int s = 0; s < 4; ++s) qf[s] = *(const bf16x8*)(qp + 16 * s);
    f32x16 st[5];
    float mx = sink2;
#pragma unroll
    for (int kt = 0; kt < 5; ++kt) {
        const int j0 = q0 - 128 + 32 * kt;
#pragma unroll
        for (int r = 0; r < 16; ++r) st[kt][r] = 0.f;
        if (j0 >= 0) {
            const bf16_t* kp = P.KB + (size_t)(b * SEQ + j0 + n32) * 256 + kvh * 64 + 8 * hi;
#pragma unroll
            for (int s = 0; s < 4; ++s) { const bf16x8 kf = *(const bf16x8*)(kp + 16 * s); st[kt] = MFMA32(kf, qf[s], st[kt]); }
        }
#pragma unroll
        for (int r = 0; r < 16; ++r) {
            const int dist = 128 - 32 * kt + n32 - crow32(r, hi);
            const bool valid = (j0 >= 0) && dist >= 0 && dist < 128;
            const float sc = valid ? st[kt][r] + bias2[h * 128 + (dist & 127)] : -INFINITY;
            st[kt][r] = sc; mx = fmaxf(mx, sc);
        }
    }
    mx = fmaxf(mx, __shfl_xor(mx, 32));
    float l = 0.f;
#pragma unroll
    for (int kt = 0; kt < 5; ++kt)
#pragma unroll
        for (int r = 0; r < 16; ++r) { const float p = fast_exp2(st[kt][r] - mx); st[kt][r] = p; l += p; }
    l += __shfl_xor(l, 32);
    l += fast_exp2(sink2 - mx);
    const float linv = 1.0f / l;
    f32x16 o[2];
#pragma unroll
    for (int r = 0; r < 16; ++r) { o[0][r] = 0.f; o[1][r] = 0.f; }
#pragma unroll
    for (int kt = 0; kt < 5; ++kt) {
        const int j0 = q0 - 128 + 32 * kt;
        if (j0 >= 0) {
#pragma unroll
            for (int s2 = 0; s2 < 2; ++s2) {
                u32x4 w; w.x = pk2(st[kt][8 * s2 + 0], st[kt][8 * s2 + 1]); w.y = pk2(st[kt][8 * s2 + 2], st[kt][8 * s2 + 3]);
                w.z = pk2(st[kt][8 * s2 + 4], st[kt][8 * s2 + 5]); w.w = pk2(st[kt][8 * s2 + 6], st[kt][8 * s2 + 7]);
                const bf16x8 pa = __builtin_bit_cast(bf16x8, w);
#pragma unroll
                for (int dh = 0; dh < 2; ++dh) {
                    const bf16_t* vp = P.VT + ((size_t)(b * 4 + kvh) * 64 + 32 * dh + n32) * SEQ + j0 + 16 * s2 + 4 * hi;
                    const u32x2 lo = *(const u32x2*)vp, hi8 = *(const u32x2*)(vp + 8);
                    u32x4 vw; vw.x = lo.x; vw.y = lo.y; vw.z = hi8.x; vw.w = hi8.y;
                    o[dh] = MFMA32(pa, __builtin_bit_cast(bf16x8, vw), o[dh]);
                }
            }
        }
    }
    bf16_t* op = P.AO + (size_t)(b * SEQ + q0) * D + h * 64 + n32;
#pragma unroll
    for (int r = 0; r < 16; ++r) {
        const int m = crow32(r, hi);
        const float li = __shfl(linv, m);
        op[(size_t)m * D] = f2bf(o[0][r] * li); op[(size_t)m * D + 32] = f2bf(o[1][r] * li);
    }
}

struct SAttnArgs { const float* qs; const float* kvs; const float* ck; const float* cv; const float* sinks; bf16_t* aos; };
__device__ __forceinline__ void sattn_unit(const SAttnArgs& P, const LAS float* bias2, int b, int h, int lane) {
    const int kvh = h >> 3;
    const float qd = P.qs[(size_t)b * D + h * 64 + lane];
    const float sink2 = P.sinks[h] * LOG2E;
    float sc[2];
#pragma unroll
    for (int hh = 0; hh < 2; ++hh) {
        const int c = lane + 64 * hh + 1;
        const float* kp = (c < 128) ? P.ck + ((size_t)(b * 128 + c) * 4 + kvh) * 64 : P.kvs + (size_t)b * 512 + kvh * 64;
        float s = 0.f;
#pragma unroll
        for (int d4 = 0; d4 < 16; ++d4) { const f32x4 kv = *(const f32x4*)(kp + 4 * d4);
#pragma unroll
            for (int x = 0; x < 4; ++x) s += __uint_as_float(__builtin_amdgcn_readlane(__float_as_uint(qd), 4 * d4 + x)) * kv[x]; }
        sc[hh] = s + bias2[h * 128 + (128 - c)];
    }
    float mx = fmaxf(sc[0], sc[1]);
#pragma unroll
    for (int o = 1; o < 64; o <<= 1) mx = fmaxf(mx, __shfl_xor(mx, o));
    mx = fmaxf(mx, sink2);
    const float p0 = fast_exp2(sc[0] - mx), p1 = fast_exp2(sc[1] - mx);
    const float l = wave_sum(p0 + p1) + fast_exp2(sink2 - mx);
    float acc = 0.f;
#pragma unroll 8
    for (int cc = 0; cc < 64; ++cc) {
        const float pa = __uint_as_float(__builtin_amdgcn_readlane(__float_as_uint(p0), cc));
        const float pb = __uint_as_float(__builtin_amdgcn_readlane(__float_as_uint(p1), cc));
        const int ca = cc + 1, cb = cc + 65;
        const float* va = P.cv + ((size_t)(b * 128 + ca) * 4 + kvh) * 64;
        const float* vb = (cb < 128) ? P.cv + ((size_t)(b * 128 + cb) * 4 + kvh) * 64 : P.kvs + (size_t)b * 512 + 256 + kvh * 64;
        acc += pa * va[lane] + pb * vb[lane];
    }
    P.aos[(size_t)b * D + h * 64 + lane] = f2bf(acc / l);
}
#define XB_TMO      128
#define XB_XCNT(j)  (256  + 64 * (j))
#define XB_XSUB(j)  (1280 + 64 * (j))
#define XB_XGEN(j)  (2304 + 64 * (j))
#define XB_TOP      3328
#define XB_TOPGEN   3392
#define XCD_BAR_WORDS 3456
#define XB_SPIN_CAP (1u << 18)

__device__ __forceinline__ unsigned xb_ld(unsigned* p)              { return __hip_atomic_load(p, __ATOMIC_RELAXED, __HIP_MEMORY_SCOPE_AGENT); }
__device__ __forceinline__ unsigned xb_add(unsigned* p, unsigned v) { return __hip_atomic_fetch_add(p, v, __ATOMIC_RELAXED, __HIP_MEMORY_SCOPE_AGENT); }
__device__ __forceinline__ unsigned xb_xcc_id() { return (unsigned)__builtin_amdgcn_s_getreg((3 << 11) | 20) & 0xFu; }
#define XB_SPIN(cond, bar) do { unsigned _sp = 0; while (cond) { __builtin_amdgcn_s_sleep(1); \
    if ((++_sp & 255u) == 0u) { if (xb_ld(&(bar)[XB_TMO])) break; if (_sp > XB_SPIN_CAP) { atomicAdd(&(bar)[XB_TMO], 1u); break; } } } } while (0)

struct XcdBarrier {
    unsigned* bar; unsigned x;
    volatile LAS unsigned* st;
};

__device__ __forceinline__ XcdBarrier xcd_barrier_post(unsigned* bar, volatile LAS unsigned* st) {
    XcdBarrier b; b.bar = bar; b.x = xb_xcc_id(); b.st = st;
    if (threadIdx.x == 0) (void)xb_add(&bar[XB_XCNT(b.x)], 1u);
    return b;
}
__device__ __forceinline__ void xcd_barrier_complete(unsigned* bar, unsigned x, unsigned& nloc, unsigned& nx) {
    const unsigned G = gridDim.x * gridDim.y * gridDim.z;
    unsigned sum, cnt, mine, sp = 0u;
    for (;;) {
        sum = 0u; cnt = 0u; mine = 0u;
#pragma unroll
        for (unsigned j = 0; j < 16; ++j) { const unsigned c = xb_ld(&bar[XB_XCNT(j)]); sum += c; cnt += (c > 0u) ? 1u : 0u; mine = (j == x) ? c : mine; }
        if (sum == G) break;
        __builtin_amdgcn_s_sleep(1);
        if ((++sp & 255u) == 0u) { if (xb_ld(&bar[XB_TMO])) break; if (sp > XB_SPIN_CAP) { atomicAdd(&bar[XB_TMO], 1u); break; } }
    }
    nloc = mine > 0u ? mine : 1u; nx = cnt > 0u ? cnt : 1u;
}

__device__ __forceinline__ void xcd_barrier(const XcdBarrier& b) {
    asm volatile("s_waitcnt vmcnt(0)" ::: "memory");
    __syncthreads();
    if (threadIdx.x == 0) {
        unsigned* bar = b.bar;
        __builtin_amdgcn_s_waitcnt(0);
        unsigned nloc = b.st[0], nx = b.st[1];
        if (nloc == 0u) { xcd_barrier_complete(bar, b.x, nloc, nx); b.st[0] = nloc; b.st[1] = nx; }
        const unsigned old = xb_add(&bar[XB_XSUB(b.x)], 1u);
        const unsigned gen = old / nloc;
        if (old + 1u == (gen + 1u) * nloc) {
            __builtin_amdgcn_fence(__ATOMIC_RELEASE, "agent");
            asm volatile("s_waitcnt vmcnt(0)" ::: "memory");
            const unsigned og = xb_add(&bar[XB_TOP], 1u);
            const unsigned tg = og / nx;
            if (og + 1u == (tg + 1u) * nx) xb_add(&bar[XB_TOPGEN], 1u);
            else XB_SPIN(xb_ld(&bar[XB_TOPGEN]) == tg, bar);
            __builtin_amdgcn_fence(__ATOMIC_ACQUIRE, "agent");
            xb_add(&bar[XB_XGEN(b.x)], 1u);
            asm volatile("s_waitcnt vmcnt(0)" ::: "memory");
        } else {
            XB_SPIN(xb_ld(&bar[XB_XGEN(b.x)]) == gen, bar);
            __builtin_amdgcn_fence(__ATOMIC_ACQUIRE, "agent");
            asm volatile("s_waitcnt vmcnt(0)" ::: "memory");
        }
    }
    __syncthreads();
}

constexpr int CW_BARBASE = 131072, BAR_REGION_WORDS = 4096;
constexpr int PH_FINAL = 25, N_PHASES = 26;
#ifndef MK_EN
#define MK_EN 0xffff
#endif
#define EN(k) (((MK_EN) >> (k)) & 1)
struct Args { const float* in[23]; float* out; unsigned char* ws; int ph_lo, ph_hi, li, pad; };

constexpr size_t O_Y = 0, O_YS = 16777216, O_DP = 16842752, O_CP = 21037056, O_KP = 21233664, O_VP = 21364736, O_DS = 21495808, O_CS = 55050240, O_KS = 56623104, O_VS = 57671680;

__global__ void __launch_bounds__(NTHR, 2) mk_fwd(Args args) {
    extern __shared__ __attribute__((aligned(16))) unsigned char lds_raw[];
    LAS unsigned char* lds = (LAS unsigned char*)lds_raw;
    volatile LAS unsigned* MISC = (volatile LAS unsigned*)(lds + MISC_OFF);
    const int G = gridDim.x, bid = blockIdx.x;
    if (threadIdx.x < 64) MISC[threadIdx.x] = 0u;
    __syncthreads();
    XcdBarrier bar = xcd_barrier_post((unsigned*)(args.ws + WS_CTL) + CW_BARBASE + args.li * BAR_REGION_WORDS, MISC + 8);
    const int lo = args.ph_lo, hi = args.ph_hi;
#define IN(k) (lo <= (k) && (k) < hi)
#define SEAM(knext) do { if (IN(knext)) xcd_barrier(bar); } while (0)
typedef const float* const __attribute__((address_space(4)))* KP_T;
#define KARG(k) (kp[(k)])
#define PH_LOCALS \
    int tid = threadIdx.x; asm volatile("" : "+v"(tid)); \
    const int lane = tid & 63, wid = __builtin_amdgcn_readfirstlane(tid >> 6); \
    KP_T kp = (KP_T)__builtin_amdgcn_kernarg_segment_ptr(); asm volatile("" : "+s"(kp)); \
    unsigned char* ws = (unsigned char*)KARG(24); \
    float* out = (float*)KARG(23); \
    const int gw = bid * NWAVES + wid, NGW = G * NWAVES; \
    float* ssq = (float*)(ws + WS_SSQP); float* ssqs = (float*)(ws + WS_SSQSP); \
    LAS float* red = (LAS float*)lds; \
    (void)gw; (void)NGW; (void)lane; (void)out; (void)ssq; (void)ssqs; (void)red;
#define RINVS ((LAS float*)(lds + 131072))
#define BUILD_RINVS(site_ptr) do { if (tid < 32) { const float* p_ = (site_ptr) + tid * 64; float s_ = 0.f; for (int i_ = 0; i_ < 64; ++i_) s_ += p_[i_]; RINVS[tid] = rinv_of(s_); } __syncthreads(); } while (0)
#define ssq_in (ssq + (size_t)(2 * L) * MP * 32)
#define ssqs_in (ssqs + (2 * L) * SB * 64)
#define ssq_mid (ssq + (size_t)(2 * L + 1) * MP * 32)
#define ssqs_mid (ssqs + (2 * L + 1) * SB * 64)
#define ssq_out (ssq + (size_t)(2 * L + 2) * MP * 32)
#define ssqs_out (ssqs + (2 * L + 2) * SB * 64)
#define x_prompt (KARG(0))
#define x_sample (KARG(1))
#define state_delta (KARG(2))
#define state_conv (KARG(3))
#define cache_k (KARG(4))
#define cache_v (KARG(5))
#define norm_mix (KARG(6))
#define norm_ffn (KARG(7))
#define w_in (KARG(8))
#define conv_w (KARG(9))
#define a_log (KARG(10))
#define dt_bias (KARG(11))
#define gnorm (KARG(12))
#define w_out (KARG(13))
#define norm_kv (KARG(14))
#define w_kv (KARG(15))
#define w_q (KARG(16))
#define w_o (KARG(17))
#define sinks (KARG(18))
#define rel_bias (KARG(19))
#define w_gu (KARG(20))
#define w_dn (KARG(21))
#define norm_final (KARG(22))
#define WIN_T ((bf16_t*)(ws + WS_WIN))
#define WBA_T ((bf16_t*)(ws + WS_WBA))
#define WOUT_T ((bf16_t*)(ws + WS_WOUT))
#define WGU_T ((bf16_t*)(ws + WS_WGU))
#define WDN_T ((bf16_t*)(ws + WS_WDN))
#define WQKV_T ((bf16_t*)(ws + WS_WQKV))
#define WQ1_T ((bf16_t*)(ws + WS_WQ1))
#define WO_T ((bf16_t*)(ws + WS_WO))
#define X ((float*)(ws + WS_X))
#define XB ((bf16_t*)(ws + WS_XB))
#define PROJ ((bf16_t*)(ws + WS_PROJ))
#define BETA ((float*)(ws + WS_BETA))
#define GG ((float*)(ws + WS_G))
#define OG ((bf16_t*)(ws + WS_OG))
#define MID ((bf16_t*)(ws + WS_MID))
#define QB ((bf16_t*)(ws + WS_Q))
#define KB ((bf16_t*)(ws + WS_K))
#define VT ((bf16_t*)(ws + WS_VT))
#define AO ((bf16_t*)(ws + WS_AO))
#define XS ((float*)(ws + WS_SMP + SM_XS))
#define XSB ((bf16_t*)(ws + WS_SMP + SM_XSB))
#define PROJS ((float*)(ws + WS_SMP + SM_PROJS))
#define QKVS ((float*)(ws + WS_SMP + SM_QKVS))
#define BETAS ((float*)(ws + WS_SMP + SM_BETAS))
#define GS ((float*)(ws + WS_SMP + SM_GS))
#define OGS ((bf16_t*)(ws + WS_SMP + SM_OGS))
#define MIDS ((bf16_t*)(ws + WS_SMP + SM_MIDS))
#define QS ((float*)(ws + WS_SMP + SM_QS))
#define KVS ((float*)(ws + WS_SMP + SM_KVS))
#define AOS ((bf16_t*)(ws + WS_SMP + SM_AOS))

    if (EN(0) && IN(0)) {
        PH_LOCALS
        LAS float* scr = (LAS float*)(lds + wid * 16640);
        constexpr int I_IN = 32 * 192, I_BA = 32, I_OUT = 64 * 32, I_GU = 32 * 176, I_DN = 88 * 32, I_KV = 32 * 8, I_Q = 32 * 32;
        constexpr int NITEMS = 2 * (I_IN + I_BA) + 2 * I_OUT + 4 * I_GU + 4 * I_DN + I_KV + 2 * I_Q + 2 * I_Q;
        for (int it = gw; it < NITEMS; it += NGW) {
            int r = it;
            if (r < 2 * I_IN) { const int l = r / I_IN; r %= I_IN; const int kb = r / 192, nb = r % 192;
                tr_item(w_in + (size_t)l * D * INDIM, INDIM, 64 * nb, D, 64 * kb, WIN_T + (size_t)l * INW * D, 64 * nb, norm_mix + l * D, 1.f, scr, lane); continue; } r -= 2 * I_IN;
            if (r < 2 * I_BA) { const int l = r / I_BA; const int kb = r % I_BA;
                tr_item(w_in + (size_t)l * D * INDIM, INDIM, INW, D, 64 * kb, WBA_T + (size_t)l * 64 * D, 0, norm_mix + l * D, 1.f, scr, lane); continue; } r -= 2 * I_BA;
            if (r < 2 * I_OUT) { const int l = r / I_OUT; r %= I_OUT; const int kb = r / 32, nb = r % 32;
                tr_item(w_out + (size_t)l * VALD * D, D, 64 * nb, VALD, 64 * kb, WOUT_T + (size_t)l * D * VALD, 64 * nb, nullptr, 1.f, scr, lane); continue; } r -= 2 * I_OUT;
            if (r < 4 * I_GU) { const int l = r / I_GU; r %= I_GU; const int kb = r / 176, nb = r % 176; const int c = 64 * nb;
                const int drow = c < FF ? 256 * (c >> 7) + (c & 127) : 256 * ((c - FF) >> 7) + 128 + ((c - FF) & 127);
                tr_item(w_gu + (size_t)l * D * GU, GU, c, D, 64 * kb, WGU_T + (size_t)l * GU * D, drow, norm_ffn + l * D, 1.f, scr, lane); continue; } r -= 4 * I_GU;
            if (r < 4 * I_DN) { const int l = r / I_DN; r %= I_DN; const int kb = r / 32, nb = r % 32;
                tr_item(w_dn + (size_t)l * FF * D, D, 64 * nb, FF, 64 * kb, WDN_T + (size_t)l * D * FF, 64 * nb, nullptr, 1.f, scr, lane); continue; } r -= 4 * I_DN;
            if (r < I_KV) { const int kb = r / 8, nb = r % 8;
                tr_item(w_kv, 512, 64 * nb, D, 64 * kb, WQKV_T, 2048 + 64 * nb, norm_kv, 1.f, scr, lane); continue; } r -= I_KV;
            if (r < 2 * I_Q) { const int j = r / I_Q; r %= I_Q; const int kb = r / 32, nb = r % 32;
                tr_item(w_q + (size_t)j * D * D, D, 64 * nb, D, 64 * kb, j == 0 ? WQKV_T : WQ1_T, 64 * nb, norm_mix + (2 + j) * D, QSCALE, scr, lane); continue; } r -= 2 * I_Q;
            { const int j = r / I_Q; r %= I_Q; const int kb = r / 32, nb = r % 32;
                tr_item(w_o + (size_t)j * D * D, D, 64 * nb, D, 64 * kb, WO_T + (size_t)j * D * D, 64 * nb, nullptr, 1.f, scr, lane); }
        }
        for (int m = gw; m < MP + SB; m += NGW) {
            if (m < MP) row_to_bf16(x_prompt + (size_t)m * D, XB + (size_t)m * D, ssq + (size_t)m * 32, 32, lane);
            else row_to_bf16(x_sample + (size_t)(m - MP) * D, XSB + (size_t)(m - MP) * D, ssqs + (size_t)(m - MP) * 64, 64, lane);
        }
        for (int i = bid * NTHR + tid; i < 2 * SB * 127 * 64; i += G * NTHR) {
            const int which = i / (SB * 127 * 64), r = i % (SB * 127 * 64), b = r / (127 * 64), o = r % (127 * 64);
            const f32x4 v = *(const f32x4*)((which ? cache_v : cache_k) + (size_t)b * 128 * 256 + 256 + 4 * o);
            *(f32x4*)(out + (which ? O_VS : O_KS) + (size_t)b * 128 * 256 + 4 * o) = v;
        }
        SEAM(1);
    }

#pragma unroll 1
    for (int L = 0; L < 4; ++L) {
        const int pb = 1 + 6 * L; const bool isA = L < 2; const int j = L - 2;
        if (IN(pb)) {
            PH_LOCALS
            if (EN(1) && isA) {
                const bf16_t* Wt = WIN_T + (size_t)L * INW * D; const bf16_t* Wba = WBA_T + (size_t)L * 64 * D;
                { pg8::Gemm g{XB, Wt, MP, INW, D}; pg8::StaticOrder S; S.init(MP, INW, G, bid);
                  pg8::EpiProj E{PROJ, INW, ssq_in};
                  pg8::gemm_phase<pg8::EpiProj, pg8::StaticOrder, true, true>(lds, g, S, E); }
                const float* al = a_log + L * 32; const float* dtb = dt_bias + L * 32;
                BUILD_RINVS(ssqs_in);
                for (int su = bid; su < 384 + 1 + 256; su += G) {
                    if (su < 384) {
                        skinny_unit<false>(XSB, D, Wt + (size_t)su * 32 * D, nullptr, D, D, red, wid, lane, tid,
                            [&](int m, int n, float v0, float) { PROJS[(size_t)m * INDIM + su * 32 + n] = v0 * RINVS[m]; });
                    } else if (su == 384) {
                        skinny_unit<true>(XSB, D, Wba, Wba + 32 * D, D, D, red, wid, lane, tid,
                            [&](int m, int n, float v0, float v1) { const float ri = RINVS[m]; PROJS[(size_t)m * INDIM + INW + n] = v0 * ri; PROJS[(size_t)m * INDIM + INW + 32 + n] = v1 * ri; });
                    } else {
                        const int u = su - 385;
                        skinny_unit<true>(XB + (size_t)u * 32 * D, D, Wba, Wba + 32 * D, D, D, red, wid, lane, tid,
                            [&](int m, int n, float v0, float v1) { const int row = 32 * u + m; const float ri = rinv_row_full(ssq_in, row);
                                const float braw = v0 * ri, xx = v1 * ri + dtb[n]; const float sp = xx > 20.f ? xx : log1pf(expf(xx));
                                BETA[(size_t)row * 32 + n] = 1.0f / (1.0f + expf(-braw)); GG[(size_t)row * 32 + n] = -expf(al[n]) * sp; });
                    }
                }
            } else if (EN(2) && !isA) {
                const bf16_t* Wt = j == 0 ? WQKV_T : WQ1_T; const int N = j == 0 ? 2560 : 2048;
                { pg8::Gemm g{XB, Wt, MP, N, D}; pg8::StaticOrder S; S.init(MP, N, G, bid);
                  pg8::EpiQKV E{QB, KB, VT, out + O_KP, out + O_VP, ssq_in};
                  pg8::gemm_phase<pg8::EpiQKV, pg8::StaticOrder, true, true>(lds, g, S, E); }
                BUILD_RINVS(ssqs_in);
                for (int su = bid; su < N / 32; su += G) {
                    skinny_unit<false>(XSB, D, Wt + (size_t)su * 32 * D, nullptr, D, D, red, wid, lane, tid,
                        [&](int m, int n, float v0, float) { const float v = v0 * RINVS[m]; const int c = su * 32 + n;
                            if (c < 2048) QS[(size_t)m * D + c] = v;
                            else { KVS[(size_t)m * 512 + (c - 2048)] = v;
                                   if (c < 2304) out[O_KS + ((size_t)m * 128 + 127) * 256 + (c - 2048)] = v; else out[O_VS + ((size_t)m * 128 + 127) * 256 + (c - 2304)] = v; } });
                }
            }
            SEAM(isA ? pb + 1 : pb + 2);
        }
        if (EN(3) && isA && IN(pb + 1)) {
            PH_LOCALS
            PrepArgs P{PROJ, BETA, GG, conv_w + (size_t)L * 4 * CONVD, ws + WS_PREPA, ws + WS_PREPU, (float*)(ws + WS_EGL), out + O_CP + (size_t)L * BATCH * 3 * CONVD};
            for (int u = bid; u < BATCH * 16 * NCH; u += G) { const int n = u & 31, kh = (u >> 5) & 15, b = u >> 9; prep_unit(P, lds, b, kh, n, tid, wid, lane); }
            SConvArgs SP{PROJS, state_conv + (size_t)L * SB * 3 * CONVD, conv_w + (size_t)L * 4 * CONVD, a_log + L * 32, dt_bias + L * 32, QKVS, BETAS, GS, out + O_CS + (size_t)L * SB * 3 * CONVD};
            for (int it = gw; it < SB * 64; it += NGW) sconv_item(SP, it >> 6, it & 63, lane);
            SEAM(pb + 2);
        }
        if (IN(pb + 2)) {
            PH_LOCALS
            if (EN(4) && isA) {
                ScanArgs P{ws + WS_PREPA, ws + WS_PREPU, (const float*)(ws + WS_EGL), PROJ, gnorm + L * 128, OG, out + O_DP + (size_t)L * BATCH * 32 * 128 * 128};
                for (int u = bid; u < BATCH * 32; u += G) scan_unit(P, lds, u >> 5, u & 31, tid, wid, lane);
                SRecArgs R{QKVS, BETAS, GS, PROJS, gnorm + L * 128, state_delta + (size_t)L * SB * 32 * 128 * 128, out + O_DS + (size_t)L * SB * 32 * 128 * 128, OGS};
                const int base = G > 128 ? 128 : 0, nb = G > 128 ? G - 128 : G;
                if (bid >= base) for (int su = bid - base; su < SB * 32; su += nb) srec_unit(R, lds, su >> 5, su & 31, tid);
            } else if (EN(5) && !isA) {
                LAS float* bias2 = (LAS float*)lds;
                for (int i = tid; i < 32 * 128; i += NTHR) { const int h = i >> 7, dist = i & 127; bias2[i] = rel_bias[t5_bucket(dist) * 32 + h] * LOG2E; }
                __syncthreads();
                AttnArgs P{QB, KB, VT, AO, sinks + j * 32};
                for (int u = gw; u < BATCH * 32 * 64; u += NGW) { const int g8 = u & 7, qb = (u >> 3) & 63, kvh = (u >> 9) & 3, b = u >> 11; attn_unit(P, bias2, b, kvh * 8 + g8, qb, lane); }
                SAttnArgs SP{QS, KVS, cache_k, cache_v, sinks + j * 32, AOS};
                for (int u = gw; u < SB * 32; u += NGW) sattn_unit(SP, bias2, u >> 5, u & 31, lane);
                __syncthreads();
            }
            SEAM(pb + 3);
        }
        if (EN(6) && IN(pb + 3)) {
            PH_LOCALS
            const bf16_t* A = isA ? OG : AO; const int K = isA ? VALD : D;
            const bf16_t* Wt = isA ? WOUT_T + (size_t)L * D * VALD : WO_T + (size_t)j * D * D;
            const float* base = L == 0 ? x_prompt : X; const float* bases = L == 0 ? x_sample : XS;
            { pg8::Gemm g{A, Wt, MP, D, K}; pg8::StaticOrder S; S.init(MP, D, G, bid);
              pg8::EpiRes E{base, X, XB, ssq_mid};
              pg8::gemm_phase<pg8::EpiRes, pg8::StaticOrder, true, true>(lds, g, S, E); }
            const bf16_t* As = isA ? OGS : AOS;
            for (int su = bid; su < 64; su += G) {
                skinny_unit<false>(As, K, Wt + (size_t)su * 32 * K, nullptr, K, K, red, wid, lane, tid,
                    [&](int m, int n, float v0, float) { const size_t o = (size_t)m * D + su * 32 + n; const float v = bases[o] + v0; XS[o] = v; XSB[o] = f2bf(v);
                        float s = v * v; s += __shfl_xor(s, 1); s += __shfl_xor(s, 2); s += __shfl_xor(s, 4); s += __shfl_xor(s, 8); s += __shfl_xor(s, 16);
                        if (n == 0) ssqs_mid[m * 64 + su] = s; });
            }
            SEAM(pb + 4);
        }
        if (EN(7) && IN(pb + 4)) {
            PH_LOCALS
            const bf16_t* Wt = WGU_T + (size_t)L * GU * D;
            { pg8::Gemm g{XB, Wt, MP, GU, D}; pg8::StaticOrder S; S.init(MP, GU, G, bid);
              pg8::EpiSwiglu E{MID, ssq_mid};
              pg8::gemm_phase<pg8::EpiSwiglu, pg8::StaticOrder, true, true>(lds, g, S, E); }
            BUILD_RINVS(ssqs_mid);
            for (int su = bid; su < FF / 32; su += G) {
                const int t = su >> 2, s4 = su & 3;
                skinny_unit<true>(XSB, D, Wt + (size_t)(256 * t + 32 * s4) * D, Wt + (size_t)(256 * t + 128 + 32 * s4) * D, D, D, red, wid, lane, tid,
                    [&](int m, int n, float v0, float v1) { const float ri = RINVS[m]; const float gt = v0 * ri, up = v1 * ri;
                        MIDS[(size_t)m * FF + su * 32 + n] = f2bf(gt / (1.0f + expf(-gt)) * up); });
            }
            SEAM(pb + 5);
        }
        if (EN(8) && IN(pb + 5)) {
            PH_LOCALS
            const bf16_t* Wt = WDN_T + (size_t)L * D * FF;
            { pg8::Gemm g{MID, Wt, MP, D, FF}; pg8::StaticOrder S; S.init(MP, D, G, bid);
              pg8::EpiRes E{X, X, XB, ssq_out};
              pg8::gemm_phase<pg8::EpiRes, pg8::StaticOrder, true, true>(lds, g, S, E); }
            for (int su = bid; su < 64; su += G) {
                skinny_unit<false>(MIDS, FF, Wt + (size_t)su * 32 * FF, nullptr, FF, FF, red, wid, lane, tid,
                    [&](int m, int n, float v0, float) { const size_t o = (size_t)m * D + su * 32 + n; const float v = XS[o] + v0; XS[o] = v; XSB[o] = f2bf(v);
                        float s = v * v; s += __shfl_xor(s, 1); s += __shfl_xor(s, 2); s += __shfl_xor(s, 4); s += __shfl_xor(s, 8); s += __shfl_xor(s, 16);
                        if (n == 0) ssqs_out[m * 64 + su] = s; });
            }
            SEAM(L == 3 ? PH_FINAL : pb + 6);
        }
    }
    if (EN(9) && IN(PH_FINAL)) {
        PH_LOCALS
        const float* sq = ssq + (size_t)8 * MP * 32; const float* sqs = ssqs + 8 * SB * 64;
        for (int m = gw; m < MP + SB; m += NGW) {
            const bool sp = m >= MP; const int r = sp ? m - MP : m;
            const float ri = rinv_of(wave_sum(sp ? sqs[r * 64 + lane] : (lane < 32 ? sq[(size_t)r * 32 + lane] : 0.f)));
            const f32x4* xr = (const f32x4*)((sp ? XS : X) + (size_t)r * D) + lane; f32x4* yr = (f32x4*)(out + (sp ? O_YS : O_Y) + (size_t)r * D) + lane; const f32x4* gr = (const f32x4*)norm_final + lane;
#pragma unroll
            for (int q = 0; q < 8; ++q) yr[64 * q] = xr[64 * q] * ri * gr[64 * q];
        }
    }
#undef IN
#undef SEAM
}
#undef RINVS
#undef BUILD_RINVS
#undef x_prompt
#undef x_sample
#undef state_delta
#undef state_conv
#undef cache_k
#undef cache_v
#undef norm_mix
#undef norm_ffn
#undef w_in
#undef conv_w
#undef a_log
#undef dt_bias
#undef gnorm
#undef w_out
#undef norm_kv
#undef w_kv
#undef w_q
#undef w_o
#undef sinks
#undef rel_bias
#undef w_gu
#undef w_dn
#undef norm_final
#undef WIN_T
#undef WBA_T
#undef WOUT_T
#undef WGU_T
#undef WDN_T
#undef WQKV_T
#undef WQ1_T
#undef WO_T
#undef X
#undef XB
#undef PROJ
#undef BETA
#undef GG
#undef OG
#undef MID
#undef QB
#undef KB
#undef VT
#undef AO
#undef XS
#undef XSB
#undef PROJS
#undef QKVS
#undef BETAS
#undef GS
#undef OGS
#undef MIDS
#undef QS
#undef KVS
#undef AOS
#undef ssq_in
#undef ssqs_in
#undef ssq_mid
#undef ssqs_mid
#undef ssq_out
#undef ssqs_out
#undef PH_LOCALS
#undef KARG

#ifndef MK_PER_PHASE
#define MK_PER_PHASE 0
#endif
static int mk_grid = 0;
static bool mk_setup(int n_in, size_t ws_size) {
    if (mk_grid == 0) {
        if (n_in != 23 || ws_size < WS_END) { fprintf(stderr, "kernel_launch: unexpected inputs (%d) or workspace (%zu < %zu)\n", n_in, ws_size, (size_t)WS_END); mk_grid = -1; return false; }
        int dev = 0, cus = 0, per_cu = 0;
        if (hipGetDevice(&dev) != hipSuccess || hipDeviceGetAttribute(&cus, hipDeviceAttributeMultiprocessorCount, dev) != hipSuccess) { mk_grid = -1; return false; }
        if (hipFuncSetAttribute((const void*)mk_fwd, hipFuncAttributeMaxDynamicSharedMemorySize, LDS_BYTES) != hipSuccess) { fprintf(stderr, "kernel_launch: hipFuncSetAttribute failed\n"); mk_grid = -1; return false; }
        if (hipOccupancyMaxActiveBlocksPerMultiprocessor(&per_cu, (const void*)mk_fwd, NTHR, LDS_BYTES) != hipSuccess || per_cu < 1) { fprintf(stderr, "kernel_launch: occupancy query says %d\n", per_cu); }
        (void)hipGetLastError();
        mk_grid = cus;
    }
    return mk_grid > 0;
}
static void mk_run(void* const* d_in, void* d_out, void* d_ws, hipStream_t stream, int p_lo, int p_hi, bool per_phase) {
    (void)hipMemsetAsync((char*)d_ws + WS_CTL, 0, CTL_ZERO_BYTES, stream);
    Args a{};
    for (int i = 0; i < 23; ++i) a.in[i] = (const float*)d_in[i];
    a.out = (float*)d_out; a.ws = (unsigned char*)d_ws;
    if (per_phase) {
        int li = 0;
        for (int p = p_lo; p < p_hi; ++p) {
            if (p >= 14 && p <= 24 && ((p - 1) % 6) == 1) continue;
            a.ph_lo = p; a.ph_hi = p + 1; a.li = li++;
            hipLaunchKernelGGL(mk_fwd, dim3(mk_grid), dim3(NTHR), LDS_BYTES, stream, a);
        }
    } else {
        a.ph_lo = p_lo; a.ph_hi = p_hi; a.li = 0;
        hipLaunchKernelGGL(mk_fwd, dim3(mk_grid), dim3(NTHR), LDS_BYTES, stream, a);
    }
}
#ifndef MK_NO_ENTRY
extern "C" void kernel_launch(void* const* d_in, const int* in_sizes, int n_in, void* d_out, int out_size, void* d_ws, size_t ws_size, hipStream_t stream) {
    if (!mk_setup(n_in, ws_size)) return;
    mk_run(d_in, d_out, d_ws, stream, 0, N_PHASES, MK_PER_PHASE != 0);
}
#endif
```

```cpp
#include <hip/hip_runtime.h>
#include <cstdio>
#include <cstdint>
#include <cmath>
namespace pg8 {
#define PG8_LAS __attribute__((address_space(3)))
typedef unsigned short bf16_t;
typedef short bf16x8 __attribute__((ext_vector_type(8)));
typedef float f32x4 __attribute__((ext_vector_type(4)));
typedef unsigned u32x4 __attribute__((ext_vector_type(4)));
constexpr int BM = 256, BK = 64, HALF = 128, HTB = HALF * BK * 2  , STAGE_BYTES = 8 * HTB, NXCD = 8, WGM = 8;

__host__ __device__ __forceinline__ int lds_byte(int r, int c) { const int st = (r >> 4) * 2 + (c >> 5), rr = r & 15, cc = c & 31, ob = rr * 64 + cc * 2; return st * 1024 + (ob ^ (((ob >> 9) & 1) << 5)); }
__host__ __device__ __forceinline__ void stage_rc(int b, int& R, int& C) { const int st = b / 1024, sb = b % 1024, swz = sb ^ (((sb >> 9) & 1) << 5); R = (st >> 1) * 16 + swz / 64; C = (st & 1) * 32 + (swz % 64) / 2; }
__host__ __device__ __forceinline__ int perm32(int rho) { const int n = rho >> 4, i = rho & 15; return 8 * (i >> 2) + 4 * n + (i & 3); }

struct Unit { int pm, pn; };
struct Gemm { const bf16_t* A; const bf16_t* Bt; int M, N, K; };

struct StaticOrder {
    int nM, nN, nwg, G, c;
    __host__ __device__ void init(int M, int N, int G_, int c_) { nM = M / BM; nN = N / BM; nwg = nM * nN; G = G_; c = c_; }
    __host__ __device__ bool next(int i, Unit& u) const {
        const long L = (long)i * G + c; if (L >= nwg) return false;
        int wgid = (int)L; { const int q = nwg / NXCD, r = nwg % NXCD, xcd = wgid % NXCD, off = wgid / NXCD; wgid = (xcd < r ? xcd * (q + 1) : r * (q + 1) + (xcd - r) * q) + off; }
        const int nig = WGM * nN, gid = wgid / nig, fm = gid * WGM, gsz = (nM - fm) < WGM ? (nM - fm) : WGM;
        u.pm = fm + ((wgid % nig) % gsz); u.pn = (wgid % nig) / gsz; return true;
    }
    __device__ __forceinline__ void a_ready(const Unit&) const {}
    __device__ __forceinline__ void done(const Unit&) const {}
};

__device__ __forceinline__ unsigned cvt_pk_bf16(float lo, float hi) { unsigned r; asm volatile("v_cvt_pk_bf16_f32 %0, %1, %2" : "=v"(r) : "v"(lo), "v"(hi)); return r; }
typedef float f32x2 __attribute__((ext_vector_type(2)));
template <class Epi, class Sched, bool ALIGN_EPI = false, bool SP2 = false>
__device__ __forceinline__ void gemm_phase(PG8_LAS unsigned char* lds, const Gemm g, const Sched& S, const Epi& E) {
    int tid = threadIdx.x; asm volatile("" : "+v"(tid));
    const int wid = __builtin_amdgcn_readfirstlane(tid >> 6), lane = tid & 63, wr = wid >> 2, wc = wid & 3, fr = lane & 15, fq = lane >> 4;
    const int K = g.K, nt = K / BK;
    unsigned voffA[2], voffB[2];
#pragma unroll
    for (int i = 0; i < 2; ++i) { int R, C; stage_rc(tid * 16 + i * 8192, R, C); const int Rb = Epi::PERM ? ((R & ~31) + perm32(R & 31)) : R;
        voffA[i] = (unsigned)(R * K + C) * 2u; voffB[i] = (unsigned)(Rb * K + C) * 2u; }
    const size_t kstep = (size_t)(BK * 2);
    const size_t hstep = (size_t)HALF * K * 2;
    const size_t tstep = 2 * hstep;
    const unsigned ldsw = (unsigned)wid * 1024u;
    const int aoff = lds_byte(wr * 64 + fr, fq * 8), boff = lds_byte(wc * 32 + fr, fq * 8);
#define PG8_SA(b, h) (((b) * 2 + (h)) * HTB)
#define PG8_SB(b, h) ((4 + (b) * 2 + (h)) * HTB)
#define PG8_STAGE(bufoff, gbase, voff) do { _Pragma("unroll") for (int _i = 0; _i < 2; ++_i) \
        __builtin_amdgcn_global_load_lds((const unsigned*)((const char*)(gbase) + (voff)[_i]), (PG8_LAS unsigned*)(lds + (bufoff) + ldsw + _i * 8192), 16, 0, 0); } while (0)
#define PG8_LDA(dst, b, h) do { _Pragma("unroll") for (int m = 0; m < 4; ++m) _Pragma("unroll") for (int k = 0; k < 2; ++k) dst[m][k] = *(const PG8_LAS bf16x8*)(lds + PG8_SA(b, h) + aoff + m * 2048 + k * 1024); } while (0)
#define PG8_LDB(dst, b, h) do { _Pragma("unroll") for (int n = 0; n < 2; ++n) _Pragma("unroll") for (int k = 0; k < 2; ++k) dst[n][k] = *(const PG8_LAS bf16x8*)(lds + PG8_SB(b, h) + boff + n * 2048 + k * 1024); } while (0)
#define PG8_MMA(ai, bj, At, Bt) do { __builtin_amdgcn_s_setprio(1); _Pragma("unroll") for (int m = 0; m < 4; ++m) _Pragma("unroll") for (int n = 0; n < 2; ++n) _Pragma("unroll") for (int k = 0; k < 2; ++k) \
        acc[ai][bj][m][n] = __builtin_amdgcn_mfma_f32_16x16x32_bf16(Bt[n][k], At[m][k], acc[ai][bj][m][n], 0, 0, 0); __builtin_amdgcn_s_setprio(0); } while (0)
#define PG8_WAIT_V(n) asm volatile("s_waitcnt vmcnt(" #n ")" ::: "memory")
#define PG8_WAIT_L(n) asm volatile("s_waitcnt lgkmcnt(" #n ")" ::: "memory")
#define PG8_BAR __builtin_amdgcn_s_barrier()
#define PG8_SCHED __builtin_amdgcn_sched_barrier(0)
    Unit cur, nxt; int ui = 0;
    if (!S.next(0, cur)) return;
    f32x4 acc[2][2][4][2];
#pragma unroll
    for (int a = 0; a < 2; ++a)
#pragma unroll
        for (int b = 0; b < 2; ++b)
#pragma unroll
            for (int m = 0; m < 4; ++m)
#pragma unroll
                for (int n = 0; n < 2; ++n) acc[a][b][m][n] = (f32x4){0.f, 0.f, 0.f, 0.f};
    bf16x8 At[4][2], B0[2][2], B1[2][2];
    const char* cA = (const char*)g.A + (size_t)cur.pm * tstep; const char* cB = (const char*)g.Bt + (size_t)cur.pn * tstep;
    S.a_ready(cur);
    if constexpr (SP2) {
        PG8_STAGE(PG8_SB(0, 0), cB, voffB); PG8_STAGE(PG8_SB(0, 1), cB + hstep, voffB); PG8_STAGE(PG8_SA(0, 0), cA, voffA); PG8_STAGE(PG8_SA(0, 1), cA + hstep, voffA);
        if (wr == 1) PG8_BAR;
        PG8_WAIT_V(2); PG8_BAR;
        PG8_STAGE(PG8_SB(1, 0), cB + kstep, voffB); PG8_STAGE(PG8_SA(1, 0), cA + kstep, voffA); PG8_STAGE(PG8_SB(1, 1), cB + hstep + kstep, voffB);
        PG8_WAIT_V(6); PG8_BAR;
    } else {
        PG8_STAGE(PG8_SB(0, 0), cB, voffB); PG8_STAGE(PG8_SA(0, 0), cA, voffA); PG8_STAGE(PG8_SB(0, 1), cB + hstep, voffB); PG8_STAGE(PG8_SA(0, 1), cA + hstep, voffA);
        if (wr == 1) PG8_BAR;
        PG8_WAIT_V(4); PG8_BAR;
        PG8_STAGE(PG8_SB(1, 0), cB + kstep, voffB); PG8_STAGE(PG8_SA(1, 0), cA + kstep, voffA); PG8_STAGE(PG8_SB(1, 1), cB + hstep + kstep, voffB);
        PG8_WAIT_V(6); PG8_BAR;
    }
    for (;;) {
        const bool has_next = S.next(ui + 1, nxt);
        const char* nA = has_next ? (const char*)g.A + (size_t)nxt.pm * tstep : cA; const char* nB = has_next ? (const char*)g.Bt + (size_t)nxt.pn * tstep : cB;
        for (int t = 0; t < nt; t += 2) {
            const bool last = (t == nt - 2);
            const char* a1 = cA + (size_t)(t + 1) * kstep;
            const char* a2 = last ? nA : cA + (size_t)(t + 2) * kstep; const char* b2 = last ? nB : cB + (size_t)(t + 2) * kstep;
            const char* a3 = a2 + kstep; const char* b3 = b2 + kstep;
            if (last && has_next) S.a_ready(nxt);
            if constexpr (SP2) {
            PG8_LDB(B0, 0, 0); PG8_LDB(B1, 0, 1); PG8_SCHED; PG8_LDA(At, 0, 0); PG8_STAGE(PG8_SA(1, 1), a1 + hstep, voffA);
            PG8_WAIT_V(8); PG8_WAIT_L(0); PG8_BAR; PG8_MMA(0, 0, At, B0); PG8_MMA(0, 1, At, B1); PG8_BAR; PG8_SCHED;
            PG8_LDA(At, 0, 1); PG8_STAGE(PG8_SB(0, 0), b2, voffB); PG8_STAGE(PG8_SB(0, 1), b2 + hstep, voffB); PG8_STAGE(PG8_SA(0, 0), a2, voffA);
            PG8_WAIT_V(8); PG8_WAIT_L(0); PG8_BAR; PG8_MMA(1, 0, At, B0); PG8_MMA(1, 1, At, B1); PG8_BAR; PG8_SCHED;
            PG8_LDB(B0, 1, 0); PG8_LDB(B1, 1, 1); PG8_SCHED; PG8_LDA(At, 1, 0); PG8_STAGE(PG8_SA(0, 1), a2 + hstep, voffA);
            PG8_WAIT_V(8); PG8_WAIT_L(0); PG8_BAR; PG8_MMA(0, 0, At, B0); PG8_MMA(0, 1, At, B1); PG8_BAR; PG8_SCHED;
            PG8_LDA(At, 1, 1); PG8_STAGE(PG8_SB(1, 0), b3, voffB); PG8_STAGE(PG8_SB(1, 1), b3 + hstep, voffB); PG8_STAGE(PG8_SA(1, 0), a3, voffA);
            PG8_WAIT_V(8); PG8_WAIT_L(0); PG8_BAR; PG8_MMA(1, 0, At, B0); PG8_MMA(1, 1, At, B1); PG8_BAR; PG8_SCHED;
            } else {
            PG8_LDB(B0, 0, 0); PG8_SCHED; PG8_LDA(At, 0, 0); PG8_STAGE(PG8_SA(1, 1), a1 + hstep, voffA);
            PG8_WAIT_L(8); PG8_BAR; PG8_WAIT_L(0); PG8_MMA(0, 0, At, B0); PG8_BAR; PG8_SCHED;
            PG8_LDB(B1, 0, 1); PG8_STAGE(PG8_SB(0, 0), b2, voffB);
            PG8_BAR; PG8_WAIT_L(0); PG8_MMA(0, 1, At, B1); PG8_BAR;
            PG8_LDA(At, 0, 1); PG8_STAGE(PG8_SA(0, 0), a2, voffA);
            PG8_BAR; PG8_WAIT_L(0); PG8_MMA(1, 0, At, B0); PG8_BAR; PG8_SCHED;
            PG8_STAGE(PG8_SB(0, 1), b2 + hstep, voffB);
            PG8_WAIT_V(6); PG8_BAR; PG8_MMA(1, 1, At, B1); PG8_BAR;
            PG8_LDB(B0, 1, 0); PG8_SCHED; PG8_LDA(At, 1, 0); PG8_STAGE(PG8_SA(0, 1), a2 + hstep, voffA);
            PG8_WAIT_L(8); PG8_BAR; PG8_WAIT_L(0); PG8_MMA(0, 0, At, B0); PG8_BAR; PG8_SCHED;
            PG8_LDB(B1, 1, 1); PG8_STAGE(PG8_SB(1, 0), b3, voffB);
            PG8_BAR; PG8_WAIT_L(0); PG8_MMA(0, 1, At, B1); PG8_BAR;
            PG8_LDA(At, 1, 1); PG8_STAGE(PG8_SA(1, 0), a3, voffA);
            PG8_BAR; PG8_WAIT_L(0); PG8_MMA(1, 0, At, B0); PG8_BAR; PG8_SCHED;
            PG8_STAGE(PG8_SB(1, 1), b3 + hstep, voffB);
            PG8_WAIT_V(6); PG8_BAR; PG8_MMA(1, 1, At, B1); PG8_BAR;
            }
        }
        if constexpr (ALIGN_EPI) { if (wr == 0) PG8_BAR; }
        if constexpr (!Epi::AFTER_DRAIN) { E(acc, cur, wr, wc, fr, fq); S.done(cur); }
        if (!has_next) break;
#pragma unroll
        for (int a = 0; a < 2; ++a)
#pragma unroll
            for (int b = 0; b < 2; ++b)
#pragma unroll
                for (int m = 0; m < 4; ++m)
#pragma unroll
                    for (int n = 0; n < 2; ++n) acc[a][b][m][n] = (f32x4){0.f, 0.f, 0.f, 0.f};
        cur = nxt; cA = nA; cB = nB; ++ui;
        if constexpr (ALIGN_EPI) { if (wr == 1) PG8_BAR; }
    }
    PG8_WAIT_V(0);
    if constexpr (!ALIGN_EPI) { if (wr == 0) PG8_BAR; }
    PG8_BAR;
    if constexpr (Epi::AFTER_DRAIN) { E.fused(acc, cur, wr, wc, fr, fq, lds, wid, lane); S.done(cur); }
#undef PG8_SA
#undef PG8_SB
#undef PG8_STAGE
#undef PG8_LDA
#undef PG8_LDB
#undef PG8_MMA
#undef PG8_WAIT_V
#undef PG8_WAIT_L
#undef PG8_BAR
#undef PG8_SCHED
}
}

constexpr int D = 2048, BATCH = 4, SEQ = 2048, MP = BATCH * SEQ, SB = 32;
constexpr int INW = 12288, INDIM = 12352, CONVD = 8192, VALD = 4096, FF = 5632, GU = 2 * FF;
constexpr int NCH = 32;
constexpr float EPS = 1e-6f;
constexpr float LOG2E = 1.4426950408889634f;
constexpr float QSCALE = 0.125f * LOG2E;
constexpr int NWAVES = 8, NTHR = 512;

constexpr size_t MiB = 1u << 20;
constexpr size_t WS_CTL = 0, CTL_ZERO_BYTES = 4 * MiB;
constexpr size_t WS_WIN = 4 * MiB;
constexpr size_t WS_WBA = 100 * MiB;
constexpr size_t WS_WOUT = 101 * MiB;
constexpr size_t WS_WGU = 133 * MiB;
constexpr size_t WS_WDN = 309 * MiB;
constexpr size_t WS_WQKV = 397 * MiB;
constexpr size_t WS_WQ1 = 407 * MiB;
constexpr size_t WS_WO = 415 * MiB;
constexpr size_t WS_X = 431 * MiB;
constexpr size_t WS_XB = 495 * MiB;
constexpr size_t WS_PROJ = 527 * MiB;
constexpr size_t WS_BETA = 719 * MiB;
constexpr size_t WS_G = 720 * MiB;
constexpr size_t WS_PREPA = 721 * MiB;
constexpr size_t WS_PREPU = 945 * MiB;
constexpr size_t WS_EGL = 1009 * MiB;
constexpr size_t WS_OG = 1010 * MiB;
constexpr size_t WS_MID = 1074 * MiB;
constexpr size_t WS_Q = 1162 * MiB;
constexpr size_t WS_K = 1194 * MiB;
constexpr size_t WS_VT = 1198 * MiB;
constexpr size_t WS_AO = 1202 * MiB;
constexpr size_t WS_SMP = 1234 * MiB;
constexpr size_t WS_SSQP = 1242 * MiB;
constexpr size_t WS_SSQSP = 1251 * MiB;
constexpr size_t WS_END = 1252 * MiB;
constexpr size_t SM_XS = 0;
constexpr size_t SM_XSB = 262144;
constexpr size_t SM_PROJS = 393216;
constexpr size_t SM_QKVS = 2 * MiB;
constexpr size_t SM_BETAS = 3 * MiB;
constexpr size_t SM_GS = 3 * MiB + 4096;
constexpr size_t SM_OGS = 3 * MiB + 8192;
constexpr size_t SM_MIDS = 4 * MiB;
constexpr size_t SM_QS = 5 * MiB;
constexpr size_t SM_KVS = 5 * MiB + 262144;
constexpr size_t SM_AOS = 6 * MiB;
constexpr int CW_BAR = 4096;
constexpr int CW_SSQ = 16384;
constexpr int CW_SSQS = 16384 + 9 * 8192;
constexpr int PREPA_REC = 57344, PREPU_REC = 16384;

constexpr int LDS_BYTES = 147456, MISC_OFF = LDS_BYTES - 256;

#define GAS __attribute__((address_space(1)))
#define LAS __attribute__((address_space(3)))
typedef unsigned short bf16_t;
typedef unsigned u32x4 __attribute__((ext_vector_type(4)));
typedef unsigned u32x2 __attribute__((ext_vector_type(2)));
typedef float f32x4 __attribute__((ext_vector_type(4)));
typedef float f32x16 __attribute__((ext_vector_type(16)));
typedef short bf16x8 __attribute__((ext_vector_type(8)));
typedef short bf16x4 __attribute__((ext_vector_type(4)));
#define LDS_WAIT() asm volatile("s_waitcnt lgkmcnt(0)" ::: "memory")
#define VM_WAIT() asm volatile("s_waitcnt vmcnt(0)" ::: "memory")
#define MFMA16(a, b, c) __builtin_amdgcn_mfma_f32_16x16x32_bf16((a), (b), (c), 0, 0, 0)
#define MFMA32(a, b, c) __builtin_amdgcn_mfma_f32_32x32x16_bf16((a), (b), (c), 0, 0, 0)

__device__ __forceinline__ float bf2f(bf16_t v) { return __uint_as_float((unsigned)v << 16); }
typedef float f32x2_t __attribute__((ext_vector_type(2))); typedef __bf16 bf16x2_t __attribute__((ext_vector_type(2)));
__device__ __forceinline__ unsigned pk2(float lo, float hi) { const f32x2_t v = {lo, hi}; const bf16x2_t b = __builtin_convertvector(v, bf16x2_t); return __builtin_bit_cast(unsigned, b); }
__device__ __forceinline__ bf16_t f2bf(float f) { return (bf16_t)(pk2(f, 0.f) & 0xffffu); }
__device__ __forceinline__ float fast_exp2(float x) { return __builtin_amdgcn_exp2f(x); }
__device__ __forceinline__ float fast_exp(float x) { return __builtin_amdgcn_exp2f(x * LOG2E); }
__device__ __forceinline__ float fast_rcp(float x) { return __builtin_amdgcn_rcpf(x); }
__device__ __forceinline__ float silu_f(float x) { return x * fast_rcp(1.0f + fast_exp(-x)); }
__device__ __forceinline__ float rinv_of(float ssq) { return 1.0f / sqrtf(ssq * (1.0f / D) + EPS); }
__device__ __forceinline__ float wave_sum(float v) {
#pragma unroll
    for (int o = 1; o < 64; o <<= 1) v += __shfl_xor(v, o);
    return v;
}
__device__ __forceinline__ float rinv_row4(const float* ssqp, int row, int fq) {
    const f32x4* p = (const f32x4*)(ssqp + (size_t)row * 32 + 8 * fq); const f32x4 a = p[0], b = p[1];
    float s = ((a[0] + a[1]) + (a[2] + a[3])) + ((b[0] + b[1]) + (b[2] + b[3]));
    s += __shfl_xor(s, 16); s += __shfl_xor(s, 32);
    return rinv_of(s);
}
__device__ __forceinline__ float rinv_row_full(const float* ssqp, int row) {
    const f32x4* p = (const f32x4*)(ssqp + (size_t)row * 32); float s = 0.f;
#pragma unroll
    for (int i = 0; i < 8; ++i) { const f32x4 a = p[i]; s += (a[0] + a[1]) + (a[2] + a[3]); }
    return rinv_of(s);
}
__device__ __forceinline__ int crow32(int r, int hi) { return (r & 3) + 8 * (r >> 2) + 4 * hi; }

namespace pg8 {
struct EpiProj {
    static constexpr bool PERM = true, AFTER_DRAIN = false;
    bf16_t* O; int ldc; const float* ssq; int silu_from;
    __device__ __forceinline__ void operator()(const f32x4 (&acc)[2][2][4][2], const Unit& u, int wr, int wc, int fr, int fq) const {
        asm volatile("" : "+v"(fr), "+v"(fq));
        const int row0 = u.pm * BM + wr * 64 + fr, col0 = u.pn * BM + wc * 32 + 8 * fq;
#pragma unroll
        for (int ai = 0; ai < 2; ++ai)
#pragma unroll
            for (int m = 0; m < 4; ++m) { const int row = row0 + ai * HALF + m * 16; const float ri = rinv_row4(ssq, row, fq); bf16_t* rowp = O + (size_t)row * ldc + col0;
#pragma unroll
                for (int bj = 0; bj < 2; ++bj) { f32x4 v0 = acc[ai][bj][m][0] * ri, v1 = acc[ai][bj][m][1] * ri;
                    if (u.pn >= silu_from) {
#pragma unroll
                        for (int e = 0; e < 4; ++e) { v0[e] = silu_f(v0[e]); v1[e] = silu_f(v1[e]); } }
                    u32x4 w; w.x = cvt_pk_bf16(v0[0], v0[1]); w.y = cvt_pk_bf16(v0[2], v0[3]); w.z = cvt_pk_bf16(v1[0], v1[1]); w.w = cvt_pk_bf16(v1[2], v1[3]);
                    *(u32x4*)(rowp + bj * HALF) = w; } }
    }
};
struct EpiRes {
    static constexpr bool PERM = true, AFTER_DRAIN = false;
    const float* base; float* X; bf16_t* XB; float* ssq;
    __device__ __forceinline__ void operator()(const f32x4 (&acc)[2][2][4][2], const Unit& u, int wr, int wc, int fr, int fq) const {
        asm volatile("" : "+v"(fr), "+v"(fq));
        const int row0 = u.pm * BM + wr * 64 + fr, col0 = u.pn * BM + wc * 32 + 8 * fq;
#pragma unroll
        for (int ai = 0; ai < 2; ++ai)
#pragma unroll
            for (int m = 0; m < 4; ++m) { const int row = row0 + ai * HALF + m * 16; const size_t off = (size_t)row * D + col0; float s = 0.f;
#pragma unroll
                for (int bj = 0; bj < 2; ++bj) { const f32x4 b0 = *(const f32x4*)(base + off + bj * HALF), b1 = *(const f32x4*)(base + off + bj * HALF + 4);
                    const f32x4 v0 = acc[ai][bj][m][0] + b0, v1 = acc[ai][bj][m][1] + b1;
                    *(f32x4*)(X + off + bj * HALF) = v0; *(f32x4*)(X + off + bj * HALF + 4) = v1;
                    u32x4 w; w.x = cvt_pk_bf16(v0[0], v0[1]); w.y = cvt_pk_bf16(v0[2], v0[3]); w.z = cvt_pk_bf16(v1[0], v1[1]); w.w = cvt_pk_bf16(v1[2], v1[3]);
                    *(u32x4*)(XB + off + bj * HALF) = w;
                    s += (v0[0] * v0[0] + v0[1] * v0[1]) + (v0[2] * v0[2] + v0[3] * v0[3]) + (v1[0] * v1[0] + v1[1] * v1[1]) + (v1[2] * v1[2] + v1[3] * v1[3]); }
                s += __shfl_xor(s, 16); s += __shfl_xor(s, 32);
                if (fq == 0) ssq[(size_t)row * 32 + u.pn * 4 + wc] = s; }
    }
};
struct EpiSwiglu {
    static constexpr bool PERM = true, AFTER_DRAIN = false;
    bf16_t* O; const float* ssq;
    __device__ __forceinline__ void operator()(const f32x4 (&acc)[2][2][4][2], const Unit& u, int wr, int wc, int fr, int fq) const {
        asm volatile("" : "+v"(fr), "+v"(fq));
        const int row0 = u.pm * BM + wr * 64 + fr, col0 = u.pn * HALF + wc * 32 + 8 * fq;
#pragma unroll
        for (int ai = 0; ai < 2; ++ai)
#pragma unroll
            for (int m = 0; m < 4; ++m) { const int row = row0 + ai * HALF + m * 16; const float ri = rinv_row4(ssq, row, fq); float o[8];
#pragma unroll
                for (int n = 0; n < 2; ++n)
#pragma unroll
                    for (int e = 0; e < 4; ++e) { const float g = acc[ai][0][m][n][e] * ri, up = acc[ai][1][m][n][e] * ri; o[4 * n + e] = silu_f(g) * up; }
                u32x4 w; w.x = cvt_pk_bf16(o[0], o[1]); w.y = cvt_pk_bf16(o[2], o[3]); w.z = cvt_pk_bf16(o[4], o[5]); w.w = cvt_pk_bf16(o[6], o[7]);
                *(u32x4*)(O + (size_t)row * FF + col0) = w; }
    }
};
struct EpiQKV {
    static constexpr bool PERM = true, AFTER_DRAIN = false;
    bf16_t* Q; bf16_t* KB; bf16_t* VT; float* kwin; float* vwin; const float* ssq;
    __device__ __forceinline__ void operator()(const f32x4 (&acc)[2][2][4][2], const Unit& u, int wr, int wc, int fr, int fq) const {
        asm volatile("" : "+v"(fr), "+v"(fq));
        const int row0 = u.pm * BM + wr * 64 + fr, cl0 = wc * 32 + 8 * fq;
#pragma unroll
        for (int ai = 0; ai < 2; ++ai)
#pragma unroll
            for (int m = 0; m < 4; ++m) { const int row = row0 + ai * HALF + m * 16; const float ri = rinv_row4(ssq, row, fq); const int b = row >> 11, t = row & 2047;
#pragma unroll
                for (int bj = 0; bj < 2; ++bj) { const f32x4 v0 = acc[ai][bj][m][0] * ri, v1 = acc[ai][bj][m][1] * ri; const int cl = cl0 + bj * HALF;
                    if (u.pn < 8) {
                        u32x4 w; w.x = cvt_pk_bf16(v0[0], v0[1]); w.y = cvt_pk_bf16(v0[2], v0[3]); w.z = cvt_pk_bf16(v1[0], v1[1]); w.w = cvt_pk_bf16(v1[2], v1[3]);
                        *(u32x4*)(Q + (size_t)row * D + u.pn * BM + cl) = w;
                    } else if (u.pn == 8) {
                        u32x4 w; w.x = cvt_pk_bf16(v0[0], v0[1]); w.y = cvt_pk_bf16(v0[2], v0[3]); w.z = cvt_pk_bf16(v1[0], v1[1]); w.w = cvt_pk_bf16(v1[2], v1[3]);
                        *(u32x4*)(KB + (size_t)row * 256 + cl) = w;
                        if (t >= SEQ - 128) { float* o = kwin + ((size_t)(b * 128 + t - (SEQ - 128))) * 256 + cl; *(f32x4*)o = v0; *(f32x4*)(o + 4) = v1; }
                    } else {
                        const float vv[8] = {v0[0], v0[1], v0[2], v0[3], v1[0], v1[1], v1[2], v1[3]};
#pragma unroll
                        for (int e = 0; e < 8; ++e) { const int c = cl + e; VT[((size_t)(b * 4 + (c >> 6)) * 64 + (c & 63)) * SEQ + t] = (bf16_t)(cvt_pk_bf16(vv[e], 0.f) & 0xffffu); }
                        if (t >= SEQ - 128) { float* o = vwin + ((size_t)(b * 128 + t - (SEQ - 128))) * 256 + cl; *(f32x4*)o = v0; *(f32x4*)(o + 4) = v1; }
                    } } }
    }
};
}

__device__ __forceinline__ void tr_item(const float* __restrict__ src, int ld, int col0, int K, int k0, bf16_t* __restrict__ dst, int drow0,
                                        const float* __restrict__ gain, float scale, LAS float* scr, int lane) {
#pragma unroll 4
    for (int i = 0; i < 16; ++i) {
        const int kk = 4 * i + (lane >> 4);
        const f32x4 v = *(const f32x4*)(src + (size_t)(k0 + kk) * ld + col0 + 4 * (lane & 15));
        const float g = gain ? gain[k0 + kk] * scale : scale;
        LAS float* p = scr + kk * 65 + 4 * (lane & 15);
        p[0] = v[0] * g; p[1] = v[1] * g; p[2] = v[2] * g; p[3] = v[3] * g;
    }
    LDS_WAIT();
#pragma unroll
    for (int j = 0; j < 8; ++j) {
        const int idx = j * 64 + lane, n = idx >> 3, kc = idx & 7;
        const LAS float* s = scr + (8 * kc) * 65 + n;
        u32x4 o; o.x = pk2(s[0], s[65]); o.y = pk2(s[2 * 65], s[3 * 65]); o.z = pk2(s[4 * 65], s[5 * 65]); o.w = pk2(s[6 * 65], s[7 * 65]);
        *(u32x4*)(dst + (size_t)(drow0 + n) * K + k0 + 8 * kc) = o;
    }
    LDS_WAIT();
}

__device__ __forceinline__ void row_to_bf16(const float* __restrict__ xrow, bf16_t* __restrict__ orow, float* ssq_out, int npart, int lane) {
    const f32x4* xr = (const f32x4*)xrow + lane;
    f32x4 v[8]; float s = 0.f;
#pragma unroll
    for (int j = 0; j < 8; ++j) { v[j] = xr[64 * j]; s += (v[j][0] * v[j][0] + v[j][1] * v[j][1]) + (v[j][2] * v[j][2] + v[j][3] * v[j][3]); }
    s = wave_sum(s);
    if (lane < npart) ssq_out[lane] = lane == 0 ? s : 0.f;
    u32x2* o8 = (u32x2*)orow + lane;
#pragma unroll
    for (int j = 0; j < 8; ++j) { u32x2 w; w.x = pk2(v[j][0], v[j][1]); w.y = pk2(v[j][2], v[j][3]); o8[64 * j] = w; }
}

template <bool PAIR, class F>
__device__ __forceinline__ void skinny_unit(const bf16_t* __restrict__ A, int lda, const bf16_t* __restrict__ B0, const bf16_t* __restrict__ B1, int ldb, int K,
                                            LAS float* red, int wid, int lane, int tid, F&& epi) {
    asm volatile("" : "+v"(tid), "+v"(lane));
    const int kw = K >> 3, kbeg = wid * kw;
    f32x16 acc0, acc1;
#pragma unroll
    for (int r = 0; r < 16; ++r) { acc0[r] = 0.f; acc1[r] = 0.f; }
    const bf16_t* ap = A + (size_t)(lane & 31) * lda + kbeg + 8 * (lane >> 5);
    const bf16_t* bp0 = B0 + (size_t)(lane & 31) * ldb + kbeg + 8 * (lane >> 5);
    const bf16_t* bp1 = (PAIR ? B1 : B0) + (size_t)(lane & 31) * ldb + kbeg + 8 * (lane >> 5);
#pragma unroll 4
    for (int k = 0; k < kw; k += 16) {
        const bf16x8 a = *(const bf16x8*)(ap + k);
        const bf16x8 b0 = *(const bf16x8*)(bp0 + k);
        acc0 = MFMA32(a, b0, acc0);
        if (PAIR) { const bf16x8 b1 = *(const bf16x8*)(bp1 + k); acc1 = MFMA32(a, b1, acc1); }
    }
#pragma unroll
    for (int r = 0; r < 16; ++r) { red[((wid * 2 + 0) * 16 + r) * 64 + lane] = acc0[r]; if (PAIR) red[((wid * 2 + 1) * 16 + r) * 64 + lane] = acc1[r]; }
    __syncthreads();
#pragma unroll
    for (int q = 0; q < 2; ++q) {
        const int e = tid + 512 * q, r = e >> 6, ln = e & 63;
        float v0 = 0.f, v1 = 0.f;
#pragma unroll
        for (int w = 0; w < 8; ++w) { v0 += red[((w * 2 + 0) * 16 + r) * 64 + ln]; if (PAIR) v1 += red[((w * 2 + 1) * 16 + r) * 64 + ln]; }
        epi(crow32(r, ln >> 5), ln & 31, v0, v1);
    }
    __syncthreads();
}

constexpr int PL_QN = 0, PL_KN = 18432, PL_KT = 36864, PL_VT = 55296, PL_AM = 92160, PL_TAB = 126976;
constexpr int PL_T = 0, PL_TP = 18432;
constexpr int NAT_LD = 136, TR_LD = 72, AM_LD = 68;


__host__ __device__ constexpr int ti_q(int idx) { int q = 0; while ((q + 1) * (q + 2) / 2 <= idx) ++q; return q; }
template <int IDX> __device__ __forceinline__ void ti_load(const LAS float* A, f32x4 (&buf)[4][4]) {
    constexpr int q = ti_q(IDX), g = IDX - q * (q + 1) / 2;
#pragma unroll
    for (int r = 0; r < 4; ++r) buf[IDX % 4][r] = *(const LAS f32x4*)(A + (4 * q + r) * AM_LD + 4 * g);
}
template <int IDX, int END> __device__ __forceinline__ void ti_prologue(const LAS float* A, f32x4 (&buf)[4][4]) {
    if constexpr (IDX < END) { ti_load<IDX>(A, buf); ti_prologue<IDX + 1, END>(A, buf); }
}
template <int IDX, int END, int DEPTH> __device__ __forceinline__ void ti_steps(const LAS float* A, f32x4 (&buf)[4][4], float (&t)[64], float (&acc)[4], int c) {
    if constexpr (IDX < END) {
        constexpr int q = ti_q(IDX), g = IDX - q * (q + 1) / 2;
        __builtin_amdgcn_sched_barrier(0);
        if constexpr (g == 0) {
#pragma unroll
            for (int r = 0; r < 4; ++r) acc[r] = (c == 4 * q + r) ? 1.f : 0.f;
        }
        if constexpr (g < q) {
#pragma unroll
            for (int r = 0; r < 4; ++r) { const f32x4 av = buf[IDX % 4][r]; acc[r] -= (av[0] * t[4 * g] + av[1] * t[4 * g + 1]) + (av[2] * t[4 * g + 2] + av[3] * t[4 * g + 3]); }
        } else {
            const f32x4 a1 = buf[IDX % 4][1], a2 = buf[IDX % 4][2], a3 = buf[IDX % 4][3];
            const float t0 = acc[0];
            const float t1 = acc[1] - a1[0] * t0;
            const float t2 = acc[2] - (a2[0] * t0 + a2[1] * t1);
            const float t3 = acc[3] - ((a3[0] * t0 + a3[1] * t1) + a3[2] * t2);
            t[4 * q] = t0; t[4 * q + 1] = t1; t[4 * q + 2] = t2; t[4 * q + 3] = t3;
        }
        __builtin_amdgcn_sched_barrier(0);
        if constexpr (IDX + DEPTH < END) ti_load<IDX + DEPTH>(A, buf);
        ti_steps<IDX + 1, END, DEPTH>(A, buf, t, acc, c);
    }
}

struct PrepArgs { const bf16_t* proj; const float* beta; const float* g; const float* convw; unsigned char* prepa; unsigned char* prepu; float* egl; float* conv_p; };

__device__ __forceinline__ void prep_unit(const PrepArgs& P, LAS unsigned char* lds, int b, int kh, int n, int tid, int wid, int lane) {
    asm volatile("" : "+v"(tid), "+v"(lane));
    LAS bf16_t* QN = (LAS bf16_t*)(lds + PL_QN); LAS bf16_t* KN = (LAS bf16_t*)(lds + PL_KN);
    LAS bf16_t* KT = (LAS bf16_t*)(lds + PL_KT); LAS bf16_t* VTt = (LAS bf16_t*)(lds + PL_VT);
    LAS float* AM = (LAS float*)(lds + PL_AM); LAS float* TAB = (LAS float*)(lds + PL_TAB);
    const int r0 = b * SEQ + n * 64;
    if (wid < 2) {
        const int hv = 2 * kh + wid;
        float gv = P.g[(size_t)(r0 + lane) * 32 + hv];
#pragma unroll
        for (int o = 1; o < 64; o <<= 1) { const float t = __shfl_up(gv, o); if (lane >= o) gv += t; }
        TAB[wid * 64 + lane] = gv;
        TAB[128 + wid * 64 + lane] = P.beta[(size_t)(r0 + lane) * 32 + hv];
    }
    __syncthreads();
    {
        const int t = tid;
        const int gcol = t < 128 ? kh * 128 + t : (t < 256 ? 2048 + kh * 128 + (t - 128) : 4096 + kh * 256 + (t - 256));
        const float c0 = P.convw[gcol], c1 = P.convw[CONVD + gcol], c2 = P.convw[2 * CONVD + gcol], c3 = P.convw[3 * CONVD + gcol];
        const bf16_t* pp = P.proj + (size_t)r0 * INW + gcol;
        float w0 = 0.f, w1 = 0.f, w2 = 0.f;
        if (n > 0) { w0 = bf2f(pp[-3 * (long)INW]); w1 = bf2f(pp[-2 * (long)INW]); w2 = bf2f(pp[-(long)INW]); }
        const int vh = (t - 256) >> 7;
        bf16_t rawb[64];
#pragma unroll
        for (int j = 0; j < 64; ++j) rawb[j] = pp[(size_t)j * INW];
#pragma unroll
        for (int jb = 0; jb < 8; ++jb) {
            float raw[8];
#pragma unroll
            for (int e = 0; e < 8; ++e) raw[e] = bf2f(rawb[jb * 8 + e]);
            float ov[8];
#pragma unroll
            for (int e = 0; e < 8; ++e) { const float cv = w0 * c0 + w1 * c1 + w2 * c2 + raw[e] * c3; ov[e] = silu_f(cv); w0 = w1; w1 = w2; w2 = raw[e]; }
            if (t < 256) {
                LAS bf16_t* nat = (t < 128 ? QN : KN) + (t & 127);
#pragma unroll
                for (int e = 0; e < 8; ++e) nat[(jb * 8 + e) * NAT_LD] = f2bf(ov[e]);
                if (t >= 128) { u32x4 w; w.x = pk2(ov[0], ov[1]); w.y = pk2(ov[2], ov[3]); w.z = pk2(ov[4], ov[5]); w.w = pk2(ov[6], ov[7]);
                    *(LAS u32x4*)(KT + (t - 128) * TR_LD + jb * 8) = w; }
            } else {
                const LAS float* bt = TAB + 128 + vh * 64 + jb * 8;
                u32x4 w; w.x = pk2(ov[0] * bt[0], ov[1] * bt[1]); w.y = pk2(ov[2] * bt[2], ov[3] * bt[3]); w.z = pk2(ov[4] * bt[4], ov[5] * bt[5]); w.w = pk2(ov[6] * bt[6], ov[7] * bt[7]);
                *(LAS u32x4*)(VTt + (t - 256) * TR_LD + jb * 8) = w;
            }
            if (n == NCH - 1 && jb == 7) {
#pragma unroll
                for (int e = 5; e < 8; ++e) P.conv_p[((size_t)b * 3 + (e - 5)) * CONVD + gcol] = raw[e];
            }
        }
    }
    __syncthreads();
    {
        const int arr = tid >> 8, row = (tid >> 2) & 63, part = tid & 3;
        const LAS bf16_t* p = (arr ? KN : QN) + row * NAT_LD + part * 32;
        float s = 0.f;
#pragma unroll
        for (int c = 0; c < 4; ++c) { const bf16x8 v = *(const LAS bf16x8*)(p + c * 8);
#pragma unroll
            for (int e = 0; e < 8; ++e) { const float f = bf2f((bf16_t)v[e]); s += f * f; } }
        s += __shfl_xor(s, 1); s += __shfl_xor(s, 2);
        if (part == 0) TAB[256 + arr * 64 + row] = 1.0f / sqrtf(s + EPS);
    }
    __syncthreads();
    const int m16 = lane & 15, q4 = lane >> 4;
    unsigned char* recA0 = P.prepa + (size_t)((b * 32 + 2 * kh) * NCH + n) * PREPA_REC;
    const size_t hstrideA = (size_t)NCH * PREPA_REC;
    {
        const int half = wid >> 2, it = wid & 3;
        f32x4 acc[4];
#pragma unroll
        for (int jt = 0; jt < 4; ++jt) acc[jt] = (f32x4){0.f, 0.f, 0.f, 0.f};
        if (half == 0) {
#pragma unroll
            for (int s = 0; s < 4; ++s) { const bf16x8 bq = *(const LAS bf16x8*)(QN + (16 * it + m16) * NAT_LD + 32 * s + 8 * q4);
#pragma unroll
                for (int jt = 0; jt < 4; ++jt) { const bf16x8 ak = *(const LAS bf16x8*)(KN + (16 * jt + m16) * NAT_LD + 32 * s + 8 * q4); acc[jt] = MFMA16(ak, bq, acc[jt]); } }
            const int i = 16 * it + m16; const float rqi = TAB[256 + i] * 0.08838834764831845f;
#pragma unroll
            for (int h = 0; h < 2; ++h) { const float gci = TAB[h * 64 + i];
#pragma unroll
                for (int s = 0; s < 2; ++s) { float o[8];
#pragma unroll
                    for (int e = 0; e < 8; ++e) { const int jt = 2 * s + (e >> 2), j = 16 * jt + 4 * q4 + (e & 3);
                        const float dec = fast_exp(gci - TAB[h * 64 + j]); o[e] = (i >= j) ? acc[jt][e & 3] * rqi * TAB[320 + j] * dec : 0.f; }
                    u32x4 w; w.x = pk2(o[0], o[1]); w.y = pk2(o[2], o[3]); w.z = pk2(o[4], o[5]); w.w = pk2(o[6], o[7]);
                    *(u32x4*)(recA0 + h * hstrideA + (48 + it * 2 + s) * 1024 + lane * 16) = w; } }
        } else {
#pragma unroll
            for (int s = 0; s < 4; ++s) { const bf16x8 ai = *(const LAS bf16x8*)(KN + (16 * it + m16) * NAT_LD + 32 * s + 8 * q4);
#pragma unroll
                for (int jt = 0; jt < 4; ++jt) { const bf16x8 bk = *(const LAS bf16x8*)(KN + (16 * jt + m16) * NAT_LD + 32 * s + 8 * q4); acc[jt] = MFMA16(ai, bk, acc[jt]); } }
#pragma unroll
            for (int jt = 0; jt < 4; ++jt) { const int j = 16 * jt + m16; const float rkj = TAB[320 + j];
#pragma unroll
                for (int e = 0; e < 4; ++e) { const int i = 16 * it + 4 * q4 + e; const float base = acc[jt][e] * rkj * TAB[320 + i];
#pragma unroll
                    for (int h = 0; h < 2; ++h) { const float dec = fast_exp(TAB[h * 64 + i] - TAB[h * 64 + j]);
                        AM[h * 64 * AM_LD + i * AM_LD + j] = (i > j) ? base * TAB[128 + h * 64 + i] * dec : 0.f; } } }
        }
        {
            const int h = wid >> 2, mt = wid & 3, i = 16 * mt + m16;
            const float sc = TAB[256 + i] * 0.08838834764831845f * fast_exp(TAB[h * 64 + i]);
#pragma unroll
            for (int s = 0; s < 4; ++s) {
                const bf16x4 lo = *(const LAS bf16x4*)(QN + i * NAT_LD + 32 * s + 4 * q4), hi = *(const LAS bf16x4*)(QN + i * NAT_LD + 32 * s + 16 + 4 * q4);
                u32x4 w; w.x = pk2(bf2f((bf16_t)lo[0]) * sc, bf2f((bf16_t)lo[1]) * sc); w.y = pk2(bf2f((bf16_t)lo[2]) * sc, bf2f((bf16_t)lo[3]) * sc);
                w.z = pk2(bf2f((bf16_t)hi[0]) * sc, bf2f((bf16_t)hi[1]) * sc); w.w = pk2(bf2f((bf16_t)hi[2]) * sc, bf2f((bf16_t)hi[3]) * sc);
                *(u32x4*)(recA0 + h * hstrideA + (16 + mt * 4 + s) * 1024 + lane * 16) = w;
            }
        }
    }
    __syncthreads();
    asm volatile("" : "+v"(lane));
    if (wid < 2) {
        const int h = wid, c = lane;
        const LAS float* A = AM + h * 64 * AM_LD;
        float t[64];
        constexpr int TIDEPTH = 4, NGRP = 136;
        f32x4 buf[TIDEPTH][4];
        ti_prologue<0, TIDEPTH>(A, buf);
        float acc[4];
        ti_steps<0, NGRP, TIDEPTH>(A, buf, t, acc, c);
        const float scc = -TAB[320 + c] * TAB[128 + h * 64 + c] * fast_exp(TAB[h * 64 + c]);
        LAS bf16_t* T = (LAS bf16_t*)(lds + PL_T + h * 9216); LAS bf16_t* TP = (LAS bf16_t*)(lds + PL_TP + h * 9216);
#pragma unroll
        for (int i = 0; i < 64; ++i) { T[i * TR_LD + c] = f2bf(t[i]); TP[i * TR_LD + c] = f2bf(t[i] * scc); }
    } else {
        for (int f = wid - 2; f < 32; f += 6) {
            const int h = f >> 4, mt = (f >> 1) & 7, s = f & 1, d = 16 * mt + m16;
            const float glast = TAB[h * 64 + 63];
            const bf16x4 lo = *(const LAS bf16x4*)(KT + d * TR_LD + 32 * s + 4 * q4), hi = *(const LAS bf16x4*)(KT + d * TR_LD + 32 * s + 16 + 4 * q4);
            float o[8];
#pragma unroll
            for (int e = 0; e < 8; ++e) { const int j = 32 * s + 16 * (e >> 2) + 4 * q4 + (e & 3);
                o[e] = bf2f((bf16_t)(e < 4 ? lo[e & 3] : hi[e & 3])) * TAB[320 + j] * fast_exp(glast - TAB[h * 64 + j]); }
            u32x4 w; w.x = pk2(o[0], o[1]); w.y = pk2(o[2], o[3]); w.z = pk2(o[4], o[5]); w.w = pk2(o[6], o[7]);
            *(u32x4*)(recA0 + h * hstrideA + (32 + mt * 2 + s) * 1024 + lane * 16) = w;
        }
    }
    __syncthreads();
    {
        asm volatile("" : "+v"(lane)); const int m16 = lane & 15, q4 = lane >> 4;
        const int h = wid >> 2, it = wid & 3;
        const LAS bf16_t* T = (const LAS bf16_t*)(lds + PL_T + h * 9216); const LAS bf16_t* TP = (const LAS bf16_t*)(lds + PL_TP + h * 9216);
        bf16x8 tp[2], tt[2];
#pragma unroll
        for (int s = 0; s < 2; ++s) { tp[s] = *(const LAS bf16x8*)(TP + (16 * it + m16) * TR_LD + 32 * s + 8 * q4); tt[s] = *(const LAS bf16x8*)(T + (16 * it + m16) * TR_LD + 32 * s + 8 * q4); }
        unsigned char* recA = recA0 + h * hstrideA;
#pragma unroll
        for (int sp = 0; sp < 4; ++sp) {
            f32x4 a0 = (f32x4){0.f, 0.f, 0.f, 0.f}, a1 = a0;
#pragma unroll
            for (int s = 0; s < 2; ++s) {
                const bf16x8 k0 = *(const LAS bf16x8*)(KT + (32 * sp + m16) * TR_LD + 32 * s + 8 * q4), k1 = *(const LAS bf16x8*)(KT + (32 * sp + 16 + m16) * TR_LD + 32 * s + 8 * q4);
                a0 = MFMA16(k0, tp[s], a0); a1 = MFMA16(k1, tp[s], a1);
            }
            u32x4 w; w.x = pk2(a0[0], a0[1]); w.y = pk2(a0[2], a0[3]); w.z = pk2(a1[0], a1[1]); w.w = pk2(a1[2], a1[3]);
            *(u32x4*)(recA + (it * 4 + sp) * 1024 + lane * 16) = w;
        }
        unsigned char* recU = P.prepu + (size_t)((b * 32 + 2 * kh + h) * NCH + n) * PREPU_REC;
#pragma unroll
        for (int et = 0; et < 8; ++et) {
            f32x4 a = (f32x4){0.f, 0.f, 0.f, 0.f};
#pragma unroll
            for (int s = 0; s < 2; ++s) { const bf16x8 bv = *(const LAS bf16x8*)(VTt + (h * 128 + 16 * et + m16) * TR_LD + 32 * s + 8 * q4); a = MFMA16(tt[s], bv, a); }
            u32x2 w; w.x = pk2(a[0], a[1]); w.y = pk2(a[2], a[3]);
            *(u32x2*)(recU + (et * 4 + it) * 512 + lane * 8) = w;
        }
        if (tid < 2) P.egl[(b * 32 + 2 * kh + tid) * NCH + n] = fast_exp(TAB[tid * 64 + 63]);
    }
    __syncthreads();
}

#define BAR_LDS() do { asm volatile("s_waitcnt lgkmcnt(0)" ::: "memory"); __builtin_amdgcn_s_barrier(); asm volatile("" ::: "memory"); } while (0)

__device__ __forceinline__ float row16_sum(float v) {
    v += __builtin_bit_cast(float, __builtin_amdgcn_update_dpp(0, __builtin_bit_cast(int, v), 0x128, 0xf, 0xf, false));
    v += __builtin_bit_cast(float, __builtin_amdgcn_update_dpp(0, __builtin_bit_cast(int, v), 0x124, 0xf, 0xf, false));
    v += __builtin_bit_cast(float, __builtin_amdgcn_update_dpp(0, __builtin_bit_cast(int, v), 0x122, 0xf, 0xf, false));
    v += __builtin_bit_cast(float, __builtin_amdgcn_update_dpp(0, __builtin_bit_cast(int, v), 0x121, 0xf, 0xf, false));
    return v;
}
#define SCHED_FENCE() __builtin_amdgcn_sched_barrier(0)
struct ScanArgs { const unsigned char* prepa; const unsigned char* prepu; const float* egl; const bf16_t* proj; const float* gnorm; bf16_t* og; float* delta_out; int xf; };

__device__ __forceinline__ void scan_unit(const ScanArgs& P, LAS unsigned char* lds, int b, int hv, int tid, int wid, int lane) {
    asm volatile("" : "+v"(tid), "+v"(lane));
    const int m16 = lane & 15, q4 = lane >> 4;
    const unsigned char* recA = P.prepa + (size_t)((b * 32 + hv) * NCH) * PREPA_REC;
    const unsigned char* recU = P.prepu + (size_t)((b * 32 + hv) * NCH) * PREPU_REC;
    const float* eglp = P.egl + (b * 32 + hv) * NCH;
    LAS float* part = (LAS float*)(lds + 114688);
    LAS bf16_t* ogb = (LAS bf16_t*)(lds + 116736);
    constexpr int OG_LD = 136;
    const float gn = P.gnorm[16 * wid + m16];
    const bf16_t* zrow = P.proj + (size_t)(b * SEQ) * INW + 8192 + hv * 128;
    bf16_t* ogrow = P.og + (size_t)(b * SEQ) * VALD + hv * 128;
    f32x4 S[8];
#pragma unroll
    for (int dt = 0; dt < 8; ++dt) S[dt] = (f32x4){0.f, 0.f, 0.f, 0.f};
#define SCAN_DMA(n_, stage_) do { _Pragma("unroll") for (int k_ = 0; k_ < 7; ++k_) \
        __builtin_amdgcn_global_load_lds((const unsigned*)(recA + (size_t)(n_) * PREPA_REC + (k_ * 8 + wid) * 1024 + lane * 16), \
                                         (LAS unsigned*)(lds + (stage_) * PREPA_REC + (k_ * 8 + wid) * 1024), 16, 0, 0); } while (0)
#define SCAN_OGFLUSH(n_) do { _Pragma("unroll") for (int k_ = 0; k_ < 2; ++k_) { const int p_ = tid + 512 * k_, r_ = p_ >> 4, c_ = (p_ & 15) * 8; \
        const u32x4 v_ = *(const LAS u32x4*)(ogb + r_ * OG_LD + c_); u32x4 w_; \
        _Pragma("unroll") for (int e_ = 0; e_ < 4; ++e_) { const unsigned a_ = v_[e_], z_ = zq[k_][e_]; \
            w_[e_] = pk2(__uint_as_float(a_ << 16) * __uint_as_float(z_ << 16), __uint_as_float(a_ & 0xffff0000u) * __uint_as_float(z_ & 0xffff0000u)); } \
        *(u32x4*)(ogrow + (size_t)((n_) * 64 + r_) * VALD + c_) = w_; } } while (0)
#define SCAN_ZLOAD(n_) do { _Pragma("unroll") for (int k_ = 0; k_ < 2; ++k_) { const int p_ = tid + 512 * k_, r_ = p_ >> 4, c_ = (p_ & 15) * 8; \
        zq[k_] = *(const u32x4*)(zrow + (size_t)((n_) * 64 + r_) * INW + c_); } } while (0)
    u32x4 zq[2];
    SCAN_DMA(0, 0);
    u32x2 un[4]; float egn;
#pragma unroll
    for (int mt = 0; mt < 4; ++mt) un[mt] = *(const u32x2*)(recU + (wid * 4 + mt) * 512 + lane * 8);
    egn = eglp[0];
#pragma unroll 1
    for (int n = 0; n < NCH; ++n) {
        __builtin_amdgcn_s_waitcnt(0x0F70); VM_WAIT(); BAR_LDS();
        const float egl = egn;
        f32x4 vn[4], o[4];
#pragma unroll
        for (int mt = 0; mt < 4; ++mt) vn[mt] = (f32x4){__uint_as_float(un[mt].x << 16), __uint_as_float(un[mt].x & 0xffff0000u), __uint_as_float(un[mt].y << 16), __uint_as_float(un[mt].y & 0xffff0000u)};
        SCHED_FENCE();
        if (n > 0 && !(P.xf & 16)) SCAN_OGFLUSH(n - 1);
        SCHED_FENCE();
        {
            const int nn = n + 1 < NCH ? n + 1 : NCH - 1;
            if (!(P.xf & 8)) SCAN_DMA(nn, (n + 1) & 1);
#pragma unroll
            for (int mt = 0; mt < 4; ++mt) un[mt] = *(const u32x2*)(recU + (size_t)nn * PREPU_REC + (wid * 4 + mt) * 512 + lane * 8);
            egn = eglp[nn];
            if (!(P.xf & 16)) SCAN_ZLOAD(n);
        }
        const LAS unsigned char* st = lds + (n & 1) * PREPA_REC + lane * 16;
        bf16x8 sb[4];
#pragma unroll
        for (int s = 0; s < 4; ++s) { u32x4 w; w.x = pk2(S[2 * s][0], S[2 * s][1]); w.y = pk2(S[2 * s][2], S[2 * s][3]); w.z = pk2(S[2 * s + 1][0], S[2 * s + 1][1]); w.w = pk2(S[2 * s + 1][2], S[2 * s + 1][3]);
            sb[s] = __builtin_bit_cast(bf16x8, w); }
#define LDF(i_) (*(const LAS bf16x8*)(st + (i_) * 1024))
        bf16x8 fa[8], fb[8];
#pragma unroll
        for (int s = 0; s < 4; ++s) { fa[s] = LDF(s); fa[4 + s] = LDF(16 + s); }
#pragma unroll
        for (int mt = 0; mt < 4; ++mt) {
            o[mt] = (f32x4){0.f, 0.f, 0.f, 0.f};
            if (mt < 3) {
#pragma unroll
                for (int s = 0; s < 4; ++s) { fb[s] = LDF((mt + 1) * 4 + s); fb[4 + s] = LDF(16 + (mt + 1) * 4 + s); }
            } else {
#pragma unroll
                for (int i = 0; i < 8; ++i) fb[i] = LDF(48 + i);
            }
            SCHED_FENCE();
#pragma unroll
            for (int s = 0; s < 4; ++s) { vn[mt] = MFMA16(fa[s], sb[s], vn[mt]); o[mt] = MFMA16(fa[4 + s], sb[s], o[mt]); }
            SCHED_FENCE();
#pragma unroll
            for (int i = 0; i < 8; ++i) fa[i] = fb[i];
        }
        bf16x8 vb[2];
#pragma unroll
        for (int sp = 0; sp < 2; ++sp) { u32x4 w; w.x = pk2(vn[2 * sp][0], vn[2 * sp][1]); w.y = pk2(vn[2 * sp][2], vn[2 * sp][3]); w.z = pk2(vn[2 * sp + 1][0], vn[2 * sp + 1][1]); w.w = pk2(vn[2 * sp + 1][2], vn[2 * sp + 1][3]);
            vb[sp] = __builtin_bit_cast(bf16x8, w); }
#pragma unroll
        for (int i = 0; i < 8; ++i) fb[i] = LDF(32 + i);
        SCHED_FENCE();
#pragma unroll
        for (int mt = 0; mt < 4; ++mt)
#pragma unroll
            for (int sp = 0; sp < 2; ++sp) o[mt] = MFMA16(fa[mt * 2 + sp], vb[sp], o[mt]);
        SCHED_FENCE();
#pragma unroll
        for (int i = 0; i < 8; ++i) fa[i] = LDF(40 + i);
#pragma unroll
        for (int mt = 0; mt < 4; ++mt)
#pragma unroll
            for (int jj = 0; jj < 4; ++jj) { const float s = row16_sum(o[mt][jj] * o[mt][jj]); if (m16 == 0) part[(16 * mt + 4 * q4 + jj) * 8 + wid] = s; }
        SCHED_FENCE();
#pragma unroll
        for (int dt = 0; dt < 4; ++dt) { S[dt] = S[dt] * egl;
#pragma unroll
            for (int sp = 0; sp < 2; ++sp) S[dt] = MFMA16(fb[dt * 2 + sp], vb[sp], S[dt]); }
#pragma unroll
        for (int dt = 4; dt < 8; ++dt) { S[dt] = S[dt] * egl;
#pragma unroll
            for (int sp = 0; sp < 2; ++sp) S[dt] = MFMA16(fa[(dt - 4) * 2 + sp], vb[sp], S[dt]); }
#undef LDF
        BAR_LDS();
        {
            LAS float* rtab = (LAS float*)(lds + 134144) + wid * 64;
            const f32x4 p0 = *(const LAS f32x4*)(part + lane * 8), p1 = *(const LAS f32x4*)(part + lane * 8 + 4);
            const float tot = ((p0[0] + p0[1]) + (p0[2] + p0[3])) + ((p1[0] + p1[1]) + (p1[2] + p1[3]));
            rtab[lane] = __builtin_amdgcn_rsqf(tot * (1.0f / 128.0f) + EPS);
            LDS_WAIT();
            f32x4 rv[4];
#pragma unroll
            for (int mt = 0; mt < 4; ++mt) rv[mt] = *(const LAS f32x4*)(rtab + 16 * mt + 4 * q4);
            SCHED_FENCE();
#pragma unroll
            for (int mt = 0; mt < 4; ++mt)
#pragma unroll
                for (int jj = 0; jj < 4; ++jj) ogb[(16 * mt + 4 * q4 + jj) * OG_LD + 16 * wid + m16] = f2bf(o[mt][jj] * rv[mt][jj] * gn);
        }
    }
    BAR_LDS();
    SCAN_OGFLUSH(NCH - 1);
#undef SCAN_DMA
#undef SCAN_OGFLUSH
#undef SCAN_ZLOAD
    float* so = P.delta_out + ((size_t)(b * 32 + hv) * 128) * 128 + 16 * wid + m16;
#pragma unroll
    for (int dt = 0; dt < 8; ++dt)
#pragma unroll
        for (int jj = 0; jj < 4; ++jj) so[(size_t)(16 * dt + 4 * q4 + jj) * 128] = S[dt][jj];
    VM_WAIT(); BAR_LDS();
}

struct SConvArgs { const float* projs; const float* sconv; const float* convw; const float* a_log; const float* dt_bias; float* qkvs; float* betas; float* gs; float* conv_s; };
__device__ __forceinline__ void sconv_item(const SConvArgs& P, int b, int cg, int lane) {
    float v[2];
#pragma unroll
    for (int hh = 0; hh < 2; ++hh) {
        const int c = cg * 128 + lane + 64 * hh;
        const float raw = P.projs[(size_t)b * INDIM + c];
        const float p0 = P.sconv[((size_t)b * 3 + 0) * CONVD + c], p1 = P.sconv[((size_t)b * 3 + 1) * CONVD + c], p2 = P.sconv[((size_t)b * 3 + 2) * CONVD + c];
        const float acc = p0 * P.convw[c] + p1 * P.convw[CONVD + c] + p2 * P.convw[2 * CONVD + c] + raw * P.convw[3 * CONVD + c];
        P.conv_s[((size_t)b * 3 + 0) * CONVD + c] = p1; P.conv_s[((size_t)b * 3 + 1) * CONVD + c] = p2; P.conv_s[((size_t)b * 3 + 2) * CONVD + c] = raw;
        v[hh] = acc / (1.0f + expf(-acc));
    }
    if (cg < 32) {
        const float s = wave_sum(v[0] * v[0] + v[1] * v[1]);
        float r = 1.0f / sqrtf(s + EPS); if (cg < 16) r *= 0.08838834764831845f;
        v[0] *= r; v[1] *= r;
    }
    P.qkvs[(size_t)b * CONVD + cg * 128 + lane] = v[0]; P.qkvs[(size_t)b * CONVD + cg * 128 + lane + 64] = v[1];
    if (cg == 0 && lane < 32) {
        const float braw = P.projs[(size_t)b * INDIM + 12288 + lane], araw = P.projs[(size_t)b * INDIM + 12320 + lane];
        const float xx = araw + P.dt_bias[lane]; const float sp = xx > 20.f ? xx : log1pf(expf(xx));
        P.betas[b * 32 + lane] = 1.0f / (1.0f + expf(-braw)); P.gs[b * 32 + lane] = -expf(P.a_log[lane]) * sp;
    }
}

struct SRecArgs { const float* qkvs; const float* betas; const float* gs; const float* projs; const float* gnorm; const float* S0; float* Sout; bf16_t* ogs; };
__device__ __forceinline__ void srec_unit(const SRecArgs& P, LAS unsigned char* lds, int b, int hv, int tid) {
    asm volatile("" : "+v"(tid));
    LAS float* qs = (LAS float*)lds; LAS float* ks = qs + 128; LAS float* red = qs + 256; LAS float* wsm = qs + 768;
    const int e = tid & 127, dq = tid >> 7, hk = hv >> 1;
    if (tid < 128) qs[tid] = P.qkvs[(size_t)b * CONVD + hk * 128 + tid]; else if (tid < 256) ks[tid - 128] = P.qkvs[(size_t)b * CONVD + 2048 + hk * 128 + (tid - 128)];
    const float ve = P.qkvs[(size_t)b * CONVD + 4096 + hv * 128 + e], beta = P.betas[b * 32 + hv], dec = expf(P.gs[b * 32 + hv]);
    const size_t sbase = ((size_t)(b * 32 + hv) * 128 + 32 * dq) * 128 + e;
    float S[32];
#pragma unroll
    for (int d = 0; d < 32; ++d) S[d] = P.S0[sbase + (size_t)d * 128];
    __syncthreads();
    float kvp = 0.f;
#pragma unroll
    for (int d = 0; d < 32; ++d) { S[d] *= dec; kvp += S[d] * ks[32 * dq + d]; }
    red[dq * 128 + e] = kvp;
    __syncthreads();
    const float kv = (red[e] + red[128 + e]) + (red[256 + e] + red[384 + e]);
    const float dl = (ve - kv) * beta;
    float op = 0.f;
#pragma unroll
    for (int d = 0; d < 32; ++d) { S[d] += ks[32 * dq + d] * dl; op += S[d] * qs[32 * dq + d]; }
    __syncthreads();
    red[dq * 128 + e] = op;
#pragma unroll
    for (int d = 0; d < 32; ++d) P.Sout[sbase + (size_t)d * 128] = S[d];
    __syncthreads();
    const float o = (red[e] + red[128 + e]) + (red[256 + e] + red[384 + e]);
    if (tid < 128) { const float s = wave_sum(o * o); if ((tid & 63) == 0) wsm[tid >> 6] = s; }
    __syncthreads();
    if (tid < 128) {
        const float ri = 1.0f / sqrtf((wsm[0] + wsm[1]) * (1.0f / 128.0f) + EPS);
        const float z = P.projs[(size_t)b * INDIM + 8192 + hv * 128 + e];
        P.ogs[(size_t)b * VALD + hv * 128 + e] = f2bf(o * ri * P.gnorm[e] * (z / (1.0f + expf(-z))));
    }
    __syncthreads();
}

__device__ __forceinline__ int t5_bucket(int d) {
    if (d < 16) return d;
    const int v = 16 + (int)(logf((float)d / 16.0f) / logf(8.0f) * 16.0f);
    return v < 31 ? v : 31;
}
struct AttnArgs { const bf16_t* Q; const bf16_t* KB; const bf16_t* VT; bf16_t* AO; const float* sinks; };
__device__ __forceinline__ void attn_unit(const AttnArgs& P, const LAS float* bias2, int b, int h, int qb, int lane) {
    asm volatile("" : "+v"(lane));
    const int n32 = lane & 31, hi = lane >> 5, kvh = h >> 3, q0 = 32 * qb;
    const float sink2 = P.sinks[h] * LOG2E;
    bf16x8 qf[4];
    const bf16_t* qp = P.Q + (size_t)(b * SEQ + q0 + n32) * D + h * 64 + 8 * hi;
#pragma unroll
    for (int s = 0; s < 4; ++s) qf[s] = *(const bf16x8*)(qp + 16 * s);
    f32x16 st[5];
    float mx = sink2;
#pragma unroll
    for (int kt = 0; kt < 5; ++kt) {
        const int j0 = q0 - 128 + 32 * kt;
#pragma unroll
        for (int r = 0; r < 16; ++r) st[kt][r] = 0.f;
        if (j0 >= 0) {
            const bf16_t* kp = P.KB + (size_t)(b * SEQ + j0 + n32) * 256 + kvh * 64 + 8 * hi;
#pragma unroll
            for (int s = 0; s < 4; ++s) { const bf16x8 kf = *(const bf16x8*)(kp + 16 * s); st[kt] = MFMA32(kf, qf[s], st[kt]); }
        }
#pragma unroll
        for (int r = 0; r < 16; ++r) {
            const int dist = 128 - 32 * kt + n32 - crow32(r, hi);
            const bool valid = (j0 >= 0) && dist >= 0 && dist < 128;
            const float sc = valid ? st[kt][r] + bias2[h * 128 + (dist & 127)] : -INFINITY;
            st[kt][r] = sc; mx = fmaxf(mx, sc);
        }
    }
    mx = fmaxf(mx, __shfl_xor(mx, 32));
    float l = 0.f;
#pragma unroll
    for (int kt = 0; kt < 5; ++kt)
#pragma unroll
        for (int r = 0; r < 16; ++r) { const float p = fast_exp2(st[kt][r] - mx); st[kt][r] = p; l += p; }
    l += __shfl_xor(l, 32);
    l += fast_exp2(sink2 - mx);
    const float linv = 1.0f / l;
    f32x16 o[2];
#pragma unroll
    for (int r = 0; r < 16; ++r) { o[0][r] = 0.f; o[1][r] = 0.f; }
#pragma unroll
    for (int kt = 0; kt < 5; ++kt) {
        const int j0 = q0 - 128 + 32 * kt;
        if (j0 >= 0) {
#pragma unroll
            for (int s2 = 0; s2 < 2; ++s2) {
                u32x4 w; w.x = pk2(st[kt][8 * s2 + 0], st[kt][8 * s2 + 1]); w.y = pk2(st[kt][8 * s2 + 2], st[kt][8 * s2 + 3]);
                w.z = pk2(st[kt][8 * s2 + 4], st[kt][8 * s2 + 5]); w.w = pk2(st[kt][8 * s2 + 6], st[kt][8 * s2 + 7]);
                const bf16x8 pa = __builtin_bit_cast(bf16x8, w);
#pragma unroll
                for (int dh = 0; dh < 2; ++dh) {
                    const bf16_t* vp = P.VT + ((size_t)(b * 4 + kvh) * 64 + 32 * dh + n32) * SEQ + j0 + 16 * s2 + 4 * hi;
                    const u32x2 lo = *(const u32x2*)vp, hi8 = *(const u32x2*)(vp + 8);
                    u32x4 vw; vw.x = lo.x; vw.y = lo.y; vw.z = hi8.x; vw.w = hi8.y;
                    o[dh] = MFMA32(pa, __builtin_bit_cast(bf16x8, vw), o[dh]);
                }
            }
        }
    }
    bf16_t* op = P.AO + (size_t)(b * SEQ + q0) * D + h * 64 + n32;
#pragma unroll
    for (int r = 0; r < 16; ++r) {
        const int m = crow32(r, hi);
        const float li = __shfl(linv, m);
        op[(size_t)m * D] = f2bf(o[0][r] * li); op[(size_t)m * D + 32] = f2bf(o[1][r] * li);
    }
}

struct SAttnArgs { const float* qs; const float* kvs; const float* ck; const float* cv; const float* sinks; bf16_t* aos; };
__device__ __forceinline__ void sattn_unit(const SAttnArgs& P, const LAS float* bias2, int b, int h, int lane) {
    const int kvh = h >> 3;
    const float qd = P.qs[(size_t)b * D + h * 64 + lane];
    const float sink2 = P.sinks[h] * LOG2E;
    float sc[2];
#pragma unroll
    for (int hh = 0; hh < 2; ++hh) {
        const int c = lane + 64 * hh + 1;
        const float* kp = (c < 128) ? P.ck + ((size_t)(b * 128 + c) * 4 + kvh) * 64 : P.kvs + (size_t)b * 512 + kvh * 64;
        float s = 0.f;
#pragma unroll
        for (int d4 = 0; d4 < 16; ++d4) { const f32x4 kv = *(const f32x4*)(kp + 4 * d4);
#pragma unroll
            for (int x = 0; x < 4; ++x) s += __uint_as_float(__builtin_amdgcn_readlane(__float_as_uint(qd), 4 * d4 + x)) * kv[x]; }
        sc[hh] = s + bias2[h * 128 + (128 - c)];
    }
    float mx = fmaxf(sc[0], sc[1]);
#pragma unroll
    for (int o = 1; o < 64; o <<= 1) mx = fmaxf(mx, __shfl_xor(mx, o));
    mx = fmaxf(mx, sink2);
    const float p0 = fast_exp2(sc[0] - mx), p1 = fast_exp2(sc[1] - mx);
    const float l = wave_sum(p0 + p1) + fast_exp2(sink2 - mx);
    float acc = 0.f;
#pragma unroll 8
    for (int cc = 0; cc < 64; ++cc) {
        const float pa = __uint_as_float(__builtin_amdgcn_readlane(__float_as_uint(p0), cc));
        const float pb = __uint_as_float(__builtin_amdgcn_readlane(__float_as_uint(p1), cc));
        const int ca = cc + 1, cb = cc + 65;
        const float* va = P.cv + ((size_t)(b * 128 + ca) * 4 + kvh) * 64;
        const float* vb = (cb < 128) ? P.cv + ((size_t)(b * 128 + cb) * 4 + kvh) * 64 : P.kvs + (size_t)b * 512 + 256 + kvh * 64;
        acc += pa * va[lane] + pb * vb[lane];
    }
    P.aos[(size_t)b * D + h * 64 + lane] = f2bf(acc / l);
}
#define XB_TMO      128
#define XB_XCNT(j)  (256  + 64 * (j))
#define XB_XSUB(j)  (1280 + 64 * (j))
#define XB_XGEN(j)  (2304 + 64 * (j))
#define XB_TOP      3328
#define XB_TOPGEN   3392
#define XCD_BAR_WORDS 3456
#define XB_SPIN_CAP (1u << 18)

__device__ __forceinline__ unsigned xb_ld(unsigned* p)              { return __hip_atomic_load(p, __ATOMIC_RELAXED, __HIP_MEMORY_SCOPE_AGENT); }
__device__ __forceinline__ unsigned xb_add(unsigned* p, unsigned v) { return __hip_atomic_fetch_add(p, v, __ATOMIC_RELAXED, __HIP_MEMORY_SCOPE_AGENT); }
__device__ __forceinline__ unsigned xb_xcc_id() { return (unsigned)__builtin_amdgcn_s_getreg((3 << 11) | 20) & 0xFu; }
#define XB_SPIN(cond, bar) do { unsigned _sp = 0; while (cond) { __builtin_amdgcn_s_sleep(1); \
    if ((++_sp & 255u) == 0u) { if (xb_ld(&(bar)[XB_TMO])) break; if (_sp > XB_SPIN_CAP) { atomicAdd(&(bar)[XB_TMO], 1u); break; } } } } while (0)

struct XcdBarrier {
    unsigned* bar; unsigned x;
    volatile LAS unsigned* st;
};

__device__ __forceinline__ XcdBarrier xcd_barrier_post(unsigned* bar, volatile LAS unsigned* st) {
    XcdBarrier b; b.bar = bar; b.x = xb_xcc_id(); b.st = st;
    if (threadIdx.x == 0) (void)xb_add(&bar[XB_XCNT(b.x)], 1u);
    return b;
}
__device__ __forceinline__ void xcd_barrier_complete(unsigned* bar, unsigned x, unsigned& nloc, unsigned& nx) {
    const unsigned G = gridDim.x * gridDim.y * gridDim.z;
    unsigned sum, cnt, mine, sp = 0u;
    for (;;) {
        sum = 0u; cnt = 0u; mine = 0u;
#pragma unroll
        for (unsigned j = 0; j < 16; ++j) { const unsigned c = xb_ld(&bar[XB_XCNT(j)]); sum += c; cnt += (c > 0u) ? 1u : 0u; mine = (j == x) ? c : mine; }
        if (sum == G) break;
        __builtin_amdgcn_s_sleep(1);
        if ((++sp & 255u) == 0u) { if (xb_ld(&bar[XB_TMO])) break; if (sp > XB_SPIN_CAP) { atomicAdd(&bar[XB_TMO], 1u); break; } }
    }
    nloc = mine > 0u ? mine : 1u; nx = cnt > 0u ? cnt : 1u;
}

__device__ __forceinline__ void xcd_barrier(const XcdBarrier& b) {
    asm volatile("s_waitcnt vmcnt(0)" ::: "memory");
    __syncthreads();
    if (threadIdx.x == 0) {
        unsigned* bar = b.bar;
        __builtin_amdgcn_s_waitcnt(0);
        unsigned nloc = b.st[0], nx = b.st[1];
        if (nloc == 0u) { xcd_barrier_complete(bar, b.x, nloc, nx); b.st[0] = nloc; b.st[1] = nx; }
        const unsigned old = xb_add(&bar[XB_XSUB(b.x)], 1u);
        const unsigned gen = old / nloc;
        if (old + 1u == (gen + 1u) * nloc) {
            __builtin_amdgcn_fence(__ATOMIC_RELEASE, "agent");
            asm volatile("s_waitcnt vmcnt(0)" ::: "memory");
            const unsigned og = xb_add(&bar[XB_TOP], 1u);
            const unsigned tg = og / nx;
            if (og + 1u == (tg + 1u) * nx) xb_add(&bar[XB_TOPGEN], 1u);
            else XB_SPIN(xb_ld(&bar[XB_TOPGEN]) == tg, bar);
            __builtin_amdgcn_fence(__ATOMIC_ACQUIRE, "agent");
            xb_add(&bar[XB_XGEN(b.x)], 1u);
            asm volatile("s_waitcnt vmcnt(0)" ::: "memory");
        } else {
            XB_SPIN(xb_ld(&bar[XB_XGEN(b.x)]) == gen, bar);
            __builtin_amdgcn_fence(__ATOMIC_ACQUIRE, "agent");
            asm volatile("s_waitcnt vmcnt(0)" ::: "memory");
        }
    }
    __syncthreads();
}

constexpr int CW_BARBASE = 131072, BAR_REGION_WORDS = 4096;
constexpr int PH_FINAL = 25, N_PHASES = 26;
#ifndef MK_EN
#define MK_EN 0xffff
#endif
#define EN(k) (((MK_EN) >> (k)) & 1)
struct Args { const float* in[23]; float* out; unsigned char* ws; int ph_lo, ph_hi, li, pad; };

constexpr size_t O_Y = 0, O_YS = 16777216, O_DP = 16842752, O_CP = 21037056, O_KP = 21233664, O_VP = 21364736, O_DS = 21495808, O_CS = 55050240, O_KS = 56623104, O_VS = 57671680;

__global__ void __launch_bounds__(NTHR, 2) mk_fwd(Args args) {
    extern __shared__ __attribute__((aligned(16))) unsigned char lds_raw[];
    LAS unsigned char* lds = (LAS unsigned char*)lds_raw;
    volatile LAS unsigned* MISC = (volatile LAS unsigned*)(lds + MISC_OFF);
    const int G = gridDim.x, bid = blockIdx.x;
    if (threadIdx.x < 64) MISC[threadIdx.x] = 0u;
    __syncthreads();
    XcdBarrier bar = xcd_barrier_post((unsigned*)(args.ws + WS_CTL) + CW_BARBASE + args.li * BAR_REGION_WORDS, MISC + 8);
    const int lo = args.ph_lo, hi = args.ph_hi;
#define IN(k) (lo <= (k) && (k) < hi)
#define SEAM(knext) do { if (IN(knext)) xcd_barrier(bar); } while (0)
typedef const float* const __attribute__((address_space(4)))* KP_T;
#define KARG(k) (kp[(k)])
#define PH_LOCALS \
    int tid = threadIdx.x; asm volatile("" : "+v"(tid)); \
    const int lane = tid & 63, wid = __builtin_amdgcn_readfirstlane(tid >> 6); \
    KP_T kp = (KP_T)__builtin_amdgcn_kernarg_segment_ptr(); asm volatile("" : "+s"(kp)); \
    unsigned char* ws = (unsigned char*)KARG(24); \
    float* out = (float*)KARG(23); \
    const int gw = bid * NWAVES + wid, NGW = G * NWAVES; \
    float* ssq = (float*)(ws + WS_SSQP); float* ssqs = (float*)(ws + WS_SSQSP); \
    LAS float* red = (LAS float*)lds; \
    (void)gw; (void)NGW; (void)lane; (void)out; (void)ssq; (void)ssqs; (void)red;
#define RINVS ((LAS float*)(lds + 131072))
#define BUILD_RINVS(site_ptr) do { if (tid < 32) { const float* p_ = (site_ptr) + tid * 64; float s_ = 0.f; for (int i_ = 0; i_ < 64; ++i_) s_ += p_[i_]; RINVS[tid] = rinv_of(s_); } __syncthreads(); } while (0)
#define ssq_in (ssq + (size_t)(2 * L) * MP * 32)
#define ssqs_in (ssqs + (2 * L) * SB * 64)
#define ssq_mid (ssq + (size_t)(2 * L + 1) * MP * 32)
#define ssqs_mid (ssqs + (2 * L + 1) * SB * 64)
#define ssq_out (ssq + (size_t)(2 * L + 2) * MP * 32)
#define ssqs_out (ssqs + (2 * L + 2) * SB * 64)
#define x_prompt (KARG(0))
#define x_sample (KARG(1))
#define state_delta (KARG(2))
#define state_conv (KARG(3))
#define cache_k (KARG(4))
#define cache_v (KARG(5))
#define norm_mix (KARG(6))
#define norm_ffn (KARG(7))
#define w_in (KARG(8))
#define conv_w (KARG(9))
#define a_log (KARG(10))
#define dt_bias (KARG(11))
#define gnorm (KARG(12))
#define w_out (KARG(13))
#define norm_kv (KARG(14))
#define w_kv (KARG(15))
#define w_q (KARG(16))
#define w_o (KARG(17))
#define sinks (KARG(18))
#define rel_bias (KARG(19))
#define w_gu (KARG(20))
#define w_dn (KARG(21))
#define norm_final (KARG(22))
#define WIN_T ((bf16_t*)(ws + WS_WIN))
#define WBA_T ((bf16_t*)(ws + WS_WBA))
#define WOUT_T ((bf16_t*)(ws + WS_WOUT))
#define WGU_T ((bf16_t*)(ws + WS_WGU))
#define WDN_T ((bf16_t*)(ws + WS_WDN))
#define WQKV_T ((bf16_t*)(ws + WS_WQKV))
#define WQ1_T ((bf16_t*)(ws + WS_WQ1))
#define WO_T ((bf16_t*)(ws + WS_WO))
#define X ((float*)(ws + WS_X))
#define XB ((bf16_t*)(ws + WS_XB))
#define PROJ ((bf16_t*)(ws + WS_PROJ))
#define BETA ((float*)(ws + WS_BETA))
#define GG ((float*)(ws + WS_G))
#define OG ((bf16_t*)(ws + WS_OG))
#define MID ((bf16_t*)(ws + WS_MID))
#define QB ((bf16_t*)(ws + WS_Q))
#define KB ((bf16_t*)(ws + WS_K))
#define VT ((bf16_t*)(ws + WS_VT))
#define AO ((bf16_t*)(ws + WS_AO))
#define XS ((float*)(ws + WS_SMP + SM_XS))
#define XSB ((bf16_t*)(ws + WS_SMP + SM_XSB))
#define PROJS ((float*)(ws + WS_SMP + SM_PROJS))
#define QKVS ((float*)(ws + WS_SMP + SM_QKVS))
#define BETAS ((float*)(ws + WS_SMP + SM_BETAS))
#define GS ((float*)(ws + WS_SMP + SM_GS))
#define OGS ((bf16_t*)(ws + WS_SMP + SM_OGS))
#define MIDS ((bf16_t*)(ws + WS_SMP + SM_MIDS))
#define QS ((float*)(ws + WS_SMP + SM_QS))
#define KVS ((float*)(ws + WS_SMP + SM_KVS))
#define AOS ((bf16_t*)(ws + WS_SMP + SM_AOS))

    if (EN(0) && IN(0)) {
        PH_LOCALS
        LAS float* scr = (LAS float*)(lds + wid * 16640);
        constexpr int I_IN = 32 * 192, I_BA = 32, I_OUT = 64 * 32, I_GU = 32 * 176, I_DN = 88 * 32, I_KV = 32 * 8, I_Q = 32 * 32;
        constexpr int NITEMS = 2 * (I_IN + I_BA) + 2 * I_OUT + 4 * I_GU + 4 * I_DN + I_KV + 2 * I_Q + 2 * I_Q;
        for (int it = gw; it < NITEMS; it += NGW) {
            int r = it;
            if (r < 2 * I_IN) { const int l = r / I_IN; r %= I_IN; const int kb = r / 192, nb = r % 192;
                tr_item(w_in + (size_t)l * D * INDIM, INDIM, 64 * nb, D, 64 * kb, WIN_T + (size_t)l * INW * D, 64 * nb, norm_mix + l * D, 1.f, scr, lane); continue; } r -= 2 * I_IN;
            if (r < 2 * I_BA) { const int l = r / I_BA; const int kb = r % I_BA;
                tr_item(w_in + (size_t)l * D * INDIM, INDIM, INW, D, 64 * kb, WBA_T + (size_t)l * 64 * D, 0, norm_mix + l * D, 1.f, scr, lane); continue; } r -= 2 * I_BA;
            if (r < 2 * I_OUT) { const int l = r / I_OUT; r %= I_OUT; const int kb = r / 32, nb = r % 32;
                tr_item(w_out + (size_t)l * VALD * D, D, 64 * nb, VALD, 64 * kb, WOUT_T + (size_t)l * D * VALD, 64 * nb, nullptr, 1.f, scr, lane); continue; } r -= 2 * I_OUT;
            if (r < 4 * I_GU) { const int l = r / I_GU; r %= I_GU; const int kb = r / 176, nb = r % 176; const int c = 64 * nb;
                const int drow = c < FF ? 256 * (c >> 7) + (c & 127) : 256 * ((c - FF) >> 7) + 128 + ((c - FF) & 127);
                tr_item(w_gu + (size_t)l * D * GU, GU, c, D, 64 * kb, WGU_T + (size_t)l * GU * D, drow, norm_ffn + l * D, 1.f, scr, lane); continue; } r -= 4 * I_GU;
            if (r < 4 * I_DN) { const int l = r / I_DN; r %= I_DN; const int kb = r / 32, nb = r % 32;
                tr_item(w_dn + (size_t)l * FF * D, D, 64 * nb, FF, 64 * kb, WDN_T + (size_t)l * D * FF, 64 * nb, nullptr, 1.f, scr, lane); continue; } r -= 4 * I_DN;
            if (r < I_KV) { const int kb = r / 8, nb = r % 8;
                tr_item(w_kv, 512, 64 * nb, D, 64 * kb, WQKV_T, 2048 + 64 * nb, norm_kv, 1.f, scr, lane); continue; } r -= I_KV;
            if (r < 2 * I_Q) { const int j = r / I_Q; r %= I_Q; const int kb = r / 32, nb = r % 32;
                tr_item(w_q + (size_t)j * D * D, D, 64 * nb, D, 64 * kb, j == 0 ? WQKV_T : WQ1_T, 64 * nb, norm_mix + (2 + j) * D, QSCALE, scr, lane); continue; } r -= 2 * I_Q;
            { const int j = r / I_Q; r %= I_Q; const int kb = r / 32, nb = r % 32;
                tr_item(w_o + (size_t)j * D * D, D, 64 * nb, D, 64 * kb, WO_T + (size_t)j * D * D, 64 * nb, nullptr, 1.f, scr, lane); }
        }
        for (int m = gw; m < MP + SB; m += NGW) {
            if (m < MP) row_to_bf16(x_prompt + (size_t)m * D, XB + (size_t)m * D, ssq + (size_t)m * 32, 32, lane);
            else row_to_bf16(x_sample + (size_t)(m - MP) * D, XSB + (size_t)(m - MP) * D, ssqs + (size_t)(m - MP) * 64, 64, lane);
        }
        for (int i = bid * NTHR + tid; i < 2 * SB * 127 * 64; i += G * NTHR) {
            const int which = i / (SB * 127 * 64), r = i % (SB * 127 * 64), b = r / (127 * 64), o = r % (127 * 64);
            const f32x4 v = *(const f32x4*)((which ? cache_v : cache_k) + (size_t)b * 128 * 256 + 256 + 4 * o);
            *(f32x4*)(out + (which ? O_VS : O_KS) + (size_t)b * 128 * 256 + 4 * o) = v;
        }
        SEAM(1);
    }

#pragma unroll 1
    for (int L = 0; L < 4; ++L) {
        const int pb = 1 + 6 * L; const bool isA = L < 2; const int j = L - 2;
        if (IN(pb)) {
            PH_LOCALS
            if (EN(1) && isA) {
                const bf16_t* Wt = WIN_T + (size_t)L * INW * D; const bf16_t* Wba = WBA_T + (size_t)L * 64 * D;
                { pg8::Gemm g{XB, Wt, MP, INW, D}; pg8::StaticOrder S; S.init(MP, INW, G, bid);
                  pg8::EpiProj E{PROJ, INW, ssq_in, 32};
                  pg8::gemm_phase<pg8::EpiProj, pg8::StaticOrder, true, true>(lds, g, S, E); }
                const float* al = a_log + L * 32; const float* dtb = dt_bias + L * 32;
                BUILD_RINVS(ssqs_in);
                for (int su = bid; su < 384 + 1 + 256; su += G) {
                    if (su < 384) {
                        skinny_unit<false>(XSB, D, Wt + (size_t)su * 32 * D, nullptr, D, D, red, wid, lane, tid,
                            [&](int m, int n, float v0, float) { PROJS[(size_t)m * INDIM + su * 32 + n] = v0 * RINVS[m]; });
                    } else if (su == 384) {
                        skinny_unit<true>(XSB, D, Wba, Wba + 32 * D, D, D, red, wid, lane, tid,
                            [&](int m, int n, float v0, float v1) { const float ri = RINVS[m]; PROJS[(size_t)m * INDIM + INW + n] = v0 * ri; PROJS[(size_t)m * INDIM + INW + 32 + n] = v1 * ri; });
                    } else {
                        const int u = su - 385;
                        skinny_unit<true>(XB + (size_t)u * 32 * D, D, Wba, Wba + 32 * D, D, D, red, wid, lane, tid,
                            [&](int m, int n, float v0, float v1) { const int row = 32 * u + m; const float ri = rinv_row_full(ssq_in, row);
                                const float braw = v0 * ri, xx = v1 * ri + dtb[n]; const float sp = xx > 20.f ? xx : log1pf(expf(xx));
                                BETA[(size_t)row * 32 + n] = 1.0f / (1.0f + expf(-braw)); GG[(size_t)row * 32 + n] = -expf(al[n]) * sp; });
                    }
                }
            } else if (EN(2) && !isA) {
                const bf16_t* Wt = j == 0 ? WQKV_T : WQ1_T; const int N = j == 0 ? 2560 : 2048;
                { pg8::Gemm g{XB, Wt, MP, N, D}; pg8::StaticOrder S; S.init(MP, N, G, bid);
                  pg8::EpiQKV E{QB, KB, VT, out + O_KP, out + O_VP, ssq_in};
                  pg8::gemm_phase<pg8::EpiQKV, pg8::StaticOrder, true, true>(lds, g, S, E); }
                BUILD_RINVS(ssqs_in);
                for (int su = bid; su < N / 32; su += G) {
                    skinny_unit<false>(XSB, D, Wt + (size_t)su * 32 * D, nullptr, D, D, red, wid, lane, tid,
                        [&](int m, int n, float v0, float) { const float v = v0 * RINVS[m]; const int c = su * 32 + n;
                            if (c < 2048) QS[(size_t)m * D + c] = v;
                            else { KVS[(size_t)m * 512 + (c - 2048)] = v;
                                   if (c < 2304) out[O_KS + ((size_t)m * 128 + 127) * 256 + (c - 2048)] = v; else out[O_VS + ((size_t)m * 128 + 127) * 256 + (c - 2304)] = v; } });
                }
            }
            SEAM(isA ? pb + 1 : pb + 2);
        }
        if (EN(3) && isA && IN(pb + 1)) {
            PH_LOCALS
            PrepArgs P{PROJ, BETA, GG, conv_w + (size_t)L * 4 * CONVD, ws + WS_PREPA, ws + WS_PREPU, (float*)(ws + WS_EGL), out + O_CP + (size_t)L * BATCH * 3 * CONVD};
            for (int u = bid; u < BATCH * 16 * NCH; u += G) { const int n = u & 31, kh = (u >> 5) & 15, b = u >> 9; prep_unit(P, lds, b, kh, n, tid, wid, lane); }
            SConvArgs SP{PROJS, state_conv + (size_t)L * SB * 3 * CONVD, conv_w + (size_t)L * 4 * CONVD, a_log + L * 32, dt_bias + L * 32, QKVS, BETAS, GS, out + O_CS + (size_t)L * SB * 3 * CONVD};
            for (int it = gw; it < SB * 64; it += NGW) sconv_item(SP, it >> 6, it & 63, lane);
            SEAM(pb + 2);
        }
        if (IN(pb + 2)) {
            PH_LOCALS
            if (EN(4) && isA) {
                ScanArgs P{ws + WS_PREPA, ws + WS_PREPU, (const float*)(ws + WS_EGL), PROJ, gnorm + L * 128, (args.pad & 4) ? MID : OG, (args.pad & 4) ? (float*)QB : out + O_DP + (size_t)L * BATCH * 32 * 128 * 128, args.pad};
                if (!(args.pad & 1)) for (int u = bid; u < BATCH * 32; u += G) scan_unit(P, lds, u >> 5, u & 31, tid, wid, lane);
                SRecArgs R{QKVS, BETAS, GS, PROJS, gnorm + L * 128, state_delta + (size_t)L * SB * 32 * 128 * 128, out + O_DS + (size_t)L * SB * 32 * 128 * 128, OGS};
                const int base = G > 128 ? 128 : 0, nb = G > 128 ? G - 128 : G;
                if (!(args.pad & 2) && bid >= base) for (int su = bid - base; su < SB * 32; su += nb) srec_unit(R, lds, su >> 5, su & 31, tid);
            } else if (EN(5) && !isA) {
                LAS float* bias2 = (LAS float*)lds;
                for (int i = tid; i < 32 * 128; i += NTHR) { const int h = i >> 7, dist = i & 127; bias2[i] = rel_bias[t5_bucket(dist) * 32 + h] * LOG2E; }
                __syncthreads();
                AttnArgs P{QB, KB, VT, AO, sinks + j * 32};
                for (int u = gw; u < BATCH * 32 * 64; u += NGW) { const int g8 = u & 7, qb = (u >> 3) & 63, kvh = (u >> 9) & 3, b = u >> 11; attn_unit(P, bias2, b, kvh * 8 + g8, qb, lane); }
                SAttnArgs SP{QS, KVS, cache_k, cache_v, sinks + j * 32, AOS};
                for (int u = gw; u < SB * 32; u += NGW) sattn_unit(SP, bias2, u >> 5, u & 31, lane);
                __syncthreads();
            }
            SEAM(pb + 3);
        }
        if (EN(6) && IN(pb + 3)) {
            PH_LOCALS
            const bf16_t* A = isA ? OG : AO; const int K = isA ? VALD : D;
            const bf16_t* Wt = isA ? WOUT_T + (size_t)L * D * VALD : WO_T + (size_t)j * D * D;
            const float* base = L == 0 ? x_prompt : X; const float* bases = L == 0 ? x_sample : XS;
            { pg8::Gemm g{A, Wt, MP, D, K}; pg8::StaticOrder S; S.init(MP, D, G, bid);
              pg8::EpiRes E{base, X, XB, ssq_mid};
              pg8::gemm_phase<pg8::EpiRes, pg8::StaticOrder, true, true>(lds, g, S, E); }
            const bf16_t* As = isA ? OGS : AOS;
            for (int su = bid; su < 64; su += G) {
                skinny_unit<false>(As, K, Wt + (size_t)su * 32 * K, nullptr, K, K, red, wid, lane, tid,
                    [&](int m, int n, float v0, float) { const size_t o = (size_t)m * D + su * 32 + n; const float v = bases[o] + v0; XS[o] = v; XSB[o] = f2bf(v);
                        float s = v * v; s += __shfl_xor(s, 1); s += __shfl_xor(s, 2); s += __shfl_xor(s, 4); s += __shfl_xor(s, 8); s += __shfl_xor(s, 16);
                        if (n == 0) ssqs_mid[m * 64 + su] = s; });
            }
            SEAM(pb + 4);
        }
        if (EN(7) && IN(pb + 4)) {
            PH_LOCALS
            const bf16_t* Wt = WGU_T + (size_t)L * GU * D;
            { pg8::Gemm g{XB, Wt, MP, GU, D}; pg8::StaticOrder S; S.init(MP, GU, G, bid);
              pg8::EpiSwiglu E{MID, ssq_mid};
              pg8::gemm_phase<pg8::EpiSwiglu, pg8::StaticOrder, true, true>(lds, g, S, E); }
            BUILD_RINVS(ssqs_mid);
            for (int su = bid; su < FF / 32; su += G) {
                const int t = su >> 2, s4 = su & 3;
                skinny_unit<true>(XSB, D, Wt + (size_t)(256 * t + 32 * s4) * D, Wt + (size_t)(256 * t + 128 + 32 * s4) * D, D, D, red, wid, lane, tid,
                    [&](int m, int n, float v0, float v1) { const float ri = RINVS[m]; const float gt = v0 * ri, up = v1 * ri;
                        MIDS[(size_t)m * FF + su * 32 + n] = f2bf(gt / (1.0f + expf(-gt)) * up); });
            }
            SEAM(pb + 5);
        }
        if (EN(8) && IN(pb + 5)) {
            PH_LOCALS
            const bf16_t* Wt = WDN_T + (size_t)L * D * FF;
            { pg8::Gemm g{MID, Wt, MP, D, FF}; pg8::StaticOrder S; S.init(MP, D, G, bid);
              pg8::EpiRes E{X, X, XB, ssq_out};
              pg8::gemm_phase<pg8::EpiRes, pg8::StaticOrder, true, true>(lds, g, S, E); }
            for (int su = bid; su < 64; su += G) {
                skinny_unit<false>(MIDS, FF, Wt + (size_t)su * 32 * FF, nullptr, FF, FF, red, wid, lane, tid,
                    [&](int m, int n, float v0, float) { const size_t o = (size_t)m * D + su * 32 + n; const float v = XS[o] + v0; XS[o] = v; XSB[o] = f2bf(v);
                        float s = v * v; s += __shfl_xor(s, 1); s += __shfl_xor(s, 2); s += __shfl_xor(s, 4); s += __shfl_xor(s, 8); s += __shfl_xor(s, 16);
                        if (n == 0) ssqs_out[m * 64 + su] = s; });
            }
            SEAM(L == 3 ? PH_FINAL : pb + 6);
        }
    }
    if (EN(9) && IN(PH_FINAL)) {
        PH_LOCALS
        const float* sq = ssq + (size_t)8 * MP * 32; const float* sqs = ssqs + 8 * SB * 64;
        for (int m = gw; m < MP + SB; m += NGW) {
            const bool sp = m >= MP; const int r = sp ? m - MP : m;
            const float ri = rinv_of(wave_sum(sp ? sqs[r * 64 + lane] : (lane < 32 ? sq[(size_t)r * 32 + lane] : 0.f)));
            const f32x4* xr = (const f32x4*)((sp ? XS : X) + (size_t)r * D) + lane; f32x4* yr = (f32x4*)(out + (sp ? O_YS : O_Y) + (size_t)r * D) + lane; const f32x4* gr = (const f32x4*)norm_final + lane;
#pragma unroll
            for (int q = 0; q < 8; ++q) yr[64 * q] = xr[64 * q] * ri * gr[64 * q];
        }
    }
#undef IN
#undef SEAM
}
#undef RINVS
#undef BUILD_RINVS
#undef x_prompt
#undef x_sample
#undef state_delta
#undef state_conv
#undef cache_k
#undef cache_v
#undef norm_mix
#undef norm_ffn
#undef w_in
#undef conv_w
#undef a_log
#undef dt_bias
#undef gnorm
#undef w_out
#undef norm_kv
#undef w_kv
#undef w_q
#undef w_o
#undef sinks
#undef rel_bias
#undef w_gu
#undef w_dn
#undef norm_final
#undef WIN_T
#undef WBA_T
#undef WOUT_T
#undef WGU_T
#undef WDN_T
#undef WQKV_T
#undef WQ1_T
#undef WO_T
#undef X
#undef XB
#undef PROJ
#undef BETA
#undef GG
#undef OG
#undef MID
#undef QB
#undef KB
#undef VT
#undef AO
#undef XS
#undef XSB
#undef PROJS
#undef QKVS
#undef BETAS
#undef GS
#undef OGS
#undef MIDS
#undef QS
#undef KVS
#undef AOS
#undef ssq_in
#undef ssqs_in
#undef ssq_mid
#undef ssqs_mid
#undef ssq_out
#undef ssqs_out
#undef PH_LOCALS
#undef KARG

#ifndef MK_PER_PHASE
#define MK_PER_PHASE 0
#endif
static int mk_grid = 0;
static bool mk_setup(int n_in, size_t ws_size) {
    if (mk_grid == 0) {
        if (n_in != 23 || ws_size < WS_END) { fprintf(stderr, "kernel_launch: unexpected inputs (%d) or workspace (%zu < %zu)\n", n_in, ws_size, (size_t)WS_END); mk_grid = -1; return false; }
        int dev = 0, cus = 0, per_cu = 0;
        if (hipGetDevice(&dev) != hipSuccess || hipDeviceGetAttribute(&cus, hipDeviceAttributeMultiprocessorCount, dev) != hipSuccess) { mk_grid = -1; return false; }
        if (hipFuncSetAttribute((const void*)mk_fwd, hipFuncAttributeMaxDynamicSharedMemorySize, LDS_BYTES) != hipSuccess) { fprintf(stderr, "kernel_launch: hipFuncSetAttribute failed\n"); mk_grid = -1; return false; }
        if (hipOccupancyMaxActiveBlocksPerMultiprocessor(&per_cu, (const void*)mk_fwd, NTHR, LDS_BYTES) != hipSuccess || per_cu < 1) { fprintf(stderr, "kernel_launch: occupancy query says %d\n", per_cu); }
        (void)hipGetLastError();
        mk_grid = cus;
    }
    return mk_grid > 0;
}
static void mk_run(void* const* d_in, void* d_out, void* d_ws, hipStream_t stream, int p_lo, int p_hi, bool per_phase, int flags = 0) {
    (void)hipMemsetAsync((char*)d_ws + WS_CTL, 0, CTL_ZERO_BYTES, stream);
    Args a{};
    for (int i = 0; i < 23; ++i) a.in[i] = (const float*)d_in[i];
    a.out = (float*)d_out; a.ws = (unsigned char*)d_ws; a.pad = flags;
    if (per_phase) {
        int li = 0;
        for (int p = p_lo; p < p_hi; ++p) {
            if (p >= 14 && p <= 24 && ((p - 1) % 6) == 1) continue;
            a.ph_lo = p; a.ph_hi = p + 1; a.li = li++;
            hipLaunchKernelGGL(mk_fwd, dim3(mk_grid), dim3(NTHR), LDS_BYTES, stream, a);
        }
    } else {
        a.ph_lo = p_lo; a.ph_hi = p_hi; a.li = 0;
        hipLaunchKernelGGL(mk_fwd, dim3(mk_grid), dim3(NTHR), LDS_BYTES, stream, a);
    }
}
#ifndef MK_NO_ENTRY
extern "C" void kernel_launch(void* const* d_in, const int* in_sizes, int n_in, void* d_out, int out_size, void* d_ws, size_t ws_size, hipStream_t stream) {
    if (!mk_setup(n_in, ws_size)) return;
    mk_run(d_in, d_out, d_ws, stream, 0, N_PHASES, MK_PER_PHASE != 0);
}
#endif
```

```cpp
#include <hip/hip_runtime.h>
#include <cstdio>
#include <cstdint>
#include <cmath>
namespace pg8 {
#define PG8_LAS __attribute__((address_space(3)))
typedef unsigned short bf16_t;
typedef short bf16x8 __attribute__((ext_vector_type(8)));
typedef float f32x4 __attribute__((ext_vector_type(4)));
typedef unsigned u32x4 __attribute__((ext_vector_type(4)));
constexpr int BM = 256, BK = 64, HALF = 128, HTB = HALF * BK * 2  , STAGE_BYTES = 8 * HTB, NXCD = 8, WGM = 8;

__host__ __device__ __forceinline__ int lds_byte(int r, int c) { const int st = (r >> 4) * 2 + (c >> 5), rr = r & 15, cc = c & 31, ob = rr * 64 + cc * 2; return st * 1024 + (ob ^ (((ob >> 9) & 1) << 5)); }
__host__ __device__ __forceinline__ void stage_rc(int b, int& R, int& C) { const int st = b / 1024, sb = b % 1024, swz = sb ^ (((sb >> 9) & 1) << 5); R = (st >> 1) * 16 + swz / 64; C = (st & 1) * 32 + (swz % 64) / 2; }
__host__ __device__ __forceinline__ int perm32(int rho) { const int n = rho >> 4, i = rho & 15; return 8 * (i >> 2) + 4 * n + (i & 3); }

struct Unit { int pm, pn; };
struct Gemm { const bf16_t* A; const bf16_t* Bt; int M, N, K; };

struct StaticOrder {
    int nM, nN, nwg, G, c, lim;
    __host__ __device__ void init(int M, int N, int G_, int c_) { nM = M / BM; nN = N / BM; nwg = nM * nN; G = G_; c = c_; lim = nwg; }
    __host__ __device__ void map(int L, Unit& u) const {
        int wgid = L; { const int q = nwg / NXCD, r = nwg % NXCD, xcd = wgid % NXCD, off = wgid / NXCD; wgid = (xcd < r ? xcd * (q + 1) : r * (q + 1) + (xcd - r) * q) + off; }
        const int nig = WGM * nN, gid = wgid / nig, fm = gid * WGM, gsz = (nM - fm) < WGM ? (nM - fm) : WGM;
        u.pm = fm + ((wgid % nig) % gsz); u.pn = (wgid % nig) / gsz;
    }
    __host__ __device__ bool next(int i, Unit& u) const {
        const long L = (long)i * G + c; if (L >= lim) return false;
        map((int)L, u); return true;
    }
    __device__ __forceinline__ void a_ready(const Unit&) const {}
    __device__ __forceinline__ void done(const Unit&) const {}
};
struct TailOrder {
    StaticOrder base; int first;
    __host__ __device__ bool next(int i, Unit& u) const {
        const long t = (long)i * base.G + base.c; if (t >= 2L * (base.nwg - first)) return false;
        Unit f; base.map(first + (int)(t >> 1), f); u.pm = 2 * f.pm + (int)(t & 1); u.pn = f.pn; return true;
    }
    __device__ __forceinline__ void a_ready(const Unit&) const {}
    __device__ __forceinline__ void done(const Unit&) const {}
};

__device__ __forceinline__ unsigned cvt_pk_bf16(float lo, float hi) { unsigned r; asm volatile("v_cvt_pk_bf16_f32 %0, %1, %2" : "=v"(r) : "v"(lo), "v"(hi)); return r; }
typedef float f32x2 __attribute__((ext_vector_type(2)));
template <class Epi, class Sched, bool ALIGN_EPI = false, bool SP2 = false, bool HALFM = false>
__device__ __forceinline__ void gemm_phase(PG8_LAS unsigned char* lds, const Gemm g, const Sched& S, const Epi& E, int tid_in) {
    int tid = tid_in; asm volatile("" : "+v"(tid));
    const int wid = __builtin_amdgcn_readfirstlane(tid >> 6), lane = tid & 63, wr = wid >> 2, wc = wid & 3, fr = lane & 15, fq = lane >> 4;
    const int K = g.K, nt = K / BK;
    unsigned voffA[2], voffB[2];
#pragma unroll
    for (int i = 0; i < 2; ++i) { int R, C; stage_rc(tid * 16 + i * 8192, R, C); const int Rb = Epi::PERM ? ((R & ~31) + perm32(R & 31)) : R;
        voffA[i] = (unsigned)(R * K + C) * 2u; voffB[i] = (unsigned)(Rb * K + C) * 2u; }
    const size_t kstep = (size_t)(BK * 2);
    const size_t hstep = (size_t)HALF * K * 2;
    const size_t tstep = 2 * hstep;
    const size_t tstepA = HALFM ? hstep : tstep;
    const unsigned ldsw = (unsigned)wid * 1024u;
    const int aoff = lds_byte(wr * 64 + fr, fq * 8), boff = lds_byte(wc * 32 + fr, fq * 8);
#define PG8_SA(b, h) (((b) * 2 + (h)) * HTB)
#define PG8_SB(b, h) ((4 + (b) * 2 + (h)) * HTB)
#define PG8_STAGE(bufoff, gbase, voff) do { _Pragma("unroll") for (int _i = 0; _i < 2; ++_i) \
        __builtin_amdgcn_global_load_lds((const unsigned*)((const char*)(gbase) + (voff)[_i]), (PG8_LAS unsigned*)(lds + (bufoff) + ldsw + _i * 8192), 16, 0, 0); } while (0)
#define PG8_LDA(dst, b, h) do { _Pragma("unroll") for (int m = 0; m < 4; ++m) _Pragma("unroll") for (int k = 0; k < 2; ++k) dst[m][k] = *(const PG8_LAS bf16x8*)(lds + PG8_SA(b, h) + aoff + m * 2048 + k * 1024); } while (0)
#define PG8_LDB(dst, b, h) do { _Pragma("unroll") for (int n = 0; n < 2; ++n) _Pragma("unroll") for (int k = 0; k < 2; ++k) dst[n][k] = *(const PG8_LAS bf16x8*)(lds + PG8_SB(b, h) + boff + n * 2048 + k * 1024); } while (0)
#define PG8_MMA(ai, bj, At, Bt) do { __builtin_amdgcn_s_setprio(1); _Pragma("unroll") for (int m = 0; m < 4; ++m) _Pragma("unroll") for (int n = 0; n < 2; ++n) _Pragma("unroll") for (int k = 0; k < 2; ++k) \
        acc[ai][bj][m][n] = __builtin_amdgcn_mfma_f32_16x16x32_bf16(Bt[n][k], At[m][k], acc[ai][bj][m][n], 0, 0, 0); __builtin_amdgcn_s_setprio(0); } while (0)
#define PG8_WAIT_V(n) asm volatile("s_waitcnt vmcnt(" #n ")" ::: "memory")
#define PG8_WAIT_L(n) asm volatile("s_waitcnt lgkmcnt(" #n ")" ::: "memory")
#define PG8_BAR __builtin_amdgcn_s_barrier()
#define PG8_SCHED __builtin_amdgcn_sched_barrier(0)
    Unit cur, nxt; int ui = 0;
    if (!S.next(0, cur)) return;
    f32x4 acc[2][2][4][2];
#pragma unroll
    for (int a = 0; a < 2; ++a)
#pragma unroll
        for (int b = 0; b < 2; ++b)
#pragma unroll
            for (int m = 0; m < 4; ++m)
#pragma unroll
                for (int n = 0; n < 2; ++n) acc[a][b][m][n] = (f32x4){0.f, 0.f, 0.f, 0.f};
    bf16x8 At[4][2], B0[2][2], B1[2][2];
    const char* cA = (const char*)g.A + (size_t)cur.pm * tstepA; const char* cB = (const char*)g.Bt + (size_t)cur.pn * tstep;
    S.a_ready(cur);
    if constexpr (SP2) {
        PG8_STAGE(PG8_SB(0, 0), cB, voffB); PG8_STAGE(PG8_SB(0, 1), cB + hstep, voffB); PG8_STAGE(PG8_SA(0, 0), cA, voffA); PG8_STAGE(PG8_SA(0, 1), cA + hstep, voffA);
        if (wr == 1) PG8_BAR;
        PG8_WAIT_V(2); PG8_BAR;
        PG8_STAGE(PG8_SB(1, 0), cB + kstep, voffB); PG8_STAGE(PG8_SA(1, 0), cA + kstep, voffA); PG8_STAGE(PG8_SB(1, 1), cB + hstep + kstep, voffB);
        PG8_WAIT_V(6); PG8_BAR;
    } else {
        PG8_STAGE(PG8_SB(0, 0), cB, voffB); PG8_STAGE(PG8_SA(0, 0), cA, voffA); PG8_STAGE(PG8_SB(0, 1), cB + hstep, voffB); PG8_STAGE(PG8_SA(0, 1), cA + hstep, voffA);
        if (wr == 1) PG8_BAR;
        PG8_WAIT_V(4); PG8_BAR;
        PG8_STAGE(PG8_SB(1, 0), cB + kstep, voffB); PG8_STAGE(PG8_SA(1, 0), cA + kstep, voffA); PG8_STAGE(PG8_SB(1, 1), cB + hstep + kstep, voffB);
        PG8_WAIT_V(6); PG8_BAR;
    }
    for (;;) {
        const bool has_next = S.next(ui + 1, nxt);
        const char* nA = has_next ? (const char*)g.A + (size_t)nxt.pm * tstepA : cA; const char* nB = has_next ? (const char*)g.Bt + (size_t)nxt.pn * tstep : cB;
        for (int t = 0; t < nt; t += 2) {
            const bool last = (t == nt - 2);
            const char* a1 = cA + (size_t)(t + 1) * kstep;
            const char* a2 = last ? nA : cA + (size_t)(t + 2) * kstep; const char* b2 = last ? nB : cB + (size_t)(t + 2) * kstep;
            const char* a3 = a2 + kstep; const char* b3 = b2 + kstep;
            if (last && has_next) S.a_ready(nxt);
            if constexpr (SP2) {
            PG8_LDB(B0, 0, 0); PG8_LDB(B1, 0, 1); PG8_SCHED; PG8_LDA(At, 0, 0); PG8_STAGE(PG8_SA(1, 1), a1 + hstep, voffA);
            PG8_WAIT_V(8); PG8_WAIT_L(0); PG8_BAR; PG8_MMA(0, 0, At, B0); PG8_MMA(0, 1, At, B1); PG8_BAR; PG8_SCHED;
            if constexpr (!HALFM) { PG8_LDA(At, 0, 1); } PG8_STAGE(PG8_SB(0, 0), b2, voffB); PG8_STAGE(PG8_SB(0, 1), b2 + hstep, voffB); PG8_STAGE(PG8_SA(0, 0), a2, voffA);
            PG8_WAIT_V(8); PG8_WAIT_L(0); PG8_BAR; if constexpr (!HALFM) { PG8_MMA(1, 0, At, B0); PG8_MMA(1, 1, At, B1); } PG8_BAR; PG8_SCHED;
            PG8_LDB(B0, 1, 0); PG8_LDB(B1, 1, 1); PG8_SCHED; PG8_LDA(At, 1, 0); PG8_STAGE(PG8_SA(0, 1), a2 + hstep, voffA);
            PG8_WAIT_V(8); PG8_WAIT_L(0); PG8_BAR; PG8_MMA(0, 0, At, B0); PG8_MMA(0, 1, At, B1); PG8_BAR; PG8_SCHED;
            if constexpr (!HALFM) { PG8_LDA(At, 1, 1); } PG8_STAGE(PG8_SB(1, 0), b3, voffB); PG8_STAGE(PG8_SB(1, 1), b3 + hstep, voffB); PG8_STAGE(PG8_SA(1, 0), a3, voffA);
            PG8_WAIT_V(8); PG8_WAIT_L(0); PG8_BAR; if constexpr (!HALFM) { PG8_MMA(1, 0, At, B0); PG8_MMA(1, 1, At, B1); } PG8_BAR; PG8_SCHED;
            } else {
            PG8_LDB(B0, 0, 0); PG8_SCHED; PG8_LDA(At, 0, 0); PG8_STAGE(PG8_SA(1, 1), a1 + hstep, voffA);
            PG8_WAIT_L(8); PG8_BAR; PG8_WAIT_L(0); PG8_MMA(0, 0, At, B0); PG8_BAR; PG8_SCHED;
            PG8_LDB(B1, 0, 1); PG8_STAGE(PG8_SB(0, 0), b2, voffB);
            PG8_BAR; PG8_WAIT_L(0); PG8_MMA(0, 1, At, B1); PG8_BAR;
            PG8_LDA(At, 0, 1); PG8_STAGE(PG8_SA(0, 0), a2, voffA);
            PG8_BAR; PG8_WAIT_L(0); PG8_MMA(1, 0, At, B0); PG8_BAR; PG8_SCHED;
            PG8_STAGE(PG8_SB(0, 1), b2 + hstep, voffB);
            PG8_WAIT_V(6); PG8_BAR; PG8_MMA(1, 1, At, B1); PG8_BAR;
            PG8_LDB(B0, 1, 0); PG8_SCHED; PG8_LDA(At, 1, 0); PG8_STAGE(PG8_SA(0, 1), a2 + hstep, voffA);
            PG8_WAIT_L(8); PG8_BAR; PG8_WAIT_L(0); PG8_MMA(0, 0, At, B0); PG8_BAR; PG8_SCHED;
            PG8_LDB(B1, 1, 1); PG8_STAGE(PG8_SB(1, 0), b3, voffB);
            PG8_BAR; PG8_WAIT_L(0); PG8_MMA(0, 1, At, B1); PG8_BAR;
            PG8_LDA(At, 1, 1); PG8_STAGE(PG8_SA(1, 0), a3, voffA);
            PG8_BAR; PG8_WAIT_L(0); PG8_MMA(1, 0, At, B0); PG8_BAR; PG8_SCHED;
            PG8_STAGE(PG8_SB(1, 1), b3 + hstep, voffB);
            PG8_WAIT_V(6); PG8_BAR; PG8_MMA(1, 1, At, B1); PG8_BAR;
            }
        }
        if constexpr (ALIGN_EPI) { if (wr == 0) PG8_BAR; }
        if constexpr (!Epi::AFTER_DRAIN) { E(acc, cur, wr, wc, fr, fq); S.done(cur); }
        if (!has_next) break;
#pragma unroll
        for (int a = 0; a < 2; ++a)
#pragma unroll
            for (int b = 0; b < 2; ++b)
#pragma unroll
                for (int m = 0; m < 4; ++m)
#pragma unroll
                    for (int n = 0; n < 2; ++n) acc[a][b][m][n] = (f32x4){0.f, 0.f, 0.f, 0.f};
        cur = nxt; cA = nA; cB = nB; ++ui;
        if constexpr (ALIGN_EPI) { if (wr == 1) PG8_BAR; }
    }
    PG8_WAIT_V(0);
    if constexpr (!ALIGN_EPI) { if (wr == 0) PG8_BAR; }
    PG8_BAR;
    if constexpr (Epi::AFTER_DRAIN) { E.fused(acc, cur, wr, wc, fr, fq, lds, wid, lane); S.done(cur); }
#undef PG8_SA
#undef PG8_SB
#undef PG8_STAGE
#undef PG8_LDA
#undef PG8_LDB
#undef PG8_MMA
#undef PG8_WAIT_V
#undef PG8_WAIT_L
#undef PG8_BAR
#undef PG8_SCHED
}
}

constexpr int D = 2048, BATCH = 4, SEQ = 2048, MP = BATCH * SEQ, SB = 32;
constexpr int INW = 12288, INDIM = 12352, CONVD = 8192, VALD = 4096, FF = 5632, GU = 2 * FF;
constexpr int NCH = 32;
constexpr float EPS = 1e-6f;
constexpr float LOG2E = 1.4426950408889634f;
constexpr float QSCALE = 0.125f * LOG2E;
constexpr int NWAVES = 8, NTHR = 512;

constexpr size_t MiB = 1u << 20;
constexpr size_t WS_CTL = 0, CTL_ZERO_BYTES = 4 * MiB;
constexpr size_t WS_WIN = 4 * MiB;
constexpr size_t WS_WBA = 100 * MiB;
constexpr size_t WS_WOUT = 101 * MiB;
constexpr size_t WS_WGU = 133 * MiB;
constexpr size_t WS_WDN = 309 * MiB;
constexpr size_t WS_WQKV = 397 * MiB;
constexpr size_t WS_WQ1 = 407 * MiB;
constexpr size_t WS_WO = 415 * MiB;
constexpr size_t WS_X = 431 * MiB;
constexpr size_t WS_XB = 495 * MiB;
constexpr size_t WS_PROJ = 527 * MiB;
constexpr size_t WS_BETA = 719 * MiB;
constexpr size_t WS_G = 720 * MiB;
constexpr size_t WS_PREPA = 721 * MiB;
constexpr size_t WS_PREPU = 945 * MiB;
constexpr size_t WS_EGL = 1009 * MiB;
constexpr size_t WS_OG = 1010 * MiB;
constexpr size_t WS_MID = 1074 * MiB;
constexpr size_t WS_Q = 1162 * MiB;
constexpr size_t WS_K = 1194 * MiB;
constexpr size_t WS_VT = 1198 * MiB;
constexpr size_t WS_AO = 1202 * MiB;
constexpr size_t WS_SMP = 1234 * MiB;
constexpr size_t WS_SSQP = 1242 * MiB;
constexpr size_t WS_SSQSP = 1251 * MiB;
constexpr size_t WS_END = 1252 * MiB;
constexpr size_t SM_XS = 0;
constexpr size_t SM_XSB = 262144;
constexpr size_t SM_PROJS = 393216;
constexpr size_t SM_QKVS = 2 * MiB;
constexpr size_t SM_BETAS = 3 * MiB;
constexpr size_t SM_GS = 3 * MiB + 4096;
constexpr size_t SM_OGS = 3 * MiB + 8192;
constexpr size_t SM_MIDS = 4 * MiB;
constexpr size_t SM_QS = 5 * MiB;
constexpr size_t SM_KVS = 5 * MiB + 262144;
constexpr size_t SM_AOS = 6 * MiB;
constexpr int CW_BAR = 4096;
constexpr int CW_SSQ = 16384;
constexpr int CW_SSQS = 16384 + 9 * 8192;
constexpr int PREPA_REC = 57344, PREPU_REC = 16384;

constexpr int LDS_BYTES = 147456, MISC_OFF = LDS_BYTES - 256;

#define GAS __attribute__((address_space(1)))
#define LAS __attribute__((address_space(3)))
typedef unsigned short bf16_t;
typedef unsigned u32x4 __attribute__((ext_vector_type(4)));
typedef unsigned u32x2 __attribute__((ext_vector_type(2)));
typedef float f32x4 __attribute__((ext_vector_type(4)));
typedef float f32x16 __attribute__((ext_vector_type(16)));
typedef short bf16x8 __attribute__((ext_vector_type(8)));
typedef short bf16x4 __attribute__((ext_vector_type(4)));
#define LDS_WAIT() asm volatile("s_waitcnt lgkmcnt(0)" ::: "memory")
#define VM_WAIT() asm volatile("s_waitcnt vmcnt(0)" ::: "memory")
#define MFMA16(a, b, c) __builtin_amdgcn_mfma_f32_16x16x32_bf16((a), (b), (c), 0, 0, 0)
#define MFMA32(a, b, c) __builtin_amdgcn_mfma_f32_32x32x16_bf16((a), (b), (c), 0, 0, 0)

__device__ __forceinline__ float bf2f(bf16_t v) { return __uint_as_float((unsigned)v << 16); }
typedef float f32x2_t __attribute__((ext_vector_type(2))); typedef __bf16 bf16x2_t __attribute__((ext_vector_type(2)));
__device__ __forceinline__ unsigned pk2(float lo, float hi) { const f32x2_t v = {lo, hi}; const bf16x2_t b = __builtin_convertvector(v, bf16x2_t); return __builtin_bit_cast(unsigned, b); }
__device__ __forceinline__ bf16_t f2bf(float f) { return (bf16_t)(pk2(f, 0.f) & 0xffffu); }
__device__ __forceinline__ float fast_exp2(float x) { return __builtin_amdgcn_exp2f(x); }
__device__ __forceinline__ float fast_exp(float x) { return __builtin_amdgcn_exp2f(x * LOG2E); }
__device__ __forceinline__ float fast_rcp(float x) { return __builtin_amdgcn_rcpf(x); }
__device__ __forceinline__ float silu_f(float x) { return x * fast_rcp(1.0f + fast_exp(-x)); }
__device__ __forceinline__ float fast_rsq(float x) { return __builtin_amdgcn_rsqf(x); }
__device__ __forceinline__ float fast_log2(float x) { return __builtin_amdgcn_logf(x); }
__device__ __forceinline__ float sigmoid_f(float x) { return fast_rcp(1.0f + fast_exp(-x)); }
__device__ __forceinline__ float softplus_f(float x) { return x > 15.f ? x : fast_log2(1.0f + fast_exp(x)) * 0.6931471805599453f; }
__device__ __forceinline__ float rinv_of(float ssq) { return fast_rsq(ssq * (1.0f / D) + EPS); }
__device__ __forceinline__ float wave_sum(float v) {
#pragma unroll
    for (int o = 1; o < 64; o <<= 1) v += __shfl_xor(v, o);
    return v;
}
__device__ __forceinline__ float rinv_row4(const float* ssqp, int row, int fq) {
    const f32x4* p = (const f32x4*)(ssqp + (size_t)row * 32 + 8 * fq); const f32x4 a = p[0], b = p[1];
    float s = ((a[0] + a[1]) + (a[2] + a[3])) + ((b[0] + b[1]) + (b[2] + b[3]));
    s += __shfl_xor(s, 16); s += __shfl_xor(s, 32);
    return rinv_of(s);
}
__device__ __forceinline__ float rinv_row_full(const float* ssqp, int row) {
    const f32x4* p = (const f32x4*)(ssqp + (size_t)row * 32); float s = 0.f;
#pragma unroll
    for (int i = 0; i < 8; ++i) { const f32x4 a = p[i]; s += (a[0] + a[1]) + (a[2] + a[3]); }
    return rinv_of(s);
}
__device__ __forceinline__ int crow32(int r, int hi) { return (r & 3) + 8 * (r >> 2) + 4 * hi; }

namespace pg8 {
struct EpiProj {
    static constexpr bool PERM = true, AFTER_DRAIN = false;
    bf16_t* O; int ldc; const float* ssq; int silu_from;
    __device__ __forceinline__ void operator()(const f32x4 (&acc)[2][2][4][2], const Unit& u, int wr, int wc, int fr, int fq) const {
        asm volatile("" : "+v"(fr), "+v"(fq));
        const int row0 = u.pm * BM + wr * 64 + fr, col0 = u.pn * BM + wc * 32 + 8 * fq;
#pragma unroll
        for (int ai = 0; ai < 2; ++ai)
#pragma unroll
            for (int m = 0; m < 4; ++m) { const int row = row0 + ai * HALF + m * 16; const float ri = rinv_row4(ssq, row, fq); bf16_t* rowp = O + (size_t)row * ldc + col0;
#pragma unroll
                for (int bj = 0; bj < 2; ++bj) { f32x4 v0 = acc[ai][bj][m][0] * ri, v1 = acc[ai][bj][m][1] * ri;
                    if (u.pn >= silu_from) {
#pragma unroll
                        for (int e = 0; e < 4; ++e) { v0[e] = silu_f(v0[e]); v1[e] = silu_f(v1[e]); } }
                    u32x4 w; w.x = cvt_pk_bf16(v0[0], v0[1]); w.y = cvt_pk_bf16(v0[2], v0[3]); w.z = cvt_pk_bf16(v1[0], v1[1]); w.w = cvt_pk_bf16(v1[2], v1[3]);
                    *(u32x4*)(rowp + bj * HALF) = w; } }
    }
};
struct EpiRes {
    static constexpr bool PERM = true, AFTER_DRAIN = false;
    const float* base; float* X; bf16_t* XB; float* ssq;
    __device__ __forceinline__ void operator()(const f32x4 (&acc)[2][2][4][2], const Unit& u, int wr, int wc, int fr, int fq) const {
        asm volatile("" : "+v"(fr), "+v"(fq));
        const int row0 = u.pm * BM + wr * 64 + fr, col0 = u.pn * BM + wc * 32 + 8 * fq;
#pragma unroll
        for (int ai = 0; ai < 2; ++ai)
#pragma unroll
            for (int m = 0; m < 4; ++m) { const int row = row0 + ai * HALF + m * 16; const size_t off = (size_t)row * D + col0; float s = 0.f;
#pragma unroll
                for (int bj = 0; bj < 2; ++bj) { const f32x4 b0 = *(const f32x4*)(base + off + bj * HALF), b1 = *(const f32x4*)(base + off + bj * HALF + 4);
                    const f32x4 v0 = acc[ai][bj][m][0] + b0, v1 = acc[ai][bj][m][1] + b1;
                    *(f32x4*)(X + off + bj * HALF) = v0; *(f32x4*)(X + off + bj * HALF + 4) = v1;
                    u32x4 w; w.x = cvt_pk_bf16(v0[0], v0[1]); w.y = cvt_pk_bf16(v0[2], v0[3]); w.z = cvt_pk_bf16(v1[0], v1[1]); w.w = cvt_pk_bf16(v1[2], v1[3]);
                    *(u32x4*)(XB + off + bj * HALF) = w;
                    s += (v0[0] * v0[0] + v0[1] * v0[1]) + (v0[2] * v0[2] + v0[3] * v0[3]) + (v1[0] * v1[0] + v1[1] * v1[1]) + (v1[2] * v1[2] + v1[3] * v1[3]); }
                s += __shfl_xor(s, 16); s += __shfl_xor(s, 32);
                if (fq == 0) ssq[(size_t)row * 32 + u.pn * 4 + wc] = s; }
    }
};
template <bool HALFM> struct EpiSwigluT {
    static constexpr bool PERM = true, AFTER_DRAIN = false;
    bf16_t* O; const float* ssq;
    __device__ __forceinline__ void operator()(const f32x4 (&acc)[2][2][4][2], const Unit& u, int wr, int wc, int fr, int fq) const {
        asm volatile("" : "+v"(fr), "+v"(fq));
        const int row0 = u.pm * (HALFM ? HALF : BM) + wr * 64 + fr, col0 = u.pn * HALF + wc * 32 + 8 * fq;
#pragma unroll
        for (int ai = 0; ai < (HALFM ? 1 : 2); ++ai)
#pragma unroll
            for (int m = 0; m < 4; ++m) { const int row = row0 + ai * HALF + m * 16; const float ri = rinv_row4(ssq, row, fq); float o[8];
#pragma unroll
                for (int n = 0; n < 2; ++n)
#pragma unroll
                    for (int e = 0; e < 4; ++e) { const float g = acc[ai][0][m][n][e] * ri, up = acc[ai][1][m][n][e] * ri; o[4 * n + e] = silu_f(g) * up; }
                u32x4 w; w.x = cvt_pk_bf16(o[0], o[1]); w.y = cvt_pk_bf16(o[2], o[3]); w.z = cvt_pk_bf16(o[4], o[5]); w.w = cvt_pk_bf16(o[6], o[7]);
                *(u32x4*)(O + (size_t)row * FF + col0) = w; }
    }
};
template <bool HALFM> struct EpiQKVT {
    static constexpr bool PERM = true, AFTER_DRAIN = false;
    bf16_t* Q; bf16_t* KB; bf16_t* VT; float* kwin; float* vwin; const float* ssq;
    __device__ __forceinline__ void operator()(const f32x4 (&acc)[2][2][4][2], const Unit& u, int wr, int wc, int fr, int fq) const {
        asm volatile("" : "+v"(fr), "+v"(fq));
        const int row0 = u.pm * (HALFM ? HALF : BM) + wr * 64 + fr, cl0 = wc * 32 + 8 * fq;
#pragma unroll
        for (int ai = 0; ai < (HALFM ? 1 : 2); ++ai)
#pragma unroll
            for (int m = 0; m < 4; ++m) { const int row = row0 + ai * HALF + m * 16; const float ri = rinv_row4(ssq, row, fq); const int b = row >> 11, t = row & 2047;
#pragma unroll
                for (int bj = 0; bj < 2; ++bj) { const f32x4 v0 = acc[ai][bj][m][0] * ri, v1 = acc[ai][bj][m][1] * ri; const int cl = cl0 + bj * HALF;
                    if (u.pn < 8) {
                        u32x4 w; w.x = cvt_pk_bf16(v0[0], v0[1]); w.y = cvt_pk_bf16(v0[2], v0[3]); w.z = cvt_pk_bf16(v1[0], v1[1]); w.w = cvt_pk_bf16(v1[2], v1[3]);
                        *(u32x4*)(Q + (size_t)row * D + u.pn * BM + cl) = w;
                    } else if (u.pn == 8) {
                        u32x4 w; w.x = cvt_pk_bf16(v0[0], v0[1]); w.y = cvt_pk_bf16(v0[2], v0[3]); w.z = cvt_pk_bf16(v1[0], v1[1]); w.w = cvt_pk_bf16(v1[2], v1[3]);
                        *(u32x4*)(KB + (size_t)row * 256 + cl) = w;
                        if (t >= SEQ - 128) { float* o = kwin + ((size_t)(b * 128 + t - (SEQ - 128))) * 256 + cl; *(f32x4*)o = v0; *(f32x4*)(o + 4) = v1; }
                    } else {
                        const float vv[8] = {v0[0], v0[1], v0[2], v0[3], v1[0], v1[1], v1[2], v1[3]};
#pragma unroll
                        for (int e = 0; e < 8; ++e) { const int c = cl + e; VT[((size_t)(b * 4 + (c >> 6)) * 64 + (c & 63)) * SEQ + t] = (bf16_t)(cvt_pk_bf16(vv[e], 0.f) & 0xffffu); }
                        if (t >= SEQ - 128) { float* o = vwin + ((size_t)(b * 128 + t - (SEQ - 128))) * 256 + cl; *(f32x4*)o = v0; *(f32x4*)(o + 4) = v1; }
                    } } }
    }
};
}

struct TrItem { const float* src; bf16_t* dst; const float* gain; int ld, col0, K, k0, drow0; float scale; };
__device__ __forceinline__ void tr_load(const TrItem& T, f32x4 (&v)[16], float (&g)[16], int lane) {
#pragma unroll
    for (int i = 0; i < 16; ++i) {
        const int kk = 4 * i + (lane >> 4);
        v[i] = *(const f32x4*)(T.src + (size_t)(T.k0 + kk) * T.ld + T.col0 + 4 * (lane & 15));
        g[i] = T.gain ? T.gain[T.k0 + kk] : 1.0f;
    }
}
__device__ __forceinline__ void tr_store(const TrItem& T, const f32x4 (&v)[16], const float (&g)[16], LAS float* scr, int lane) {
#pragma unroll
    for (int i = 0; i < 16; ++i) {
        const int kk = 4 * i + (lane >> 4); const float gg = g[i] * T.scale;
        LAS float* p = scr + kk * 65 + 4 * (lane & 15);
        p[0] = v[i][0] * gg; p[1] = v[i][1] * gg; p[2] = v[i][2] * gg; p[3] = v[i][3] * gg;
    }
    LDS_WAIT();
#pragma unroll
    for (int j = 0; j < 8; ++j) {
        const int idx = j * 64 + lane, n = idx >> 3, kc = idx & 7;
        const LAS float* s = scr + (8 * kc) * 65 + n;
        u32x4 o; o.x = pk2(s[0], s[65]); o.y = pk2(s[2 * 65], s[3 * 65]); o.z = pk2(s[4 * 65], s[5 * 65]); o.w = pk2(s[6 * 65], s[7 * 65]);
        *(u32x4*)(T.dst + (size_t)(T.drow0 + n) * T.K + T.k0 + 8 * kc) = o;
    }
    LDS_WAIT();
}

typedef const float* const __attribute__((address_space(4)))* KP_T;
constexpr int CV_IN = 32 * 192, CV_BA = 32, CV_OUT = 64 * 32, CV_GU = 32 * 176, CV_DN = 88 * 32, CV_KV = 32 * 8, CV_Q = 32 * 32;
constexpr int CV_A = CV_IN + CV_BA + CV_OUT + CV_GU + CV_DN;
constexpr int CV_B0 = CV_KV + 2 * CV_Q + CV_GU + CV_DN;
constexpr int CV_B1 = 2 * CV_Q + CV_GU + CV_DN;
__host__ __device__ constexpr int cv_count(int lam) { return lam < 2 ? CV_A : (lam == 2 ? CV_B0 : CV_B1); }
__device__ __forceinline__ TrItem tr_decode(KP_T kp, unsigned char* ws, int lam, int r) {
    TrItem T; T.scale = 1.f; T.gain = nullptr;
    const float* w_gu_ = kp[20] + (size_t)lam * D * GU; const float* w_dn_ = kp[21] + (size_t)lam * FF * D;
    bf16_t* WGU = (bf16_t*)(ws + WS_WGU) + (size_t)lam * GU * D; bf16_t* WDN = (bf16_t*)(ws + WS_WDN) + (size_t)lam * D * FF;
    if (lam < 2) {
        const float* w_in_ = kp[8] + (size_t)lam * D * INDIM; const float* nm = kp[6] + lam * D;
        if (r < CV_IN) { const int kb = r / 192, nb = r % 192;
            T.src = w_in_; T.ld = INDIM; T.col0 = 64 * nb; T.K = D; T.k0 = 64 * kb; T.dst = (bf16_t*)(ws + WS_WIN) + (size_t)lam * INW * D; T.drow0 = 64 * nb; T.gain = nm; return T; } r -= CV_IN;
        if (r < CV_BA) { T.src = w_in_; T.ld = INDIM; T.col0 = INW; T.K = D; T.k0 = 64 * r; T.dst = (bf16_t*)(ws + WS_WBA) + (size_t)lam * 64 * D; T.drow0 = 0; T.gain = nm; return T; } r -= CV_BA;
        if (r < CV_OUT) { const int kb = r / 32, nb = r % 32;
            T.src = kp[13] + (size_t)lam * VALD * D; T.ld = D; T.col0 = 64 * nb; T.K = VALD; T.k0 = 64 * kb; T.dst = (bf16_t*)(ws + WS_WOUT) + (size_t)lam * D * VALD; T.drow0 = 64 * nb; return T; } r -= CV_OUT;
    } else {
        const int j = lam - 2;
        if (j == 0) { if (r < CV_KV) { const int kb = r / 8, nb = r % 8;
            T.src = kp[15]; T.ld = 512; T.col0 = 64 * nb; T.K = D; T.k0 = 64 * kb; T.dst = (bf16_t*)(ws + WS_WQKV); T.drow0 = 2048 + 64 * nb; T.gain = kp[14]; return T; } r -= CV_KV; }
        if (r < CV_Q) { const int kb = r / 32, nb = r % 32;
            T.src = kp[16] + (size_t)j * D * D; T.ld = D; T.col0 = 64 * nb; T.K = D; T.k0 = 64 * kb; T.dst = (bf16_t*)(ws + (j == 0 ? WS_WQKV : WS_WQ1)); T.drow0 = 64 * nb; T.gain = kp[6] + (2 + j) * D; T.scale = QSCALE; return T; } r -= CV_Q;
        if (r < CV_Q) { const int kb = r / 32, nb = r % 32;
            T.src = kp[17] + (size_t)j * D * D; T.ld = D; T.col0 = 64 * nb; T.K = D; T.k0 = 64 * kb; T.dst = (bf16_t*)(ws + WS_WO) + (size_t)j * D * D; T.drow0 = 64 * nb; return T; } r -= CV_Q;
    }
    if (r < CV_GU) { const int kb = r / 176, nb = r % 176; const int c = 64 * nb;
        T.src = w_gu_; T.ld = GU; T.col0 = c; T.K = D; T.k0 = 64 * kb; T.dst = WGU;
        T.drow0 = c < FF ? 256 * (c >> 7) + (c & 127) : 256 * ((c - FF) >> 7) + 128 + ((c - FF) & 127); T.gain = kp[7] + lam * D; return T; } r -= CV_GU;
    { const int kb = r / 32, nb = r % 32;
        T.src = w_dn_; T.ld = D; T.col0 = 64 * nb; T.K = FF; T.k0 = 64 * kb; T.dst = WDN; T.drow0 = 64 * nb; return T; }
}
__device__ __forceinline__ void convert_range(KP_T kp, unsigned char* ws, int lam, int first, int count, int worker, int nworkers, LAS float* scr, int lane) {
    f32x4 va[16], vb[16]; float ga[16], gb[16];
    int it = worker;
    TrItem Ta = tr_decode(kp, ws, lam, first + (it < count ? it : 0)), Tb = Ta;
    if (it < count) tr_load(Ta, va, ga, lane);
    for (; it < count; it += 2 * nworkers) {
        const bool hb = it + nworkers < count;
        if (hb) { Tb = tr_decode(kp, ws, lam, first + it + nworkers); tr_load(Tb, vb, gb, lane); }
        __builtin_amdgcn_sched_barrier(0);
        tr_store(Ta, va, ga, scr, lane);
        const bool ha = it + 2 * nworkers < count;
        if (ha) { Ta = tr_decode(kp, ws, lam, first + it + 2 * nworkers); tr_load(Ta, va, ga, lane); }
        __builtin_amdgcn_sched_barrier(0);
        if (hb) tr_store(Tb, vb, gb, scr, lane);
    }
}

__device__ __forceinline__ void row_to_bf16(const float* __restrict__ xrow, bf16_t* __restrict__ orow, float* ssq_out, int npart, int lane) {
    const f32x4* xr = (const f32x4*)xrow + lane;
    f32x4 v[8]; float s = 0.f;
#pragma unroll
    for (int j = 0; j < 8; ++j) { v[j] = xr[64 * j]; s += (v[j][0] * v[j][0] + v[j][1] * v[j][1]) + (v[j][2] * v[j][2] + v[j][3] * v[j][3]); }
    s = wave_sum(s);
    if (lane < npart) ssq_out[lane] = lane == 0 ? s : 0.f;
    u32x2* o8 = (u32x2*)orow + lane;
#pragma unroll
    for (int j = 0; j < 8; ++j) { u32x2 w; w.x = pk2(v[j][0], v[j][1]); w.y = pk2(v[j][2], v[j][3]); o8[64 * j] = w; }
}

template <bool PAIR, class F>
__device__ __forceinline__ void skinny_unit(const bf16_t* __restrict__ A, int lda, const bf16_t* __restrict__ B0, const bf16_t* __restrict__ B1, int ldb, int K,
                                            LAS float* red, int wid, int lane, int tid, F&& epi) {
    asm volatile("" : "+v"(tid), "+v"(lane));
    const int kw = K >> 3, kbeg = wid * kw;
    f32x16 acc0, acc1;
#pragma unroll
    for (int r = 0; r < 16; ++r) { acc0[r] = 0.f; acc1[r] = 0.f; }
    const bf16_t* ap = A + (size_t)(lane & 31) * lda + kbeg + 8 * (lane >> 5);
    const bf16_t* bp0 = B0 + (size_t)(lane & 31) * ldb + kbeg + 8 * (lane >> 5);
    const bf16_t* bp1 = (PAIR ? B1 : B0) + (size_t)(lane & 31) * ldb + kbeg + 8 * (lane >> 5);
    bf16x8 fa[4], fb0[4], fb1[4], ga[4], gb0[4], gb1[4];
#pragma unroll
    for (int i = 0; i < 4; ++i) { fa[i] = *(const bf16x8*)(ap + 16 * i); fb0[i] = *(const bf16x8*)(bp0 + 16 * i); if (PAIR) fb1[i] = *(const bf16x8*)(bp1 + 16 * i); }
    for (int k = 0; k < kw; k += 64) {
        const int kn = k + 64 < kw ? k + 64 : k;
#pragma unroll
        for (int i = 0; i < 4; ++i) { ga[i] = *(const bf16x8*)(ap + kn + 16 * i); gb0[i] = *(const bf16x8*)(bp0 + kn + 16 * i); if (PAIR) gb1[i] = *(const bf16x8*)(bp1 + kn + 16 * i); }
        __builtin_amdgcn_sched_barrier(0);
#pragma unroll
        for (int i = 0; i < 4; ++i) { acc0 = MFMA32(fa[i], fb0[i], acc0); if (PAIR) acc1 = MFMA32(fa[i], fb1[i], acc1); }
        __builtin_amdgcn_sched_barrier(0);
#pragma unroll
        for (int i = 0; i < 4; ++i) { fa[i] = ga[i]; fb0[i] = gb0[i]; if (PAIR) fb1[i] = gb1[i]; }
    }
#pragma unroll
    for (int r = 0; r < 16; ++r) { red[((wid * 2 + 0) * 16 + r) * 64 + lane] = acc0[r]; if (PAIR) red[((wid * 2 + 1) * 16 + r) * 64 + lane] = acc1[r]; }
    __syncthreads();
#pragma unroll
    for (int q = 0; q < 2; ++q) {
        const int e = tid + 512 * q, r = e >> 6, ln = e & 63;
        float v0 = 0.f, v1 = 0.f;
#pragma unroll
        for (int w = 0; w < 8; ++w) { v0 += red[((w * 2 + 0) * 16 + r) * 64 + ln]; if (PAIR) v1 += red[((w * 2 + 1) * 16 + r) * 64 + ln]; }
        epi(crow32(r, ln >> 5), ln & 31, v0, v1);
    }
    __syncthreads();
}

constexpr int PL_QN = 0, PL_KN = 18432, PL_KT = 36864, PL_VT = 55296, PL_AM = 92160, PL_TAB = 126976;
constexpr int PL_T = 0, PL_TP = 18432;
constexpr int NAT_LD = 136, TR_LD = 72, AM_LD = 68;


__host__ __device__ constexpr int ti_q(int idx) { int q = 0; while ((q + 1) * (q + 2) / 2 <= idx) ++q; return q; }
template <int IDX> __device__ __forceinline__ void ti_load(const LAS float* A, f32x4 (&buf)[4][4]) {
    constexpr int q = ti_q(IDX), g = IDX - q * (q + 1) / 2;
#pragma unroll
    for (int r = 0; r < 4; ++r) buf[IDX % 4][r] = *(const LAS f32x4*)(A + (4 * q + r) * AM_LD + 4 * g);
}
template <int IDX, int END> __device__ __forceinline__ void ti_prologue(const LAS float* A, f32x4 (&buf)[4][4]) {
    if constexpr (IDX < END) { ti_load<IDX>(A, buf); ti_prologue<IDX + 1, END>(A, buf); }
}
typedef float f32x2v __attribute__((ext_vector_type(2)));
template <int IDX, int END, int DEPTH> __device__ __forceinline__ void ti_steps(const LAS float* A, f32x4 (&buf)[4][4], f32x2v (&tn)[32], f32x2v (&acc)[4], int c) {
    if constexpr (IDX < END) {
        constexpr int q = ti_q(IDX), g = IDX - q * (q + 1) / 2;
        __builtin_amdgcn_sched_barrier(0);
        if constexpr (g == 0) {
#pragma unroll
            for (int r = 0; r < 4; ++r) acc[r] = (f32x2v){(c == 4 * q + r) ? 1.f : 0.f, 0.f};
        }
        if constexpr (g < q) {
#pragma unroll
            for (int r = 0; r < 4; ++r) { const f32x4 av = buf[IDX % 4][r];
                acc[r] = __builtin_elementwise_fma((f32x2v){av[0], av[1]}, tn[2 * g], acc[r]);
                acc[r] = __builtin_elementwise_fma((f32x2v){av[2], av[3]}, tn[2 * g + 1], acc[r]); }
        } else {
            const f32x4 a1 = buf[IDX % 4][1], a2 = buf[IDX % 4][2], a3 = buf[IDX % 4][3];
            const float t0 = acc[0][0] + acc[0][1];
            const float t1 = (acc[1][0] + acc[1][1]) - a1[0] * t0;
            const float t2 = (acc[2][0] + acc[2][1]) - (a2[0] * t0 + a2[1] * t1);
            const float t3 = (acc[3][0] + acc[3][1]) - ((a3[0] * t0 + a3[1] * t1) + a3[2] * t2);
            tn[2 * q] = (f32x2v){-t0, -t1}; tn[2 * q + 1] = (f32x2v){-t2, -t3};
        }
        __builtin_amdgcn_sched_barrier(0);
        if constexpr (IDX + DEPTH < END) ti_load<IDX + DEPTH>(A, buf);
        ti_steps<IDX + 1, END, DEPTH>(A, buf, tn, acc, c);
    }
}

struct PrepArgs { const bf16_t* proj; const float* beta; const float* g; const float* convw; unsigned char* prepa; unsigned char* prepu; float* egl; float* conv_p; int xf; };

struct PrepRaw { bf16_t h0, h1, h2; bf16_t raw[64]; float c0, c1, c2, c3; float gv, bt; };
__device__ __forceinline__ void prep_fetch(const PrepArgs& P, int b, int kh, int n, int tid, int wid, int lane, PrepRaw& R) {
    const int r0 = b * SEQ + n * 64, t = tid;
    const int gcol = t < 128 ? kh * 128 + t : (t < 256 ? 2048 + kh * 128 + (t - 128) : 4096 + kh * 256 + (t - 256));
    R.c0 = P.convw[gcol]; R.c1 = P.convw[CONVD + gcol]; R.c2 = P.convw[2 * CONVD + gcol]; R.c3 = P.convw[3 * CONVD + gcol];
    const bf16_t* pp = P.proj + (size_t)r0 * INW + gcol;
    R.h0 = 0; R.h1 = 0; R.h2 = 0;
    if (n > 0) { R.h0 = pp[-3 * (long)INW]; R.h1 = pp[-2 * (long)INW]; R.h2 = pp[-(long)INW]; }
#pragma unroll
    for (int j = 0; j < 64; ++j) R.raw[j] = pp[(size_t)j * INW];
    R.gv = 0.f; R.bt = 0.f;
    if (wid < 2) { const int hv = 2 * kh + wid; R.gv = P.g[(size_t)(r0 + lane) * 32 + hv]; R.bt = P.beta[(size_t)(r0 + lane) * 32 + hv]; }
}
__device__ __forceinline__ void prep_unit(const PrepArgs& P, LAS unsigned char* lds, int b, int kh, int n, int tid, int wid, int lane) {
    asm volatile("" : "+v"(tid), "+v"(lane));
    PrepRaw R; prep_fetch(P, b, kh, n, tid, wid, lane, R);
    LAS bf16_t* QN = (LAS bf16_t*)(lds + PL_QN); LAS bf16_t* KN = (LAS bf16_t*)(lds + PL_KN);
    LAS bf16_t* KT = (LAS bf16_t*)(lds + PL_KT); LAS bf16_t* VTt = (LAS bf16_t*)(lds + PL_VT);
    LAS float* AM = (LAS float*)(lds + PL_AM); LAS float* TAB = (LAS float*)(lds + PL_TAB);
    const int r0 = b * SEQ + n * 64;
    if (wid < 2) {
        float gv = R.gv;
#pragma unroll
        for (int o = 1; o < 64; o <<= 1) { const float t = __shfl_up(gv, o); if (lane >= o) gv += t; }
        TAB[wid * 64 + lane] = gv;
        TAB[128 + wid * 64 + lane] = R.bt;
    }
    __syncthreads();
    {
        const int t = tid;
        const int gcol = t < 128 ? kh * 128 + t : (t < 256 ? 2048 + kh * 128 + (t - 128) : 4096 + kh * 256 + (t - 256));
        const float c0 = R.c0, c1 = R.c1, c2 = R.c2, c3 = R.c3;
        float w0 = bf2f(R.h0), w1 = bf2f(R.h1), w2 = bf2f(R.h2);
        const int vh = (t - 256) >> 7;
#pragma unroll
        for (int jb = 0; jb < 8; ++jb) {
            float raw[8];
#pragma unroll
            for (int e = 0; e < 8; ++e) raw[e] = bf2f(R.raw[jb * 8 + e]);
            float ov[8];
#pragma unroll
            for (int e = 0; e < 8; ++e) { const float cv = w0 * c0 + w1 * c1 + w2 * c2 + raw[e] * c3; ov[e] = silu_f(cv); w0 = w1; w1 = w2; w2 = raw[e]; }
            if (t < 256) {
                LAS bf16_t* nat = (t < 128 ? QN : KN) + (t & 127);
#pragma unroll
                for (int e = 0; e < 8; ++e) nat[(jb * 8 + e) * NAT_LD] = f2bf(ov[e]);
                if (t >= 128) { u32x4 w; w.x = pk2(ov[0], ov[1]); w.y = pk2(ov[2], ov[3]); w.z = pk2(ov[4], ov[5]); w.w = pk2(ov[6], ov[7]);
                    *(LAS u32x4*)(KT + (t - 128) * TR_LD + jb * 8) = w; }
            } else {
                const LAS float* bt = TAB + 128 + vh * 64 + jb * 8;
                u32x4 w; w.x = pk2(ov[0] * bt[0], ov[1] * bt[1]); w.y = pk2(ov[2] * bt[2], ov[3] * bt[3]); w.z = pk2(ov[4] * bt[4], ov[5] * bt[5]); w.w = pk2(ov[6] * bt[6], ov[7] * bt[7]);
                *(LAS u32x4*)(VTt + (t - 256) * TR_LD + jb * 8) = w;
            }
            if (n == NCH - 1 && jb == 7) {
#pragma unroll
                for (int e = 5; e < 8; ++e) P.conv_p[((size_t)b * 3 + (e - 5)) * CONVD + gcol] = raw[e];
            }
        }
    }
    __syncthreads();
    if (P.xf & 512) return;
    {
        const int arr = tid >> 8, row = (tid >> 2) & 63, part = tid & 3;
        const LAS bf16_t* p = (arr ? KN : QN) + row * NAT_LD + part * 32;
        float s = 0.f;
#pragma unroll
        for (int c = 0; c < 4; ++c) { const bf16x8 v = *(const LAS bf16x8*)(p + c * 8);
#pragma unroll
            for (int e = 0; e < 8; ++e) { const float f = bf2f((bf16_t)v[e]); s += f * f; } }
        s += __shfl_xor(s, 1); s += __shfl_xor(s, 2);
        if (part == 0) TAB[256 + arr * 64 + row] = fast_rsq(s + EPS);
    }
    __syncthreads();
    const int m16 = lane & 15, q4 = lane >> 4;
    unsigned char* recA0 = P.prepa + (size_t)((b * 32 + 2 * kh) * NCH + n) * PREPA_REC;
    const size_t hstrideA = (size_t)NCH * PREPA_REC;
    {
        const int half = wid >> 2, it = wid & 3;
        f32x4 acc[4];
#pragma unroll
        for (int jt = 0; jt < 4; ++jt) acc[jt] = (f32x4){0.f, 0.f, 0.f, 0.f};
        if (half == 0) {
#pragma unroll
            for (int s = 0; s < 4; ++s) { const bf16x8 bq = *(const LAS bf16x8*)(QN + (16 * it + m16) * NAT_LD + 32 * s + 8 * q4);
#pragma unroll
                for (int jt = 0; jt < 4; ++jt) { const bf16x8 ak = *(const LAS bf16x8*)(KN + (16 * jt + m16) * NAT_LD + 32 * s + 8 * q4); acc[jt] = MFMA16(ak, bq, acc[jt]); } }
            const int i = 16 * it + m16; const float rqi = TAB[256 + i] * 0.08838834764831845f;
#pragma unroll
            for (int h = 0; h < 2; ++h) { const float gci = TAB[h * 64 + i];
#pragma unroll
                for (int s = 0; s < 2; ++s) { float o[8];
#pragma unroll
                    for (int e = 0; e < 8; ++e) { const int jt = 2 * s + (e >> 2), j = 16 * jt + 4 * q4 + (e & 3);
                        const float dec = fast_exp(gci - TAB[h * 64 + j]); o[e] = (i >= j) ? acc[jt][e & 3] * rqi * TAB[320 + j] * dec : 0.f; }
                    u32x4 w; w.x = pk2(o[0], o[1]); w.y = pk2(o[2], o[3]); w.z = pk2(o[4], o[5]); w.w = pk2(o[6], o[7]);
                    *(u32x4*)(recA0 + h * hstrideA + (48 + it * 2 + s) * 1024 + lane * 16) = w; } }
        } else {
#pragma unroll
            for (int s = 0; s < 4; ++s) { const bf16x8 ai = *(const LAS bf16x8*)(KN + (16 * it + m16) * NAT_LD + 32 * s + 8 * q4);
#pragma unroll
                for (int jt = 0; jt < 4; ++jt) { const bf16x8 bk = *(const LAS bf16x8*)(KN + (16 * jt + m16) * NAT_LD + 32 * s + 8 * q4); acc[jt] = MFMA16(ai, bk, acc[jt]); } }
#pragma unroll
            for (int jt = 0; jt < 4; ++jt) { const int j = 16 * jt + m16; const float rkj = TAB[320 + j];
#pragma unroll
                for (int e = 0; e < 4; ++e) { const int i = 16 * it + 4 * q4 + e; const float base = acc[jt][e] * rkj * TAB[320 + i];
#pragma unroll
                    for (int h = 0; h < 2; ++h) { const float dec = fast_exp(TAB[h * 64 + i] - TAB[h * 64 + j]);
                        AM[h * 64 * AM_LD + i * AM_LD + j] = (i > j) ? base * TAB[128 + h * 64 + i] * dec : 0.f; } } }
        }
        {
            const int h = wid >> 2, mt = wid & 3, i = 16 * mt + m16;
            const float sc = TAB[256 + i] * 0.08838834764831845f * fast_exp(TAB[h * 64 + i]);
#pragma unroll
            for (int s = 0; s < 4; ++s) {
                const bf16x4 lo = *(const LAS bf16x4*)(QN + i * NAT_LD + 32 * s + 4 * q4), hi = *(const LAS bf16x4*)(QN + i * NAT_LD + 32 * s + 16 + 4 * q4);
                u32x4 w; w.x = pk2(bf2f((bf16_t)lo[0]) * sc, bf2f((bf16_t)lo[1]) * sc); w.y = pk2(bf2f((bf16_t)lo[2]) * sc, bf2f((bf16_t)lo[3]) * sc);
                w.z = pk2(bf2f((bf16_t)hi[0]) * sc, bf2f((bf16_t)hi[1]) * sc); w.w = pk2(bf2f((bf16_t)hi[2]) * sc, bf2f((bf16_t)hi[3]) * sc);
                *(u32x4*)(recA0 + h * hstrideA + (16 + mt * 4 + s) * 1024 + lane * 16) = w;
            }
        }
    }
    __syncthreads();
    if (P.xf & 1024) return;
    asm volatile("" : "+v"(lane));
    if (wid < 2) {
        const int h = wid, c = lane;
        const LAS float* A = AM + h * 64 * AM_LD;
        f32x2v tn[32];
        constexpr int TIDEPTH = 4, NGRP = 136;
        f32x4 buf[TIDEPTH][4];
        ti_prologue<0, TIDEPTH>(A, buf);
        f32x2v acc[4];
        ti_steps<0, NGRP, TIDEPTH>(A, buf, tn, acc, c);
        const float scc = -TAB[320 + c] * TAB[128 + h * 64 + c] * fast_exp(TAB[h * 64 + c]);
        LAS bf16_t* T = (LAS bf16_t*)(lds + PL_T + h * 9216); LAS bf16_t* TP = (LAS bf16_t*)(lds + PL_TP + h * 9216);
#pragma unroll
        for (int i = 0; i < 64; ++i) { const float ti = -tn[i >> 1][i & 1]; T[i * TR_LD + c] = f2bf(ti); TP[i * TR_LD + c] = f2bf(ti * scc); }
    } else {
        for (int f = wid - 2; f < 32; f += 6) {
            const int h = f >> 4, mt = (f >> 1) & 7, s = f & 1, d = 16 * mt + m16;
            const float glast = TAB[h * 64 + 63];
            const bf16x4 lo = *(const LAS bf16x4*)(KT + d * TR_LD + 32 * s + 4 * q4), hi = *(const LAS bf16x4*)(KT + d * TR_LD + 32 * s + 16 + 4 * q4);
            float o[8];
#pragma unroll
            for (int e = 0; e < 8; ++e) { const int j = 32 * s + 16 * (e >> 2) + 4 * q4 + (e & 3);
                o[e] = bf2f((bf16_t)(e < 4 ? lo[e & 3] : hi[e & 3])) * TAB[320 + j] * fast_exp(glast - TAB[h * 64 + j]); }
            u32x4 w; w.x = pk2(o[0], o[1]); w.y = pk2(o[2], o[3]); w.z = pk2(o[4], o[5]); w.w = pk2(o[6], o[7]);
            *(u32x4*)(recA0 + h * hstrideA + (32 + mt * 2 + s) * 1024 + lane * 16) = w;
        }
    }
    __syncthreads();
    if (P.xf & 2048) return;
    {
        asm volatile("" : "+v"(lane)); const int m16 = lane & 15, q4 = lane >> 4;
        const int h = wid >> 2, it = wid & 3;
        const LAS bf16_t* T = (const LAS bf16_t*)(lds + PL_T + h * 9216); const LAS bf16_t* TP = (const LAS bf16_t*)(lds + PL_TP + h * 9216);
        bf16x8 tp[2], tt[2];
#pragma unroll
        for (int s = 0; s < 2; ++s) { tp[s] = *(const LAS bf16x8*)(TP + (16 * it + m16) * TR_LD + 32 * s + 8 * q4); tt[s] = *(const LAS bf16x8*)(T + (16 * it + m16) * TR_LD + 32 * s + 8 * q4); }
        unsigned char* recA = recA0 + h * hstrideA;
#pragma unroll
        for (int sp = 0; sp < 4; ++sp) {
            f32x4 a0 = (f32x4){0.f, 0.f, 0.f, 0.f}, a1 = a0;
#pragma unroll
            for (int s = 0; s < 2; ++s) {
                const bf16x8 k0 = *(const LAS bf16x8*)(KT + (32 * sp + m16) * TR_LD + 32 * s + 8 * q4), k1 = *(const LAS bf16x8*)(KT + (32 * sp + 16 + m16) * TR_LD + 32 * s + 8 * q4);
                a0 = MFMA16(k0, tp[s], a0); a1 = MFMA16(k1, tp[s], a1);
            }
            u32x4 w; w.x = pk2(a0[0], a0[1]); w.y = pk2(a0[2], a0[3]); w.z = pk2(a1[0], a1[1]); w.w = pk2(a1[2], a1[3]);
            *(u32x4*)(recA + (it * 4 + sp) * 1024 + lane * 16) = w;
        }
        unsigned char* recU = P.prepu + (size_t)((b * 32 + 2 * kh + h) * NCH + n) * PREPU_REC;
#pragma unroll
        for (int et = 0; et < 8; ++et) {
            f32x4 a = (f32x4){0.f, 0.f, 0.f, 0.f};
#pragma unroll
            for (int s = 0; s < 2; ++s) { const bf16x8 bv = *(const LAS bf16x8*)(VTt + (h * 128 + 16 * et + m16) * TR_LD + 32 * s + 8 * q4); a = MFMA16(tt[s], bv, a); }
            u32x2 w; w.x = pk2(a[0], a[1]); w.y = pk2(a[2], a[3]);
            *(u32x2*)(recU + (et * 4 + it) * 512 + lane * 8) = w;
        }
        if (tid < 2) P.egl[(b * 32 + 2 * kh + tid) * NCH + n] = fast_exp(TAB[tid * 64 + 63]);
    }
    __syncthreads();
}

#define BAR_LDS() do { asm volatile("s_waitcnt lgkmcnt(0)" ::: "memory"); __builtin_amdgcn_s_barrier(); asm volatile("" ::: "memory"); } while (0)

__device__ __forceinline__ float row16_sum(float v) {
    v += __builtin_bit_cast(float, __builtin_amdgcn_update_dpp(0, __builtin_bit_cast(int, v), 0x128, 0xf, 0xf, false));
    v += __builtin_bit_cast(float, __builtin_amdgcn_update_dpp(0, __builtin_bit_cast(int, v), 0x124, 0xf, 0xf, false));
    v += __builtin_bit_cast(float, __builtin_amdgcn_update_dpp(0, __builtin_bit_cast(int, v), 0x122, 0xf, 0xf, false));
    v += __builtin_bit_cast(float, __builtin_amdgcn_update_dpp(0, __builtin_bit_cast(int, v), 0x121, 0xf, 0xf, false));
    return v;
}
#define SCHED_FENCE() __builtin_amdgcn_sched_barrier(0)
struct ScanArgs { const unsigned char* prepa; const unsigned char* prepu; const float* egl; const bf16_t* proj; const float* gnorm; bf16_t* og; float* delta_out; int xf; };

__device__ __forceinline__ void scan_unit(const ScanArgs& P, LAS unsigned char* lds, int b, int hv, int tid, int wid, int lane) {
    asm volatile("" : "+v"(tid), "+v"(lane));
    const int m16 = lane & 15, q4 = lane >> 4;
    const unsigned char* recA = P.prepa + (size_t)((b * 32 + hv) * NCH) * PREPA_REC;
    const unsigned char* recU = P.prepu + (size_t)((b * 32 + hv) * NCH) * PREPU_REC;
    const float* eglp = P.egl + (b * 32 + hv) * NCH;
    LAS float* part = (LAS float*)(lds + 114688);
    LAS bf16_t* ogb = (LAS bf16_t*)(lds + 116736);
    constexpr int OG_LD = 136;
    const float gn = P.gnorm[16 * wid + m16];
    const bf16_t* zrow = P.proj + (size_t)(b * SEQ) * INW + 8192 + hv * 128;
    bf16_t* ogrow = P.og + (size_t)(b * SEQ) * VALD + hv * 128;
    f32x4 S[8];
#pragma unroll
    for (int dt = 0; dt < 8; ++dt) S[dt] = (f32x4){0.f, 0.f, 0.f, 0.f};
#define SCAN_DMA(n_, stage_) do { _Pragma("unroll") for (int k_ = 0; k_ < 7; ++k_) \
        __builtin_amdgcn_global_load_lds((const unsigned*)(recA + (size_t)(n_) * PREPA_REC + (k_ * 8 + wid) * 1024 + lane * 16), \
                                         (LAS unsigned*)(lds + (stage_) * PREPA_REC + (k_ * 8 + wid) * 1024), 16, 0, 0); } while (0)
#define SCAN_OGFLUSH(n_) do { _Pragma("unroll") for (int k_ = 0; k_ < 2; ++k_) { const int p_ = tid + 512 * k_, r_ = p_ >> 4, c_ = (p_ & 15) * 8; \
        const u32x4 v_ = *(const LAS u32x4*)(ogb + r_ * OG_LD + c_); u32x4 w_; \
        _Pragma("unroll") for (int e_ = 0; e_ < 4; ++e_) { const unsigned a_ = v_[e_], z_ = zq[k_][e_]; \
            w_[e_] = pk2(__uint_as_float(a_ << 16) * __uint_as_float(z_ << 16), __uint_as_float(a_ & 0xffff0000u) * __uint_as_float(z_ & 0xffff0000u)); } \
        *(u32x4*)(ogrow + (size_t)((n_) * 64 + r_) * VALD + c_) = w_; } } while (0)
#define SCAN_ZLOAD(n_) do { _Pragma("unroll") for (int k_ = 0; k_ < 2; ++k_) { const int p_ = tid + 512 * k_, r_ = p_ >> 4, c_ = (p_ & 15) * 8; \
        zq[k_] = *(const u32x4*)(zrow + (size_t)((n_) * 64 + r_) * INW + c_); } } while (0)
    u32x4 zq[2];
    SCAN_DMA(0, 0);
    u32x2 un[4]; float egn;
#pragma unroll
    for (int mt = 0; mt < 4; ++mt) un[mt] = *(const u32x2*)(recU + (wid * 4 + mt) * 512 + lane * 8);
    egn = eglp[0];
#pragma unroll 1
    for (int n = 0; n < NCH; ++n) {
        __builtin_amdgcn_s_waitcnt(0x0F70); VM_WAIT(); BAR_LDS();
        const float egl = egn;
        f32x4 vn[4], o[4];
#pragma unroll
        for (int mt = 0; mt < 4; ++mt) vn[mt] = (f32x4){__uint_as_float(un[mt].x << 16), __uint_as_float(un[mt].x & 0xffff0000u), __uint_as_float(un[mt].y << 16), __uint_as_float(un[mt].y & 0xffff0000u)};
        SCHED_FENCE();
        if (n > 0 && !(P.xf & 16)) SCAN_OGFLUSH(n - 1);
        SCHED_FENCE();
        {
            const int nn = n + 1 < NCH ? n + 1 : NCH - 1;
            if (!(P.xf & 8)) SCAN_DMA(nn, (n + 1) & 1);
#pragma unroll
            for (int mt = 0; mt < 4; ++mt) un[mt] = *(const u32x2*)(recU + (size_t)nn * PREPU_REC + (wid * 4 + mt) * 512 + lane * 8);
            egn = eglp[nn];
            if (!(P.xf & 16)) SCAN_ZLOAD(n);
        }
        const LAS unsigned char* st = lds + (n & 1) * PREPA_REC + lane * 16;
        bf16x8 sb[4];
#pragma unroll
        for (int s = 0; s < 4; ++s) { u32x4 w; w.x = pk2(S[2 * s][0], S[2 * s][1]); w.y = pk2(S[2 * s][2], S[2 * s][3]); w.z = pk2(S[2 * s + 1][0], S[2 * s + 1][1]); w.w = pk2(S[2 * s + 1][2], S[2 * s + 1][3]);
            sb[s] = __builtin_bit_cast(bf16x8, w); }
#define LDF(i_) (*(const LAS bf16x8*)(st + (i_) * 1024))
        bf16x8 fa[8], fb[8];
#pragma unroll
        for (int s = 0; s < 4; ++s) { fa[s] = LDF(s); fa[4 + s] = LDF(16 + s); }
#pragma unroll
        for (int mt = 0; mt < 4; ++mt) {
            o[mt] = (f32x4){0.f, 0.f, 0.f, 0.f};
            if (mt < 3) {
#pragma unroll
                for (int s = 0; s < 4; ++s) { fb[s] = LDF((mt + 1) * 4 + s); fb[4 + s] = LDF(16 + (mt + 1) * 4 + s); }
            } else {
#pragma unroll
                for (int i = 0; i < 8; ++i) fb[i] = LDF(48 + i);
            }
            SCHED_FENCE();
#pragma unroll
            for (int s = 0; s < 4; ++s) { vn[mt] = MFMA16(fa[s], sb[s], vn[mt]); o[mt] = MFMA16(fa[4 + s], sb[s], o[mt]); }
            SCHED_FENCE();
#pragma unroll
            for (int i = 0; i < 8; ++i) fa[i] = fb[i];
        }
        bf16x8 vb[2];
#pragma unroll
        for (int sp = 0; sp < 2; ++sp) { u32x4 w; w.x = pk2(vn[2 * sp][0], vn[2 * sp][1]); w.y = pk2(vn[2 * sp][2], vn[2 * sp][3]); w.z = pk2(vn[2 * sp + 1][0], vn[2 * sp + 1][1]); w.w = pk2(vn[2 * sp + 1][2], vn[2 * sp + 1][3]);
            vb[sp] = __builtin_bit_cast(bf16x8, w); }
#pragma unroll
        for (int i = 0; i < 8; ++i) fb[i] = LDF(32 + i);
        SCHED_FENCE();
#pragma unroll
        for (int mt = 0; mt < 4; ++mt)
#pragma unroll
            for (int sp = 0; sp < 2; ++sp) o[mt] = MFMA16(fa[mt * 2 + sp], vb[sp], o[mt]);
        SCHED_FENCE();
#pragma unroll
        for (int i = 0; i < 8; ++i) fa[i] = LDF(40 + i);
#pragma unroll
        for (int mt = 0; mt < 4; ++mt)
#pragma unroll
            for (int jj = 0; jj < 4; ++jj) { const float s = row16_sum(o[mt][jj] * o[mt][jj]); if (m16 == 0) part[(16 * mt + 4 * q4 + jj) * 8 + wid] = s; }
        SCHED_FENCE();
#pragma unroll
        for (int dt = 0; dt < 4; ++dt) { S[dt] = S[dt] * egl;
#pragma unroll
            for (int sp = 0; sp < 2; ++sp) S[dt] = MFMA16(fb[dt * 2 + sp], vb[sp], S[dt]); }
#pragma unroll
        for (int dt = 4; dt < 8; ++dt) { S[dt] = S[dt] * egl;
#pragma unroll
            for (int sp = 0; sp < 2; ++sp) S[dt] = MFMA16(fa[(dt - 4) * 2 + sp], vb[sp], S[dt]); }
#undef LDF
        BAR_LDS();
        {
            LAS float* rtab = (LAS float*)(lds + 134144) + wid * 64;
            const f32x4 p0 = *(const LAS f32x4*)(part + lane * 8), p1 = *(const LAS f32x4*)(part + lane * 8 + 4);
            const float tot = ((p0[0] + p0[1]) + (p0[2] + p0[3])) + ((p1[0] + p1[1]) + (p1[2] + p1[3]));
            rtab[lane] = __builtin_amdgcn_rsqf(tot * (1.0f / 128.0f) + EPS);
            LDS_WAIT();
            f32x4 rv[4];
#pragma unroll
            for (int mt = 0; mt < 4; ++mt) rv[mt] = *(const LAS f32x4*)(rtab + 16 * mt + 4 * q4);
            SCHED_FENCE();
#pragma unroll
            for (int mt = 0; mt < 4; ++mt)
#pragma unroll
                for (int jj = 0; jj < 4; ++jj) ogb[(16 * mt + 4 * q4 + jj) * OG_LD + 16 * wid + m16] = f2bf(o[mt][jj] * rv[mt][jj] * gn);
        }
    }
    BAR_LDS();
    SCAN_OGFLUSH(NCH - 1);
#undef SCAN_DMA
#undef SCAN_OGFLUSH
#undef SCAN_ZLOAD
    float* so = P.delta_out + ((size_t)(b * 32 + hv) * 128) * 128 + 16 * wid + m16;
#pragma unroll
    for (int dt = 0; dt < 8; ++dt)
#pragma unroll
        for (int jj = 0; jj < 4; ++jj) so[(size_t)(16 * dt + 4 * q4 + jj) * 128] = S[dt][jj];
    VM_WAIT(); BAR_LDS();
}

struct SConvArgs { const float* projs; const float* sconv; const float* convw; const float* a_log; const float* dt_bias; float* qkvs; float* betas; float* gs; float* conv_s; };
__device__ __forceinline__ void sconv_item(const SConvArgs& P, int b, int cg, int lane) {
    float v[2];
#pragma unroll
    for (int hh = 0; hh < 2; ++hh) {
        const int c = cg * 128 + lane + 64 * hh;
        const float raw = P.projs[(size_t)b * INDIM + c];
        const float p0 = P.sconv[((size_t)b * 3 + 0) * CONVD + c], p1 = P.sconv[((size_t)b * 3 + 1) * CONVD + c], p2 = P.sconv[((size_t)b * 3 + 2) * CONVD + c];
        const float acc = p0 * P.convw[c] + p1 * P.convw[CONVD + c] + p2 * P.convw[2 * CONVD + c] + raw * P.convw[3 * CONVD + c];
        P.conv_s[((size_t)b * 3 + 0) * CONVD + c] = p1; P.conv_s[((size_t)b * 3 + 1) * CONVD + c] = p2; P.conv_s[((size_t)b * 3 + 2) * CONVD + c] = raw;
        v[hh] = silu_f(acc);
    }
    if (cg < 32) {
        const float s = wave_sum(v[0] * v[0] + v[1] * v[1]);
        float r = fast_rsq(s + EPS); if (cg < 16) r *= 0.08838834764831845f;
        v[0] *= r; v[1] *= r;
    }
    P.qkvs[(size_t)b * CONVD + cg * 128 + lane] = v[0]; P.qkvs[(size_t)b * CONVD + cg * 128 + lane + 64] = v[1];
    if (cg == 0 && lane < 32) {
        const float braw = P.projs[(size_t)b * INDIM + 12288 + lane], araw = P.projs[(size_t)b * INDIM + 12320 + lane];
        const float xx = araw + P.dt_bias[lane];
        P.betas[b * 32 + lane] = sigmoid_f(braw); P.gs[b * 32 + lane] = -fast_exp(P.a_log[lane]) * softplus_f(xx);
    }
}

struct SRecArgs { const float* qkvs; const float* betas; const float* gs; const float* projs; const float* gnorm; const float* S0; float* Sout; bf16_t* ogs; };
__device__ __forceinline__ void srec_unit(const SRecArgs& P, LAS unsigned char* lds, int b, int hv, int tid) {
    asm volatile("" : "+v"(tid));
    LAS float* qs = (LAS float*)lds; LAS float* ks = qs + 128; LAS float* red = qs + 256; LAS float* wsm = qs + 768;
    const int e = tid & 127, dq = tid >> 7, hk = hv >> 1;
    if (tid < 128) qs[tid] = P.qkvs[(size_t)b * CONVD + hk * 128 + tid]; else if (tid < 256) ks[tid - 128] = P.qkvs[(size_t)b * CONVD + 2048 + hk * 128 + (tid - 128)];
    const float ve = P.qkvs[(size_t)b * CONVD + 4096 + hv * 128 + e], beta = P.betas[b * 32 + hv], dec = fast_exp(P.gs[b * 32 + hv]);
    const size_t sbase = ((size_t)(b * 32 + hv) * 128 + 32 * dq) * 128 + e;
    float S[32];
#pragma unroll
    for (int d = 0; d < 32; ++d) S[d] = P.S0[sbase + (size_t)d * 128];
    __syncthreads();
    float kvp = 0.f;
#pragma unroll
    for (int d = 0; d < 32; ++d) { S[d] *= dec; kvp += S[d] * ks[32 * dq + d]; }
    red[dq * 128 + e] = kvp;
    __syncthreads();
    const float kv = (red[e] + red[128 + e]) + (red[256 + e] + red[384 + e]);
    const float dl = (ve - kv) * beta;
    float op = 0.f;
#pragma unroll
    for (int d = 0; d < 32; ++d) { S[d] += ks[32 * dq + d] * dl; op += S[d] * qs[32 * dq + d]; }
    __syncthreads();
    red[dq * 128 + e] = op;
#pragma unroll
    for (int d = 0; d < 32; ++d) P.Sout[sbase + (size_t)d * 128] = S[d];
    __syncthreads();
    const float o = (red[e] + red[128 + e]) + (red[256 + e] + red[384 + e]);
    if (tid < 128) { const float s = wave_sum(o * o); if ((tid & 63) == 0) wsm[tid >> 6] = s; }
    __syncthreads();
    if (tid < 128) {
        const float ri = fast_rsq((wsm[0] + wsm[1]) * (1.0f / 128.0f) + EPS);
        const float z = P.projs[(size_t)b * INDIM + 8192 + hv * 128 + e];
        P.ogs[(size_t)b * VALD + hv * 128 + e] = f2bf(o * ri * P.gnorm[e] * silu_f(z));
    }
    __syncthreads();
}

__device__ __forceinline__ int t5_bucket(int d) {
    if (d < 16) return d;
    const int v = 16 + (int)(fast_log2((float)d * 0.0625f) * (16.0f / 3.0f));
    return v < 31 ? v : 31;
}
struct AttnArgs { const bf16_t* Q; const bf16_t* KB; const bf16_t* VT; bf16_t* AO; const float* sinks; };
__device__ __forceinline__ void attn_unit(const AttnArgs& P, const LAS float* bias2, int b, int h, int qb, int lane) {
    asm volatile("" : "+v"(lane));
    const int n32 = lane & 31, hi = lane >> 5, kvh = h >> 3, q0 = 32 * qb;
    const int kt0 = q0 >= 128 ? 0 : (128 - q0) >> 5;
    const float sink2 = P.sinks[h] * LOG2E;
    bf16x8 qf[4], kf[5][4];
    const bf16_t* qp = P.Q + (size_t)(b * SEQ + q0 + n32) * D + h * 64 + 8 * hi;
#pragma unroll
    for (int s = 0; s < 4; ++s) qf[s] = *(const bf16x8*)(qp + 16 * s);
#pragma unroll
    for (int kt = 0; kt < 5; ++kt) {
        const int j0 = q0 - 128 + 32 * kt, jc = j0 >= 0 ? j0 : 0;
        const bf16_t* kp = P.KB + (size_t)(b * SEQ + jc + n32) * 256 + kvh * 64 + 8 * hi;
#pragma unroll
        for (int s = 0; s < 4; ++s) kf[kt][s] = *(const bf16x8*)(kp + 16 * s);
    }
    SCHED_FENCE();
    f32x16 st[5];
#pragma unroll
    for (int kt = 0; kt < 5; ++kt) {
#pragma unroll
        for (int r = 0; r < 16; ++r) st[kt][r] = 0.f;
#pragma unroll
        for (int s = 0; s < 4; ++s) st[kt] = MFMA32(kf[kt][s], qf[s], st[kt]);
    }
    SCHED_FENCE();
    u32x2 vlo[5][2][2], vhi[5][2][2];
#pragma unroll
    for (int kt = 0; kt < 5; ++kt) {
        const int j0 = q0 - 128 + 32 * kt, jc = j0 >= 0 ? j0 : 0;
#pragma unroll
        for (int s2 = 0; s2 < 2; ++s2)
#pragma unroll
            for (int dh = 0; dh < 2; ++dh) {
                const bf16_t* vp = P.VT + ((size_t)(b * 4 + kvh) * 64 + 32 * dh + n32) * SEQ + jc + 16 * s2 + 4 * hi;
                vlo[kt][s2][dh] = *(const u32x2*)vp; vhi[kt][s2][dh] = *(const u32x2*)(vp + 8);
            }
    }
    SCHED_FENCE();
    float mx = sink2;
#pragma unroll
    for (int kt = 0; kt < 5; ++kt)
#pragma unroll
        for (int r = 0; r < 16; ++r) {
            const int dist = 128 - 32 * kt + n32 - crow32(r, hi);
            const bool valid = (kt >= kt0) && dist >= 0 && dist < 128;
            const float sc = valid ? st[kt][r] + bias2[h * 128 + (dist & 127)] : -INFINITY;
            st[kt][r] = sc; mx = fmaxf(mx, sc);
        }
    mx = fmaxf(mx, __shfl_xor(mx, 32));
    float l = 0.f;
#pragma unroll
    for (int kt = 0; kt < 5; ++kt)
#pragma unroll
        for (int r = 0; r < 16; ++r) { const float p = fast_exp2(st[kt][r] - mx); st[kt][r] = p; l += p; }
    l += __shfl_xor(l, 32);
    l += fast_exp2(sink2 - mx);
    const float linv = fast_rcp(l);
    f32x16 o[2];
#pragma unroll
    for (int r = 0; r < 16; ++r) { o[0][r] = 0.f; o[1][r] = 0.f; }
#pragma unroll
    for (int kt = 0; kt < 5; ++kt)
#pragma unroll
        for (int s2 = 0; s2 < 2; ++s2) {
            u32x4 w; w.x = pk2(st[kt][8 * s2 + 0], st[kt][8 * s2 + 1]); w.y = pk2(st[kt][8 * s2 + 2], st[kt][8 * s2 + 3]);
            w.z = pk2(st[kt][8 * s2 + 4], st[kt][8 * s2 + 5]); w.w = pk2(st[kt][8 * s2 + 6], st[kt][8 * s2 + 7]);
            const bf16x8 pa = __builtin_bit_cast(bf16x8, w);
#pragma unroll
            for (int dh = 0; dh < 2; ++dh) {
                u32x4 vw; vw.x = vlo[kt][s2][dh].x; vw.y = vlo[kt][s2][dh].y; vw.z = vhi[kt][s2][dh].x; vw.w = vhi[kt][s2][dh].y;
                o[dh] = MFMA32(pa, __builtin_bit_cast(bf16x8, vw), o[dh]);
            }
        }
    bf16_t* op = P.AO + (size_t)(b * SEQ + q0) * D + h * 64 + n32;
#pragma unroll
    for (int r = 0; r < 16; ++r) {
        const int m = crow32(r, hi);
        const float li = __shfl(linv, m);
        op[(size_t)m * D] = f2bf(o[0][r] * li); op[(size_t)m * D + 32] = f2bf(o[1][r] * li);
    }
}

struct SAttnArgs { const float* qs; const float* kvs; const float* ck; const float* cv; const float* sinks; bf16_t* aos; };
__device__ __forceinline__ void sattn_unit(const SAttnArgs& P, const LAS float* bias2, int b, int h, int lane) {
    const int kvh = h >> 3;
    const float qd = P.qs[(size_t)b * D + h * 64 + lane];
    const float sink2 = P.sinks[h] * LOG2E;
    float sc[2];
#pragma unroll
    for (int hh = 0; hh < 2; ++hh) {
        const int c = lane + 64 * hh + 1;
        const float* kp = (c < 128) ? P.ck + ((size_t)(b * 128 + c) * 4 + kvh) * 64 : P.kvs + (size_t)b * 512 + kvh * 64;
        float s = 0.f;
#pragma unroll
        for (int d4 = 0; d4 < 16; ++d4) { const f32x4 kv = *(const f32x4*)(kp + 4 * d4);
#pragma unroll
            for (int x = 0; x < 4; ++x) s += __uint_as_float(__builtin_amdgcn_readlane(__float_as_uint(qd), 4 * d4 + x)) * kv[x]; }
        sc[hh] = s + bias2[h * 128 + (128 - c)];
    }
    float mx = fmaxf(sc[0], sc[1]);
#pragma unroll
    for (int o = 1; o < 64; o <<= 1) mx = fmaxf(mx, __shfl_xor(mx, o));
    mx = fmaxf(mx, sink2);
    const float p0 = fast_exp2(sc[0] - mx), p1 = fast_exp2(sc[1] - mx);
    const float l = wave_sum(p0 + p1) + fast_exp2(sink2 - mx);
    float acc = 0.f;
#pragma unroll 8
    for (int cc = 0; cc < 64; ++cc) {
        const float pa = __uint_as_float(__builtin_amdgcn_readlane(__float_as_uint(p0), cc));
        const float pb = __uint_as_float(__builtin_amdgcn_readlane(__float_as_uint(p1), cc));
        const int ca = cc + 1, cb = cc + 65;
        const float* va = P.cv + ((size_t)(b * 128 + ca) * 4 + kvh) * 64;
        const float* vb = (cb < 128) ? P.cv + ((size_t)(b * 128 + cb) * 4 + kvh) * 64 : P.kvs + (size_t)b * 512 + 256 + kvh * 64;
        acc += pa * va[lane] + pb * vb[lane];
    }
    P.aos[(size_t)b * D + h * 64 + lane] = f2bf(acc / l);
}
#define XB_TMO      128
#define XB_XCNT(j)  (256  + 64 * (j))
#define XB_XSUB(j)  (1280 + 64 * (j))
#define XB_XGEN(j)  (2304 + 64 * (j))
#define XB_TOP      3328
#define XB_TOPGEN   3392
#define XCD_BAR_WORDS 3456
#define XB_SPIN_CAP (1u << 18)

__device__ __forceinline__ unsigned xb_ld(unsigned* p)              { return __hip_atomic_load(p, __ATOMIC_RELAXED, __HIP_MEMORY_SCOPE_AGENT); }
__device__ __forceinline__ unsigned xb_add(unsigned* p, unsigned v) { return __hip_atomic_fetch_add(p, v, __ATOMIC_RELAXED, __HIP_MEMORY_SCOPE_AGENT); }
__device__ __forceinline__ unsigned xb_xcc_id() { return (unsigned)__builtin_amdgcn_s_getreg((3 << 11) | 20) & 0xFu; }
#define XB_SPIN(cond, bar) do { unsigned _sp = 0; while (cond) { __builtin_amdgcn_s_sleep(1); \
    if ((++_sp & 255u) == 0u) { if (xb_ld(&(bar)[XB_TMO])) break; if (_sp > XB_SPIN_CAP) { atomicAdd(&(bar)[XB_TMO], 1u); break; } } } } while (0)

struct XcdBarrier {
    unsigned* bar; unsigned x;
    volatile LAS unsigned* st;
};

__device__ __forceinline__ XcdBarrier xcd_barrier_post(unsigned* bar, volatile LAS unsigned* st) {
    XcdBarrier b; b.bar = bar; b.x = xb_xcc_id(); b.st = st;
    if (threadIdx.x == 0) (void)xb_add(&bar[XB_XCNT(b.x)], 1u);
    return b;
}
__device__ __forceinline__ void xcd_barrier_complete(unsigned* bar, unsigned x, unsigned& nloc, unsigned& nx) {
    const unsigned G = gridDim.x * gridDim.y * gridDim.z;
    unsigned sum, cnt, mine, sp = 0u;
    for (;;) {
        sum = 0u; cnt = 0u; mine = 0u;
#pragma unroll
        for (unsigned j = 0; j < 16; ++j) { const unsigned c = xb_ld(&bar[XB_XCNT(j)]); sum += c; cnt += (c > 0u) ? 1u : 0u; mine = (j == x) ? c : mine; }
        if (sum == G) break;
        __builtin_amdgcn_s_sleep(1);
        if ((++sp & 255u) == 0u) { if (xb_ld(&bar[XB_TMO])) break; if (sp > XB_SPIN_CAP) { atomicAdd(&bar[XB_TMO], 1u); break; } }
    }
    nloc = mine > 0u ? mine : 1u; nx = cnt > 0u ? cnt : 1u;
}

__device__ __forceinline__ void xcd_barrier(const XcdBarrier& b, int tid_) {
    asm volatile("s_waitcnt vmcnt(0)" ::: "memory");
    __syncthreads();
    if (tid_ == 0) {
        unsigned* bar = b.bar; unsigned bx = b.x;
        asm volatile("" : "+s"(bar), "+s"(bx));
        __builtin_amdgcn_s_waitcnt(0);
        unsigned nloc = b.st[0], nx = b.st[1];
        if (nloc == 0u) { xcd_barrier_complete(bar, bx, nloc, nx); b.st[0] = nloc; b.st[1] = nx; }
        const unsigned old = xb_add(&bar[XB_XSUB(bx)], 1u);
        const unsigned gen = old / nloc;
        if (old + 1u == (gen + 1u) * nloc) {
            __builtin_amdgcn_fence(__ATOMIC_RELEASE, "agent");
            asm volatile("s_waitcnt vmcnt(0)" ::: "memory");
            const unsigned og = xb_add(&bar[XB_TOP], 1u);
            const unsigned tg = og / nx;
            if (og + 1u == (tg + 1u) * nx) xb_add(&bar[XB_TOPGEN], 1u);
            else XB_SPIN(xb_ld(&bar[XB_TOPGEN]) == tg, bar);
            __builtin_amdgcn_fence(__ATOMIC_ACQUIRE, "agent");
            xb_add(&bar[XB_XGEN(bx)], 1u);
            asm volatile("s_waitcnt vmcnt(0)" ::: "memory");
        } else {
            XB_SPIN(xb_ld(&bar[XB_XGEN(bx)]) == gen, bar);
            __builtin_amdgcn_fence(__ATOMIC_ACQUIRE, "agent");
            asm volatile("s_waitcnt vmcnt(0)" ::: "memory");
        }
    }
    __syncthreads();
}

constexpr int CW_BARBASE = 131072, BAR_REGION_WORDS = 4096;
constexpr int PH_FINAL = 25, N_PHASES = 26;
#ifndef MK_EN
#define MK_EN 0xffff
#endif
#define EN(k) (((MK_EN) >> (k)) & 1)
struct Args { const float* in[23]; float* out; unsigned char* ws; int ph_lo, ph_hi, li, pad; };

constexpr size_t O_Y = 0, O_YS = 16777216, O_DP = 16842752, O_CP = 21037056, O_KP = 21233664, O_VP = 21364736, O_DS = 21495808, O_CS = 55050240, O_KS = 56623104, O_VS = 57671680;

__global__ void __launch_bounds__(NTHR, 2) mk_fwd(Args args) {
    extern __shared__ __attribute__((aligned(16))) unsigned char lds_raw[];
    LAS unsigned char* lds = (LAS unsigned char*)lds_raw;
    volatile LAS unsigned* MISC = (volatile LAS unsigned*)(lds + MISC_OFF);
    const int G = gridDim.x, bid = blockIdx.x;
    const int wid0 = __builtin_amdgcn_readfirstlane((int)threadIdx.x >> 6);
    if (threadIdx.x < 64) MISC[threadIdx.x] = 0u;
    __syncthreads();
    XcdBarrier bar = xcd_barrier_post((unsigned*)(args.ws + WS_CTL) + CW_BARBASE + args.li * BAR_REGION_WORDS, MISC + 8);
    const int lo = args.ph_lo, hi = args.ph_hi;
#define IN(k) (lo <= (k) && (k) < hi)
#define SEAM(knext) do { if (IN(knext)) xcd_barrier(bar, tid); } while (0)
#define KARG(k) (kp[(k)])
#define PH_LOCALS \
    int tid; asm volatile("v_mbcnt_lo_u32_b32 %0, -1, 0\n\tv_mbcnt_hi_u32_b32 %0, -1, %0" : "=v"(tid)); tid += wid0 * 64;     \
    const int lane = tid & 63, wid = __builtin_amdgcn_readfirstlane(tid >> 6); \
    KP_T kp = (KP_T)__builtin_amdgcn_kernarg_segment_ptr(); asm volatile("" : "+s"(kp)); \
    unsigned char* ws = (unsigned char*)KARG(24); \
    float* out = (float*)KARG(23); \
    const int gw = bid * NWAVES + wid, NGW = G * NWAVES; \
    float* ssq = (float*)(ws + WS_SSQP); float* ssqs = (float*)(ws + WS_SSQSP); \
    LAS float* red = (LAS float*)lds; \
    (void)gw; (void)NGW; (void)lane; (void)out; (void)ssq; (void)ssqs; (void)red;
#define CV_SPLIT(lam) ((lam) == 1 ? 7900 : ((lam) == 2 ? 5100 : 5200))
#define RINVS ((LAS float*)(lds + 131072))
#define BUILD_RINVS(site_ptr) do { if (tid < 32) { const float* p_ = (site_ptr) + tid * 64; float s_ = 0.f; for (int i_ = 0; i_ < 64; ++i_) s_ += p_[i_]; RINVS[tid] = rinv_of(s_); } __syncthreads(); } while (0)
#define ssq_in (ssq + (size_t)(2 * L) * MP * 32)
#define ssqs_in (ssqs + (2 * L) * SB * 64)
#define ssq_mid (ssq + (size_t)(2 * L + 1) * MP * 32)
#define ssqs_mid (ssqs + (2 * L + 1) * SB * 64)
#define ssq_out (ssq + (size_t)(2 * L + 2) * MP * 32)
#define ssqs_out (ssqs + (2 * L + 2) * SB * 64)
#define x_prompt (KARG(0))
#define x_sample (KARG(1))
#define state_delta (KARG(2))
#define state_conv (KARG(3))
#define cache_k (KARG(4))
#define cache_v (KARG(5))
#define norm_mix (KARG(6))
#define norm_ffn (KARG(7))
#define w_in (KARG(8))
#define conv_w (KARG(9))
#define a_log (KARG(10))
#define dt_bias (KARG(11))
#define gnorm (KARG(12))
#define w_out (KARG(13))
#define norm_kv (KARG(14))
#define w_kv (KARG(15))
#define w_q (KARG(16))
#define w_o (KARG(17))
#define sinks (KARG(18))
#define rel_bias (KARG(19))
#define w_gu (KARG(20))
#define w_dn (KARG(21))
#define norm_final (KARG(22))
#define WIN_T ((bf16_t*)(ws + WS_WIN))
#define WBA_T ((bf16_t*)(ws + WS_WBA))
#define WOUT_T ((bf16_t*)(ws + WS_WOUT))
#define WGU_T ((bf16_t*)(ws + WS_WGU))
#define WDN_T ((bf16_t*)(ws + WS_WDN))
#define WQKV_T ((bf16_t*)(ws + WS_WQKV))
#define WQ1_T ((bf16_t*)(ws + WS_WQ1))
#define WO_T ((bf16_t*)(ws + WS_WO))
#define X ((float*)(ws + WS_X))
#define XB ((bf16_t*)(ws + WS_XB))
#define PROJ ((bf16_t*)(ws + WS_PROJ))
#define BETA ((float*)(ws + WS_BETA))
#define GG ((float*)(ws + WS_G))
#define OG ((bf16_t*)(ws + WS_OG))
#define MID ((bf16_t*)(ws + WS_MID))
#define QB ((bf16_t*)(ws + WS_Q))
#define KB ((bf16_t*)(ws + WS_K))
#define VT ((bf16_t*)(ws + WS_VT))
#define AO ((bf16_t*)(ws + WS_AO))
#define XS ((float*)(ws + WS_SMP + SM_XS))
#define XSB ((bf16_t*)(ws + WS_SMP + SM_XSB))
#define PROJS ((float*)(ws + WS_SMP + SM_PROJS))
#define QKVS ((float*)(ws + WS_SMP + SM_QKVS))
#define BETAS ((float*)(ws + WS_SMP + SM_BETAS))
#define GS ((float*)(ws + WS_SMP + SM_GS))
#define OGS ((bf16_t*)(ws + WS_SMP + SM_OGS))
#define MIDS ((bf16_t*)(ws + WS_SMP + SM_MIDS))
#define QS ((float*)(ws + WS_SMP + SM_QS))
#define KVS ((float*)(ws + WS_SMP + SM_KVS))
#define AOS ((bf16_t*)(ws + WS_SMP + SM_AOS))

    if (EN(0) && IN(0)) {
        PH_LOCALS
        LAS float* scr = (LAS float*)(lds + wid * 16640);
        convert_range(kp, ws, 0, 0, cv_count(0), gw, NGW, scr, lane);
        for (int m = gw; m < MP + SB; m += NGW) {
            if (m < MP) row_to_bf16(x_prompt + (size_t)m * D, XB + (size_t)m * D, ssq + (size_t)m * 32, 32, lane);
            else row_to_bf16(x_sample + (size_t)(m - MP) * D, XSB + (size_t)(m - MP) * D, ssqs + (size_t)(m - MP) * 64, 64, lane);
        }
        for (int i = bid * NTHR + tid; i < 2 * SB * 127 * 64; i += G * NTHR) {
            const int which = i / (SB * 127 * 64), r = i % (SB * 127 * 64), b = r / (127 * 64), o = r % (127 * 64);
            const f32x4 v = *(const f32x4*)((which ? cache_v : cache_k) + (size_t)b * 128 * 256 + 256 + 4 * o);
            *(f32x4*)(out + (which ? O_VS : O_KS) + (size_t)b * 128 * 256 + 4 * o) = v;
        }
        SEAM(1);
    }

#pragma unroll 1
    for (int L = 0; L < 4; ++L) {
        const int pb = 1 + 6 * L; const bool isA = L < 2; const int j = L - 2;
        int lo = args.ph_lo, hi = args.ph_hi; asm volatile("" : "+s"(lo), "+s"(hi));
        if (IN(pb)) {
            PH_LOCALS
            if (EN(1) && isA) {
                const bf16_t* Wt = WIN_T + (size_t)L * INW * D; const bf16_t* Wba = WBA_T + (size_t)L * 64 * D;
                { pg8::Gemm g{XB, Wt, MP, INW, D}; pg8::StaticOrder S; S.init(MP, INW, G, bid);
                  pg8::EpiProj E{PROJ, INW, ssq_in, 32};
                  pg8::gemm_phase<pg8::EpiProj, pg8::StaticOrder, true, true>(lds, g, S, E, tid); }
                const float* al = a_log + L * 32; const float* dtb = dt_bias + L * 32;
                BUILD_RINVS(ssqs_in);
                for (int su = bid; su < 384 + 1 + 256; su += G) {
                    if (su < 384) {
                        skinny_unit<false>(XSB, D, Wt + (size_t)su * 32 * D, nullptr, D, D, red, wid, lane, tid,
                            [&](int m, int n, float v0, float) { PROJS[(size_t)m * INDIM + su * 32 + n] = v0 * RINVS[m]; });
                    } else if (su == 384) {
                        skinny_unit<true>(XSB, D, Wba, Wba + 32 * D, D, D, red, wid, lane, tid,
                            [&](int m, int n, float v0, float v1) { const float ri = RINVS[m]; PROJS[(size_t)m * INDIM + INW + n] = v0 * ri; PROJS[(size_t)m * INDIM + INW + 32 + n] = v1 * ri; });
                    } else {
                        const int u = su - 385;
                        skinny_unit<true>(XB + (size_t)u * 32 * D, D, Wba, Wba + 32 * D, D, D, red, wid, lane, tid,
                            [&](int m, int n, float v0, float v1) { const int row = 32 * u + m; const float ri = rinv_row_full(ssq_in, row);
                                const float braw = v0 * ri, xx = v1 * ri + dtb[n];
                                BETA[(size_t)row * 32 + n] = sigmoid_f(braw); GG[(size_t)row * 32 + n] = -fast_exp(al[n]) * softplus_f(xx); });
                    }
                }
            } else if (EN(2) && !isA) {
                const bf16_t* Wt = j == 0 ? WQKV_T : WQ1_T; const int N = j == 0 ? 2560 : 2048;
                { pg8::Gemm g{XB, Wt, MP, N, D}; pg8::StaticOrder S; S.init(MP, N, G, bid);
                  pg8::EpiQKVT<false> E{QB, KB, VT, out + O_KP, out + O_VP, ssq_in};
                  pg8::gemm_phase<pg8::EpiQKVT<false>, pg8::StaticOrder, true, true>(lds, g, S, E, tid); }
                BUILD_RINVS(ssqs_in);
                for (int su = bid; su < N / 32; su += G) {
                    skinny_unit<false>(XSB, D, Wt + (size_t)su * 32 * D, nullptr, D, D, red, wid, lane, tid,
                        [&](int m, int n, float v0, float) { const float v = v0 * RINVS[m]; const int c = su * 32 + n;
                            if (c < 2048) QS[(size_t)m * D + c] = v;
                            else { KVS[(size_t)m * 512 + (c - 2048)] = v;
                                   if (c < 2304) out[O_KS + ((size_t)m * 128 + 127) * 256 + (c - 2048)] = v; else out[O_VS + ((size_t)m * 128 + 127) * 256 + (c - 2304)] = v; } });
                }
                if (j == 0) {
                    const int nwg_ = (MP / 256) * (N / 256), rounds = (nwg_ + G - 1) / G, nidle = rounds * G - nwg_;
                    if (nidle > 0 && bid >= G - nidle) {
                        __syncthreads();
                        convert_range(kp, ws, 3, 0, CV_SPLIT(3), (bid - (G - nidle)) * NWAVES + wid, nidle * NWAVES, (LAS float*)(lds + wid * 16640), lane);
                    }
                }
            }
            SEAM(isA ? pb + 1 : pb + 2);
        }
        if (EN(3) && isA && IN(pb + 1)) {
            PH_LOCALS
            PrepArgs P{PROJ, BETA, GG, conv_w + (size_t)L * 4 * CONVD, ws + WS_PREPA, ws + WS_PREPU, (float*)(ws + WS_EGL), out + O_CP + (size_t)L * BATCH * 3 * CONVD, args.pad};
            for (int u = bid; u < BATCH * 16 * NCH; u += G) { const int n = u & 31, kh = (u >> 5) & 15, b = u >> 9; prep_unit(P, lds, b, kh, n, tid, wid, lane); }
            SConvArgs SP{PROJS, state_conv + (size_t)L * SB * 3 * CONVD, conv_w + (size_t)L * 4 * CONVD, a_log + L * 32, dt_bias + L * 32, QKVS, BETAS, GS, out + O_CS + (size_t)L * SB * 3 * CONVD};
            for (int it = gw; it < SB * 64; it += NGW) sconv_item(SP, it >> 6, it & 63, lane);
            SEAM(pb + 2);
        }
        if (IN(pb + 2)) {
            PH_LOCALS
            if (EN(4) && isA) {
                ScanArgs P{ws + WS_PREPA, ws + WS_PREPU, (const float*)(ws + WS_EGL), PROJ, gnorm + L * 128, (args.pad & 4) ? MID : OG, (args.pad & 4) ? (float*)QB : out + O_DP + (size_t)L * BATCH * 32 * 128 * 128, args.pad};
                if (!(args.pad & 1)) for (int u = bid; u < BATCH * 32; u += G) scan_unit(P, lds, u >> 5, u & 31, tid, wid, lane);
                SRecArgs R{QKVS, BETAS, GS, PROJS, gnorm + L * 128, state_delta + (size_t)L * SB * 32 * 128 * 128, out + O_DS + (size_t)L * SB * 32 * 128 * 128, OGS};
                const int base = G > 128 ? 128 : 0, nb = G > 128 ? G - 128 : G;
                if (!(args.pad & 2) && bid >= base) for (int su = bid - base; su < SB * 32; su += nb) srec_unit(R, lds, su >> 5, su & 31, tid);
                if (G > 128 && bid >= 128) {
                    __syncthreads();
                    convert_range(kp, ws, L + 1, 0, CV_SPLIT(L + 1), (bid - 128) * NWAVES + wid, (G - 128) * NWAVES, (LAS float*)(lds + wid * 16640), lane);
                }
            } else if (EN(5) && !isA) {
                LAS float* bias2 = (LAS float*)lds;
                for (int i = tid; i < 32 * 128; i += NTHR) { const int h = i >> 7, dist = i & 127; bias2[i] = rel_bias[t5_bucket(dist) * 32 + h] * LOG2E; }
                __syncthreads();
                AttnArgs P{QB, KB, VT, AO, sinks + j * 32};
                if (!(args.pad & 64)) for (int u = gw; u < BATCH * 32 * 64; u += NGW) { const int g8 = u & 7, qb = (u >> 3) & 63, kvh = (u >> 9) & 3, b = u >> 11; attn_unit(P, bias2, b, kvh * 8 + g8, qb, lane); }
                SAttnArgs SP{QS, KVS, cache_k, cache_v, sinks + j * 32, AOS};
                if (!(args.pad & 32)) for (int u = gw; u < SB * 32; u += NGW) sattn_unit(SP, bias2, u >> 5, u & 31, lane);
                __syncthreads();
            }
            SEAM(pb + 3);
        }
        if (EN(6) && IN(pb + 3)) {
            PH_LOCALS
            const bf16_t* A = isA ? OG : AO; const int K = isA ? VALD : D;
            const bf16_t* Wt = isA ? WOUT_T + (size_t)L * D * VALD : WO_T + (size_t)j * D * D;
            const float* base = L == 0 ? x_prompt : X; const float* bases = L == 0 ? x_sample : XS;
            { pg8::Gemm g{A, Wt, MP, D, K}; pg8::StaticOrder S; S.init(MP, D, G, bid);
              pg8::EpiRes E{base, X, XB, ssq_mid};
              pg8::gemm_phase<pg8::EpiRes, pg8::StaticOrder, true, true>(lds, g, S, E, tid); }
            const bf16_t* As = isA ? OGS : AOS;
            for (int su = bid; su < 64; su += G) {
                skinny_unit<false>(As, K, Wt + (size_t)su * 32 * K, nullptr, K, K, red, wid, lane, tid,
                    [&](int m, int n, float v0, float) { const size_t o = (size_t)m * D + su * 32 + n; const float v = bases[o] + v0; XS[o] = v; XSB[o] = f2bf(v);
                        float s = v * v; s += __shfl_xor(s, 1); s += __shfl_xor(s, 2); s += __shfl_xor(s, 4); s += __shfl_xor(s, 8); s += __shfl_xor(s, 16);
                        if (n == 0) ssqs_mid[m * 64 + su] = s; });
            }
            SEAM(pb + 4);
        }
        if (EN(7) && IN(pb + 4)) {
            PH_LOCALS
            const bf16_t* Wt = WGU_T + (size_t)L * GU * D;
            { pg8::Gemm g{XB, Wt, MP, GU, D}; pg8::StaticOrder S; S.init(MP, GU, G, bid);
              pg8::EpiSwigluT<false> E{MID, ssq_mid};
              pg8::gemm_phase<pg8::EpiSwigluT<false>, pg8::StaticOrder, true, true>(lds, g, S, E, tid); }
            BUILD_RINVS(ssqs_mid);
            for (int su = bid; su < FF / 32; su += G) {
                const int t = su >> 2, s4 = su & 3;
                skinny_unit<true>(XSB, D, Wt + (size_t)(256 * t + 32 * s4) * D, Wt + (size_t)(256 * t + 128 + 32 * s4) * D, D, D, red, wid, lane, tid,
                    [&](int m, int n, float v0, float v1) { const float ri = RINVS[m]; const float gt = v0 * ri, up = v1 * ri;
                        MIDS[(size_t)m * FF + su * 32 + n] = f2bf(silu_f(gt) * up); });
            }
            if (L < 3) {
                const int nwg_ = (MP / 256) * (GU / 256), rounds = (nwg_ + G - 1) / G, nidle = rounds * G - nwg_;
                if (nidle > 0 && bid >= G - nidle) {
                    __syncthreads();
                    const int f0 = CV_SPLIT(L + 1);
                    convert_range(kp, ws, L + 1, f0, cv_count(L + 1) - f0, (bid - (G - nidle)) * NWAVES + wid, nidle * NWAVES, (LAS float*)(lds + wid * 16640), lane);
                }
            }
            SEAM(pb + 5);
        }
        if (EN(8) && IN(pb + 5)) {
            PH_LOCALS
            const bf16_t* Wt = WDN_T + (size_t)L * D * FF;
            { pg8::Gemm g{MID, Wt, MP, D, FF}; pg8::StaticOrder S; S.init(MP, D, G, bid);
              const bool dm = (args.pad & 128) != 0;
              pg8::EpiRes E{X, dm ? (float*)PROJ : X, dm ? (bf16_t*)((char*)PROJ + 64 * MiB) : XB, dm ? (float*)((char*)PROJ + 100 * MiB) : ssq_out};
              pg8::gemm_phase<pg8::EpiRes, pg8::StaticOrder, true, true>(lds, g, S, E, tid); }
            for (int su = bid; su < 64; su += G) {
                skinny_unit<false>(MIDS, FF, Wt + (size_t)su * 32 * FF, nullptr, FF, FF, red, wid, lane, tid,
                    [&](int m, int n, float v0, float) { const size_t o = (size_t)m * D + su * 32 + n; const float v = XS[o] + v0; XS[o] = v; XSB[o] = f2bf(v);
                        float s = v * v; s += __shfl_xor(s, 1); s += __shfl_xor(s, 2); s += __shfl_xor(s, 4); s += __shfl_xor(s, 8); s += __shfl_xor(s, 16);
                        if (n == 0) ssqs_out[m * 64 + su] = s; });
            }
            SEAM(L == 3 ? PH_FINAL : pb + 6);
        }
    }
    if (EN(9) && IN(PH_FINAL)) {
        PH_LOCALS
        const float* sq = ssq + (size_t)8 * MP * 32; const float* sqs = ssqs + 8 * SB * 64;
        for (int m = gw; m < MP + SB; m += NGW) {
            const bool sp = m >= MP; const int r = sp ? m - MP : m;
            const float ri = rinv_of(wave_sum(sp ? sqs[r * 64 + lane] : (lane < 32 ? sq[(size_t)r * 32 + lane] : 0.f)));
            const f32x4* xr = (const f32x4*)((sp ? XS : X) + (size_t)r * D) + lane; f32x4* yr = (f32x4*)(out + (sp ? O_YS : O_Y) + (size_t)r * D) + lane; const f32x4* gr = (const f32x4*)norm_final + lane;
#pragma unroll
            for (int q = 0; q < 8; ++q) yr[64 * q] = xr[64 * q] * ri * gr[64 * q];
        }
    }
#undef IN
#undef SEAM
}
#undef RINVS
#undef CV_SPLIT
#undef BUILD_RINVS
#undef x_prompt
#undef x_sample
#undef state_delta
#undef state_conv
#undef cache_k
#undef cache_v
#undef norm_mix
#undef norm_ffn
#undef w_in
#undef conv_w
#undef a_log
#undef dt_bias
#undef gnorm
#undef w_out
#undef norm_kv
#undef w_kv
#undef w_q
#undef w_o
#undef sinks
#undef rel_bias
#undef w_gu
#undef w_dn
#undef norm_final
#undef WIN_T
#undef WBA_T
#undef WOUT_T
#undef WGU_T
#undef WDN_T
#undef WQKV_T
#undef WQ1_T
#undef WO_T
#undef X
#undef XB
#undef PROJ
#undef BETA
#undef GG
#undef OG
#undef MID
#undef QB
#undef KB
#undef VT
#undef AO
#undef XS
#undef XSB
#undef PROJS
#undef QKVS
#undef BETAS
#undef GS
#undef OGS
#undef MIDS
#undef QS
#undef KVS
#undef AOS
#undef ssq_in
#undef ssqs_in
#undef ssq_mid
#undef ssqs_mid
#undef ssq_out
#undef ssqs_out
#undef PH_LOCALS
#undef KARG

#ifndef MK_PER_PHASE
#define MK_PER_PHASE 0
#endif
static int mk_grid = 0;
static bool mk_setup(int n_in, size_t ws_size) {
    if (mk_grid == 0) {
        if (n_in != 23 || ws_size < WS_END) { fprintf(stderr, "kernel_launch: unexpected inputs (%d) or workspace (%zu < %zu)\n", n_in, ws_size, (size_t)WS_END); mk_grid = -1; return false; }
        int dev = 0, cus = 0, per_cu = 0;
        if (hipGetDevice(&dev) != hipSuccess || hipDeviceGetAttribute(&cus, hipDeviceAttributeMultiprocessorCount, dev) != hipSuccess) { mk_grid = -1; return false; }
        if (hipFuncSetAttribute((const void*)mk_fwd, hipFuncAttributeMaxDynamicSharedMemorySize, LDS_BYTES) != hipSuccess) { fprintf(stderr, "kernel_launch: hipFuncSetAttribute failed\n"); mk_grid = -1; return false; }
        if (hipOccupancyMaxActiveBlocksPerMultiprocessor(&per_cu, (const void*)mk_fwd, NTHR, LDS_BYTES) != hipSuccess || per_cu < 1) { fprintf(stderr, "kernel_launch: occupancy query says %d\n", per_cu); }
        (void)hipGetLastError();
        mk_grid = cus;
    }
    return mk_grid > 0;
}
static void mk_run(void* const* d_in, void* d_out, void* d_ws, hipStream_t stream, int p_lo, int p_hi, bool per_phase, int flags = 0) {
    (void)hipMemsetAsync((char*)d_ws + WS_CTL, 0, CTL_ZERO_BYTES, stream);
    Args a{};
    for (int i = 0; i < 23; ++i) a.in[i] = (const float*)d_in[i];
    a.out = (float*)d_out; a.ws = (unsigned char*)d_ws; a.pad = flags;
    if (per_phase) {
        int li = 0;
        for (int p = p_lo; p < p_hi; ++p) {
            if (p >= 14 && p <= 24 && ((p - 1) % 6) == 1) continue;
            a.ph_lo = p; a.ph_hi = p + 1; a.li = li++;
            hipLaunchKernelGGL(mk_fwd, dim3(mk_grid), dim3(NTHR), LDS_BYTES, stream, a);
        }
    } else {
        a.ph_lo = p_lo; a.ph_hi = p_hi; a.li = 0;
        hipLaunchKernelGGL(mk_fwd, dim3(mk_grid), dim3(NTHR), LDS_BYTES, stream, a);
    }
}
#ifndef MK_NO_ENTRY
extern "C" void kernel_launch(void* const* d_in, const int* in_sizes, int n_in, void* d_out, int out_size, void* d_ws, size_t ws_size, hipStream_t stream) {
    if (!mk_setup(n_in, ws_size)) return;
    mk_run(d_in, d_out, d_ws, stream, 0, N_PHASES, MK_PER_PHASE != 0);
}
#endif
```

```cpp
#include <hip/hip_runtime.h>
#include <cstdio>
#include <cstdint>
#include <cmath>
namespace pg8 {
#define PG8_LAS __attribute__((address_space(3)))
typedef unsigned short bf16_t;
typedef short bf16x8 __attribute__((ext_vector_type(8)));
typedef float f32x4 __attribute__((ext_vector_type(4)));
typedef unsigned u32x4 __attribute__((ext_vector_type(4)));
constexpr int BM = 256, BK = 64, HALF = 128, HTB = HALF * BK * 2  , STAGE_BYTES = 8 * HTB, NXCD = 8, WGM = 8;

__host__ __device__ __forceinline__ int lds_byte(int r, int c) { const int st = (r >> 4) * 2 + (c >> 5), rr = r & 15, cc = c & 31, ob = rr * 64 + cc * 2; return st * 1024 + (ob ^ (((ob >> 9) & 1) << 5)); }
__host__ __device__ __forceinline__ void stage_rc(int b, int& R, int& C) { const int st = b / 1024, sb = b % 1024, swz = sb ^ (((sb >> 9) & 1) << 5); R = (st >> 1) * 16 + swz / 64; C = (st & 1) * 32 + (swz % 64) / 2; }
__host__ __device__ __forceinline__ int perm32(int rho) { const int n = rho >> 4, i = rho & 15; return 8 * (i >> 2) + 4 * n + (i & 3); }

struct Unit { int pm, pn; };
struct Gemm { const bf16_t* A; const bf16_t* Bt; int M, N, K; };

struct StaticOrder {
    int nM, nN, nwg, G, c, lim;
    __host__ __device__ void init(int M, int N, int G_, int c_) { nM = M / BM; nN = N / BM; nwg = nM * nN; G = G_; c = c_; lim = nwg; }
    __host__ __device__ void map(int L, Unit& u) const {
        int wgid = L; { const int q = nwg / NXCD, r = nwg % NXCD, xcd = wgid % NXCD, off = wgid / NXCD; wgid = (xcd < r ? xcd * (q + 1) : r * (q + 1) + (xcd - r) * q) + off; }
        const int nig = WGM * nN, gid = wgid / nig, fm = gid * WGM, gsz = (nM - fm) < WGM ? (nM - fm) : WGM;
        u.pm = fm + ((wgid % nig) % gsz); u.pn = (wgid % nig) / gsz;
    }
    __host__ __device__ bool next(int i, Unit& u) const {
        const long L = (long)i * G + c; if (L >= lim) return false;
        map((int)L, u); return true;
    }
    __device__ __forceinline__ void a_ready(const Unit&) const {}
    __device__ __forceinline__ void done(const Unit&) const {}
};
struct TailOrder {
    StaticOrder base; int first;
    __host__ __device__ bool next(int i, Unit& u) const {
        const long t = (long)i * base.G + base.c; if (t >= 2L * (base.nwg - first)) return false;
        Unit f; base.map(first + (int)(t >> 1), f); u.pm = 2 * f.pm + (int)(t & 1); u.pn = f.pn; return true;
    }
    __device__ __forceinline__ void a_ready(const Unit&) const {}
    __device__ __forceinline__ void done(const Unit&) const {}
};

__device__ __forceinline__ unsigned cvt_pk_bf16(float lo, float hi) { unsigned r; asm volatile("v_cvt_pk_bf16_f32 %0, %1, %2" : "=v"(r) : "v"(lo), "v"(hi)); return r; }
typedef float f32x2 __attribute__((ext_vector_type(2)));
template <class Epi, class Sched, bool ALIGN_EPI = false, bool SP2 = false, bool HALFM = false>
__device__ __forceinline__ void gemm_phase(PG8_LAS unsigned char* lds, const Gemm g, const Sched& S, const Epi& E, int tid_in) {
    int tid = tid_in; asm volatile("" : "+v"(tid));
    const int wid = __builtin_amdgcn_readfirstlane(tid >> 6), lane = tid & 63, wr = wid >> 2, wc = wid & 3, fr = lane & 15, fq = lane >> 4;
    const int K = g.K, nt = K / BK;
    unsigned voffA[2], voffB[2];
#pragma unroll
    for (int i = 0; i < 2; ++i) { int R, C; stage_rc(tid * 16 + i * 8192, R, C); const int Rb = Epi::PERM ? ((R & ~31) + perm32(R & 31)) : R;
        voffA[i] = (unsigned)(R * K + C) * 2u; voffB[i] = (unsigned)(Rb * K + C) * 2u; }
    const size_t kstep = (size_t)(BK * 2);
    const size_t hstep = (size_t)HALF * K * 2;
    const size_t tstep = 2 * hstep;
    const size_t tstepA = HALFM ? hstep : tstep;
    const unsigned ldsw = (unsigned)wid * 1024u;
    const int aoff = lds_byte(wr * 64 + fr, fq * 8), boff = lds_byte(wc * 32 + fr, fq * 8);
#define PG8_SA(b, h) (((b) * 2 + (h)) * HTB)
#define PG8_SB(b, h) ((4 + (b) * 2 + (h)) * HTB)
#define PG8_STAGE(bufoff, gbase, voff) do { _Pragma("unroll") for (int _i = 0; _i < 2; ++_i) \
        __builtin_amdgcn_global_load_lds((const unsigned*)((const char*)(gbase) + (voff)[_i]), (PG8_LAS unsigned*)(lds + (bufoff) + ldsw + _i * 8192), 16, 0, 0); } while (0)
#define PG8_LDA(dst, b, h) do { _Pragma("unroll") for (int m = 0; m < 4; ++m) _Pragma("unroll") for (int k = 0; k < 2; ++k) dst[m][k] = *(const PG8_LAS bf16x8*)(lds + PG8_SA(b, h) + aoff + m * 2048 + k * 1024); } while (0)
#define PG8_LDB(dst, b, h) do { _Pragma("unroll") for (int n = 0; n < 2; ++n) _Pragma("unroll") for (int k = 0; k < 2; ++k) dst[n][k] = *(const PG8_LAS bf16x8*)(lds + PG8_SB(b, h) + boff + n * 2048 + k * 1024); } while (0)
#define PG8_MMA(ai, bj, At, Bt) do { __builtin_amdgcn_s_setprio(1); _Pragma("unroll") for (int m = 0; m < 4; ++m) _Pragma("unroll") for (int n = 0; n < 2; ++n) _Pragma("unroll") for (int k = 0; k < 2; ++k) \
        acc[ai][bj][m][n] = __builtin_amdgcn_mfma_f32_16x16x32_bf16(Bt[n][k], At[m][k], acc[ai][bj][m][n], 0, 0, 0); __builtin_amdgcn_s_setprio(0); } while (0)
#define PG8_WAIT_V(n) asm volatile("s_waitcnt vmcnt(" #n ")" ::: "memory")
#define PG8_WAIT_L(n) asm volatile("s_waitcnt lgkmcnt(" #n ")" ::: "memory")
#define PG8_BAR __builtin_amdgcn_s_barrier()
#define PG8_SCHED __builtin_amdgcn_sched_barrier(0)
    Unit cur, nxt; int ui = 0;
    if (!S.next(0, cur)) return;
    f32x4 acc[2][2][4][2];
#pragma unroll
    for (int a = 0; a < 2; ++a)
#pragma unroll
        for (int b = 0; b < 2; ++b)
#pragma unroll
            for (int m = 0; m < 4; ++m)
#pragma unroll
                for (int n = 0; n < 2; ++n) acc[a][b][m][n] = (f32x4){0.f, 0.f, 0.f, 0.f};
    bf16x8 At[4][2], B0[2][2], B1[2][2];
    const char* cA = (const char*)g.A + (size_t)cur.pm * tstepA; const char* cB = (const char*)g.Bt + (size_t)cur.pn * tstep;
    S.a_ready(cur);
    if constexpr (SP2) {
        PG8_STAGE(PG8_SB(0, 0), cB, voffB); PG8_STAGE(PG8_SB(0, 1), cB + hstep, voffB); PG8_STAGE(PG8_SA(0, 0), cA, voffA); PG8_STAGE(PG8_SA(0, 1), cA + hstep, voffA);
        if (wr == 1) PG8_BAR;
        PG8_WAIT_V(2); PG8_BAR;
        PG8_STAGE(PG8_SB(1, 0), cB + kstep, voffB); PG8_STAGE(PG8_SA(1, 0), cA + kstep, voffA); PG8_STAGE(PG8_SB(1, 1), cB + hstep + kstep, voffB);
        PG8_WAIT_V(6); PG8_BAR;
    } else {
        PG8_STAGE(PG8_SB(0, 0), cB, voffB); PG8_STAGE(PG8_SA(0, 0), cA, voffA); PG8_STAGE(PG8_SB(0, 1), cB + hstep, voffB); PG8_STAGE(PG8_SA(0, 1), cA + hstep, voffA);
        if (wr == 1) PG8_BAR;
        PG8_WAIT_V(4); PG8_BAR;
        PG8_STAGE(PG8_SB(1, 0), cB + kstep, voffB); PG8_STAGE(PG8_SA(1, 0), cA + kstep, voffA); PG8_STAGE(PG8_SB(1, 1), cB + hstep + kstep, voffB);
        PG8_WAIT_V(6); PG8_BAR;
    }
    for (;;) {
        const bool has_next = S.next(ui + 1, nxt);
        const char* nA = has_next ? (const char*)g.A + (size_t)nxt.pm * tstepA : cA; const char* nB = has_next ? (const char*)g.Bt + (size_t)nxt.pn * tstep : cB;
        for (int t = 0; t < nt; t += 2) {
            const bool last = (t == nt - 2);
            const char* a1 = cA + (size_t)(t + 1) * kstep;
            const char* a2 = last ? nA : cA + (size_t)(t + 2) * kstep; const char* b2 = last ? nB : cB + (size_t)(t + 2) * kstep;
            const char* a3 = a2 + kstep; const char* b3 = b2 + kstep;
            if (last && has_next) S.a_ready(nxt);
            if constexpr (SP2) {
            PG8_LDB(B0, 0, 0); PG8_LDB(B1, 0, 1); PG8_SCHED; PG8_LDA(At, 0, 0); PG8_STAGE(PG8_SA(1, 1), a1 + hstep, voffA);
            PG8_WAIT_V(8); PG8_WAIT_L(0); PG8_BAR; PG8_MMA(0, 0, At, B0); PG8_MMA(0, 1, At, B1); PG8_BAR; PG8_SCHED;
            if constexpr (!HALFM) { PG8_LDA(At, 0, 1); } PG8_STAGE(PG8_SB(0, 0), b2, voffB); PG8_STAGE(PG8_SB(0, 1), b2 + hstep, voffB); PG8_STAGE(PG8_SA(0, 0), a2, voffA);
            PG8_WAIT_V(8); PG8_WAIT_L(0); PG8_BAR; if constexpr (!HALFM) { PG8_MMA(1, 0, At, B0); PG8_MMA(1, 1, At, B1); } PG8_BAR; PG8_SCHED;
            PG8_LDB(B0, 1, 0); PG8_LDB(B1, 1, 1); PG8_SCHED; PG8_LDA(At, 1, 0); PG8_STAGE(PG8_SA(0, 1), a2 + hstep, voffA);
            PG8_WAIT_V(8); PG8_WAIT_L(0); PG8_BAR; PG8_MMA(0, 0, At, B0); PG8_MMA(0, 1, At, B1); PG8_BAR; PG8_SCHED;
            if constexpr (!HALFM) { PG8_LDA(At, 1, 1); } PG8_STAGE(PG8_SB(1, 0), b3, voffB); PG8_STAGE(PG8_SB(1, 1), b3 + hstep, voffB); PG8_STAGE(PG8_SA(1, 0), a3, voffA);
            PG8_WAIT_V(8); PG8_WAIT_L(0); PG8_BAR; if constexpr (!HALFM) { PG8_MMA(1, 0, At, B0); PG8_MMA(1, 1, At, B1); } PG8_BAR; PG8_SCHED;
            } else {
            PG8_LDB(B0, 0, 0); PG8_SCHED; PG8_LDA(At, 0, 0); PG8_STAGE(PG8_SA(1, 1), a1 + hstep, voffA);
            PG8_WAIT_L(8); PG8_BAR; PG8_WAIT_L(0); PG8_MMA(0, 0, At, B0); PG8_BAR; PG8_SCHED;
            PG8_LDB(B1, 0, 1); PG8_STAGE(PG8_SB(0, 0), b2, voffB);
            PG8_BAR; PG8_WAIT_L(0); PG8_MMA(0, 1, At, B1); PG8_BAR;
            PG8_LDA(At, 0, 1); PG8_STAGE(PG8_SA(0, 0), a2, voffA);
            PG8_BAR; PG8_WAIT_L(0); PG8_MMA(1, 0, At, B0); PG8_BAR; PG8_SCHED;
            PG8_STAGE(PG8_SB(0, 1), b2 + hstep, voffB);
            PG8_WAIT_V(6); PG8_BAR; PG8_MMA(1, 1, At, B1); PG8_BAR;
            PG8_LDB(B0, 1, 0); PG8_SCHED; PG8_LDA(At, 1, 0); PG8_STAGE(PG8_SA(0, 1), a2 + hstep, voffA);
            PG8_WAIT_L(8); PG8_BAR; PG8_WAIT_L(0); PG8_MMA(0, 0, At, B0); PG8_BAR; PG8_SCHED;
            PG8_LDB(B1, 1, 1); PG8_STAGE(PG8_SB(1, 0), b3, voffB);
            PG8_BAR; PG8_WAIT_L(0); PG8_MMA(0, 1, At, B1); PG8_BAR;
            PG8_LDA(At, 1, 1); PG8_STAGE(PG8_SA(1, 0), a3, voffA);
            PG8_BAR; PG8_WAIT_L(0); PG8_MMA(1, 0, At, B0); PG8_BAR; PG8_SCHED;
            PG8_STAGE(PG8_SB(1, 1), b3 + hstep, voffB);
            PG8_WAIT_V(6); PG8_BAR; PG8_MMA(1, 1, At, B1); PG8_BAR;
            }
        }
        if constexpr (ALIGN_EPI) { if (wr == 0) PG8_BAR; }
        if constexpr (!Epi::AFTER_DRAIN) { E(acc, cur, wr, wc, fr, fq); S.done(cur); }
        if (!has_next) break;
#pragma unroll
        for (int a = 0; a < 2; ++a)
#pragma unroll
            for (int b = 0; b < 2; ++b)
#pragma unroll
                for (int m = 0; m < 4; ++m)
#pragma unroll
                    for (int n = 0; n < 2; ++n) acc[a][b][m][n] = (f32x4){0.f, 0.f, 0.f, 0.f};
        cur = nxt; cA = nA; cB = nB; ++ui;
        if constexpr (ALIGN_EPI) { if (wr == 1) PG8_BAR; }
    }
    PG8_WAIT_V(0);
    if constexpr (!ALIGN_EPI) { if (wr == 0) PG8_BAR; }
    PG8_BAR;
    if constexpr (Epi::AFTER_DRAIN) { E.fused(acc, cur, wr, wc, fr, fq, lds, wid, lane); S.done(cur); }
#undef PG8_SA
#undef PG8_SB
#undef PG8_STAGE
#undef PG8_LDA
#undef PG8_LDB
#undef PG8_MMA
#undef PG8_WAIT_V
#undef PG8_WAIT_L
#undef PG8_BAR
#undef PG8_SCHED
}
}

constexpr int D = 2048, BATCH = 4, SEQ = 2048, MP = BATCH * SEQ, SB = 32;
constexpr int INW = 12288, INDIM = 12352, CONVD = 8192, VALD = 4096, FF = 5632, GU = 2 * FF;
constexpr int NCH = 32;
constexpr float EPS = 1e-6f;
constexpr float LOG2E = 1.4426950408889634f;
constexpr float QSCALE = 0.125f * LOG2E;
constexpr int NWAVES = 8, NTHR = 512;

constexpr size_t MiB = 1u << 20;
constexpr size_t WS_CTL = 0, CTL_ZERO_BYTES = 4 * MiB;
constexpr size_t WS_WIN = 4 * MiB;
constexpr size_t WS_WBA = 100 * MiB;
constexpr size_t WS_WOUT = 101 * MiB;
constexpr size_t WS_WGU = 133 * MiB;
constexpr size_t WS_WDN = 309 * MiB;
constexpr size_t WS_WQKV = 397 * MiB;
constexpr size_t WS_WQ1 = 407 * MiB;
constexpr size_t WS_WO = 415 * MiB;
constexpr size_t WS_X = 431 * MiB;
constexpr size_t WS_XB = 495 * MiB;
constexpr size_t WS_PROJ = 527 * MiB;
constexpr size_t WS_BETA = 719 * MiB;
constexpr size_t WS_G = 720 * MiB;
constexpr size_t WS_PREPA = 721 * MiB;
constexpr size_t WS_PREPU = 945 * MiB;
constexpr size_t WS_EGL = 1009 * MiB;
constexpr size_t WS_OG = 1010 * MiB;
constexpr size_t WS_MID = 1074 * MiB;
constexpr size_t WS_Q = 1162 * MiB;
constexpr size_t WS_K = 1194 * MiB;
constexpr size_t WS_VT = 1198 * MiB;
constexpr size_t WS_AO = 1202 * MiB;
constexpr size_t WS_SMP = 1234 * MiB;
constexpr size_t WS_SSQP = 1242 * MiB;
constexpr size_t WS_SSQSP = 1251 * MiB;
constexpr size_t WS_END = 1252 * MiB;
constexpr size_t SM_XS = 0;
constexpr size_t SM_XSB = 262144;
constexpr size_t SM_PROJS = 393216;
constexpr size_t SM_QKVS = 2 * MiB;
constexpr size_t SM_BETAS = 3 * MiB;
constexpr size_t SM_GS = 3 * MiB + 4096;
constexpr size_t SM_OGS = 3 * MiB + 8192;
constexpr size_t SM_MIDS = 4 * MiB;
constexpr size_t SM_QS = 5 * MiB;
constexpr size_t SM_KVS = 5 * MiB + 262144;
constexpr size_t SM_AOS = 6 * MiB;
constexpr int CW_BAR = 4096;
constexpr int CW_SSQ = 16384;
constexpr int CW_SSQS = 16384 + 9 * 8192;
constexpr int PREPA_REC = 57344, PREPU_REC = 16384;

constexpr int LDS_BYTES = 147456, MISC_OFF = LDS_BYTES - 256;

#define GAS __attribute__((address_space(1)))
#define LAS __attribute__((address_space(3)))
typedef unsigned short bf16_t;
typedef unsigned u32x4 __attribute__((ext_vector_type(4)));
typedef unsigned u32x2 __attribute__((ext_vector_type(2)));
typedef float f32x4 __attribute__((ext_vector_type(4)));
typedef float f32x16 __attribute__((ext_vector_type(16)));
typedef short bf16x8 __attribute__((ext_vector_type(8)));
typedef short bf16x4 __attribute__((ext_vector_type(4)));
#define LDS_WAIT() asm volatile("s_waitcnt lgkmcnt(0)" ::: "memory")
#define VM_WAIT() asm volatile("s_waitcnt vmcnt(0)" ::: "memory")
#define MFMA16(a, b, c) __builtin_amdgcn_mfma_f32_16x16x32_bf16((a), (b), (c), 0, 0, 0)
#define MFMA32(a, b, c) __builtin_amdgcn_mfma_f32_32x32x16_bf16((a), (b), (c), 0, 0, 0)

__device__ __forceinline__ float bf2f(bf16_t v) { return __uint_as_float((unsigned)v << 16); }
typedef float f32x2_t __attribute__((ext_vector_type(2))); typedef __bf16 bf16x2_t __attribute__((ext_vector_type(2)));
__device__ __forceinline__ unsigned pk2(float lo, float hi) { const f32x2_t v = {lo, hi}; const bf16x2_t b = __builtin_convertvector(v, bf16x2_t); return __builtin_bit_cast(unsigned, b); }
__device__ __forceinline__ bf16_t f2bf(float f) { return (bf16_t)(pk2(f, 0.f) & 0xffffu); }
__device__ __forceinline__ float fast_exp2(float x) { return __builtin_amdgcn_exp2f(x); }
__device__ __forceinline__ float fast_exp(float x) { return __builtin_amdgcn_exp2f(x * LOG2E); }
__device__ __forceinline__ float fast_rcp(float x) { return __builtin_amdgcn_rcpf(x); }
__device__ __forceinline__ float silu_f(float x) { return x * fast_rcp(1.0f + fast_exp(-x)); }
__device__ __forceinline__ float fast_rsq(float x) { return __builtin_amdgcn_rsqf(x); }
__device__ __forceinline__ float fast_log2(float x) { return __builtin_amdgcn_logf(x); }
__device__ __forceinline__ float sigmoid_f(float x) { return fast_rcp(1.0f + fast_exp(-x)); }
__device__ __forceinline__ float softplus_f(float x) { return x > 15.f ? x : fast_log2(1.0f + fast_exp(x)) * 0.6931471805599453f; }
__device__ __forceinline__ float rinv_of(float ssq) { return fast_rsq(ssq * (1.0f / D) + EPS); }
__device__ __forceinline__ float wave_sum(float v) {
#pragma unroll
    for (int o = 1; o < 64; o <<= 1) v += __shfl_xor(v, o);
    return v;
}
__device__ __forceinline__ float sum_fq4(float s) {
    { const auto r = __builtin_amdgcn_permlane16_swap(__float_as_uint(s), __float_as_uint(s), false, false); s = __uint_as_float(r[0]) + __uint_as_float(r[1]); }
    { const auto r = __builtin_amdgcn_permlane32_swap(__float_as_uint(s), __float_as_uint(s), false, false); s = __uint_as_float(r[0]) + __uint_as_float(r[1]); }
    return s;
}
__device__ __forceinline__ float rinv_row4(const float* ssqp, int row, int fq) {
    const f32x4* p = (const f32x4*)(ssqp + (size_t)row * 32 + 8 * fq); const f32x4 a = p[0], b = p[1];
    float s = ((a[0] + a[1]) + (a[2] + a[3])) + ((b[0] + b[1]) + (b[2] + b[3]));
    return rinv_of(sum_fq4(s));
}
__device__ __forceinline__ float rinv_row_full(const float* ssqp, int row) {
    const f32x4* p = (const f32x4*)(ssqp + (size_t)row * 32); float s = 0.f;
#pragma unroll
    for (int i = 0; i < 8; ++i) { const f32x4 a = p[i]; s += (a[0] + a[1]) + (a[2] + a[3]); }
    return rinv_of(s);
}
__device__ __forceinline__ int crow32(int r, int hi) { return (r & 3) + 8 * (r >> 2) + 4 * hi; }

namespace pg8 {
struct EpiProj {
    static constexpr bool PERM = true, AFTER_DRAIN = false;
    bf16_t* O; int ldc; const float* ssq; int silu_from;
    __device__ __forceinline__ void operator()(const f32x4 (&acc)[2][2][4][2], const Unit& u, int wr, int wc, int fr, int fq) const {
        asm volatile("" : "+v"(fr), "+v"(fq));
        const int row0 = u.pm * BM + wr * 64 + fr, col0 = u.pn * BM + wc * 32 + 8 * fq;
#pragma unroll
        for (int ai = 0; ai < 2; ++ai)
#pragma unroll
            for (int m = 0; m < 4; ++m) { const int row = row0 + ai * HALF + m * 16; const float ri = rinv_row4(ssq, row, fq); bf16_t* rowp = O + (size_t)row * ldc + col0;
#pragma unroll
                for (int bj = 0; bj < 2; ++bj) { f32x4 v0 = acc[ai][bj][m][0] * ri, v1 = acc[ai][bj][m][1] * ri;
                    if (u.pn >= silu_from) {
#pragma unroll
                        for (int e = 0; e < 4; ++e) { v0[e] = silu_f(v0[e]); v1[e] = silu_f(v1[e]); } }
                    u32x4 w; w.x = cvt_pk_bf16(v0[0], v0[1]); w.y = cvt_pk_bf16(v0[2], v0[3]); w.z = cvt_pk_bf16(v1[0], v1[1]); w.w = cvt_pk_bf16(v1[2], v1[3]);
                    *(u32x4*)(rowp + bj * HALF) = w; } }
    }
};
struct EpiRes {
    static constexpr bool PERM = true, AFTER_DRAIN = false;
    const float* base; float* X; bf16_t* XB; float* ssq;
    __device__ __forceinline__ void operator()(const f32x4 (&acc)[2][2][4][2], const Unit& u, int wr, int wc, int fr, int fq) const {
        asm volatile("" : "+v"(fr), "+v"(fq));
        const int row0 = u.pm * BM + wr * 64 + fr, col0 = u.pn * BM + wc * 32 + 8 * fq;
#pragma unroll
        for (int ai = 0; ai < 2; ++ai)
#pragma unroll
            for (int m = 0; m < 4; ++m) { const int row = row0 + ai * HALF + m * 16; const size_t off = (size_t)row * D + col0; float s = 0.f;
#pragma unroll
                for (int bj = 0; bj < 2; ++bj) { const f32x4 b0 = *(const f32x4*)(base + off + bj * HALF), b1 = *(const f32x4*)(base + off + bj * HALF + 4);
                    const f32x4 v0 = acc[ai][bj][m][0] + b0, v1 = acc[ai][bj][m][1] + b1;
                    *(f32x4*)(X + off + bj * HALF) = v0; *(f32x4*)(X + off + bj * HALF + 4) = v1;
                    u32x4 w; w.x = cvt_pk_bf16(v0[0], v0[1]); w.y = cvt_pk_bf16(v0[2], v0[3]); w.z = cvt_pk_bf16(v1[0], v1[1]); w.w = cvt_pk_bf16(v1[2], v1[3]);
                    *(u32x4*)(XB + off + bj * HALF) = w;
                    s += (v0[0] * v0[0] + v0[1] * v0[1]) + (v0[2] * v0[2] + v0[3] * v0[3]) + (v1[0] * v1[0] + v1[1] * v1[1]) + (v1[2] * v1[2] + v1[3] * v1[3]); }
                s = sum_fq4(s);
                if (fq == 0) ssq[(size_t)row * 32 + u.pn * 4 + wc] = s; }
    }
};
template <bool HALFM> struct EpiSwigluT {
    static constexpr bool PERM = true, AFTER_DRAIN = false;
    bf16_t* O; const float* ssq;
    __device__ __forceinline__ void operator()(const f32x4 (&acc)[2][2][4][2], const Unit& u, int wr, int wc, int fr, int fq) const {
        asm volatile("" : "+v"(fr), "+v"(fq));
        const int row0 = u.pm * (HALFM ? HALF : BM) + wr * 64 + fr, col0 = u.pn * HALF + wc * 32 + 8 * fq;
#pragma unroll
        for (int ai = 0; ai < (HALFM ? 1 : 2); ++ai)
#pragma unroll
            for (int m = 0; m < 4; ++m) { const int row = row0 + ai * HALF + m * 16; const float ri = rinv_row4(ssq, row, fq); float o[8];
#pragma unroll
                for (int n = 0; n < 2; ++n)
#pragma unroll
                    for (int e = 0; e < 4; ++e) { const float g = acc[ai][0][m][n][e] * ri, up = acc[ai][1][m][n][e] * ri; o[4 * n + e] = silu_f(g) * up; }
                u32x4 w; w.x = cvt_pk_bf16(o[0], o[1]); w.y = cvt_pk_bf16(o[2], o[3]); w.z = cvt_pk_bf16(o[4], o[5]); w.w = cvt_pk_bf16(o[6], o[7]);
                *(u32x4*)(O + (size_t)row * FF + col0) = w; }
    }
};
template <bool HALFM> struct EpiQKVT {
    static constexpr bool PERM = true, AFTER_DRAIN = false;
    bf16_t* Q; bf16_t* KB; bf16_t* VT; float* kwin; float* vwin; const float* ssq;
    __device__ __forceinline__ void operator()(const f32x4 (&acc)[2][2][4][2], const Unit& u, int wr, int wc, int fr, int fq) const {
        asm volatile("" : "+v"(fr), "+v"(fq));
        const int row0 = u.pm * (HALFM ? HALF : BM) + wr * 64 + fr, cl0 = wc * 32 + 8 * fq;
#pragma unroll
        for (int ai = 0; ai < (HALFM ? 1 : 2); ++ai)
#pragma unroll
            for (int m = 0; m < 4; ++m) { const int row = row0 + ai * HALF + m * 16; const float ri = rinv_row4(ssq, row, fq); const int b = row >> 11, t = row & 2047;
#pragma unroll
                for (int bj = 0; bj < 2; ++bj) { const f32x4 v0 = acc[ai][bj][m][0] * ri, v1 = acc[ai][bj][m][1] * ri; const int cl = cl0 + bj * HALF;
                    if (u.pn < 8) {
                        u32x4 w; w.x = cvt_pk_bf16(v0[0], v0[1]); w.y = cvt_pk_bf16(v0[2], v0[3]); w.z = cvt_pk_bf16(v1[0], v1[1]); w.w = cvt_pk_bf16(v1[2], v1[3]);
                        *(u32x4*)(Q + (size_t)row * D + u.pn * BM + cl) = w;
                    } else if (u.pn == 8) {
                        u32x4 w; w.x = cvt_pk_bf16(v0[0], v0[1]); w.y = cvt_pk_bf16(v0[2], v0[3]); w.z = cvt_pk_bf16(v1[0], v1[1]); w.w = cvt_pk_bf16(v1[2], v1[3]);
                        *(u32x4*)(KB + (size_t)row * 256 + cl) = w;
                        if (t >= SEQ - 128) { float* o = kwin + ((size_t)(b * 128 + t - (SEQ - 128))) * 256 + cl; *(f32x4*)o = v0; *(f32x4*)(o + 4) = v1; }
                    } else {
                        const float vv[8] = {v0[0], v0[1], v0[2], v0[3], v1[0], v1[1], v1[2], v1[3]};
#pragma unroll
                        for (int e = 0; e < 8; ++e) { const int c = cl + e; VT[((size_t)(b * 4 + (c >> 6)) * 64 + (c & 63)) * SEQ + t] = (bf16_t)(cvt_pk_bf16(vv[e], 0.f) & 0xffffu); }
                        if (t >= SEQ - 128) { float* o = vwin + ((size_t)(b * 128 + t - (SEQ - 128))) * 256 + cl; *(f32x4*)o = v0; *(f32x4*)(o + 4) = v1; }
                    } } }
    }
};
}

struct TrItem { const float* src; bf16_t* dst; const float* gain; int ld, col0, K, k0, drow0; float scale; };
__device__ __forceinline__ void tr_load(const TrItem& T, f32x4 (&v)[16], float (&g)[16], int lane) {
#pragma unroll
    for (int i = 0; i < 16; ++i) {
        const int kk = 4 * i + (lane >> 4);
        v[i] = *(const f32x4*)(T.src + (size_t)(T.k0 + kk) * T.ld + T.col0 + 4 * (lane & 15));
        g[i] = T.gain ? T.gain[T.k0 + kk] : 1.0f;
    }
}
__device__ __forceinline__ void tr_store(const TrItem& T, const f32x4 (&v)[16], const float (&g)[16], LAS float* scr, int lane) {
#pragma unroll
    for (int i = 0; i < 16; ++i) {
        const int kk = 4 * i + (lane >> 4); const float gg = g[i] * T.scale;
        LAS float* p = scr + kk * 65 + 4 * (lane & 15);
        p[0] = v[i][0] * gg; p[1] = v[i][1] * gg; p[2] = v[i][2] * gg; p[3] = v[i][3] * gg;
    }
    LDS_WAIT();
#pragma unroll
    for (int j = 0; j < 8; ++j) {
        const int idx = j * 64 + lane, n = idx >> 3, kc = idx & 7;
        const LAS float* s = scr + (8 * kc) * 65 + n;
        u32x4 o; o.x = pk2(s[0], s[65]); o.y = pk2(s[2 * 65], s[3 * 65]); o.z = pk2(s[4 * 65], s[5 * 65]); o.w = pk2(s[6 * 65], s[7 * 65]);
        *(u32x4*)(T.dst + (size_t)(T.drow0 + n) * T.K + T.k0 + 8 * kc) = o;
    }
    LDS_WAIT();
}

typedef const float* const __attribute__((address_space(4)))* KP_T;
constexpr int CV_IN = 32 * 192, CV_BA = 32, CV_OUT = 64 * 32, CV_GU = 32 * 176, CV_DN = 88 * 32, CV_KV = 32 * 8, CV_Q = 32 * 32;
constexpr int CV_A = CV_IN + CV_BA + CV_OUT + CV_GU + CV_DN;
constexpr int CV_B0 = CV_KV + 2 * CV_Q + CV_GU + CV_DN;
constexpr int CV_B1 = 2 * CV_Q + CV_GU + CV_DN;
__host__ __device__ constexpr int cv_count(int lam) { return lam < 2 ? CV_A : (lam == 2 ? CV_B0 : CV_B1); }
__device__ __forceinline__ TrItem tr_decode(KP_T kp, unsigned char* ws, int lam, int r) {
    TrItem T; T.scale = 1.f; T.gain = nullptr;
    const float* w_gu_ = kp[20] + (size_t)lam * D * GU; const float* w_dn_ = kp[21] + (size_t)lam * FF * D;
    bf16_t* WGU = (bf16_t*)(ws + WS_WGU) + (size_t)lam * GU * D; bf16_t* WDN = (bf16_t*)(ws + WS_WDN) + (size_t)lam * D * FF;
    if (lam < 2) {
        const float* w_in_ = kp[8] + (size_t)lam * D * INDIM; const float* nm = kp[6] + lam * D;
        if (r < CV_IN) { const int kb = r / 192, nb = r % 192;
            T.src = w_in_; T.ld = INDIM; T.col0 = 64 * nb; T.K = D; T.k0 = 64 * kb; T.dst = (bf16_t*)(ws + WS_WIN) + (size_t)lam * INW * D; T.drow0 = 64 * nb; T.gain = nm; return T; } r -= CV_IN;
        if (r < CV_BA) { T.src = w_in_; T.ld = INDIM; T.col0 = INW; T.K = D; T.k0 = 64 * r; T.dst = (bf16_t*)(ws + WS_WBA) + (size_t)lam * 64 * D; T.drow0 = 0; T.gain = nm; return T; } r -= CV_BA;
        if (r < CV_OUT) { const int kb = r / 32, nb = r % 32;
            T.src = kp[13] + (size_t)lam * VALD * D; T.ld = D; T.col0 = 64 * nb; T.K = VALD; T.k0 = 64 * kb; T.dst = (bf16_t*)(ws + WS_WOUT) + (size_t)lam * D * VALD; T.drow0 = 64 * nb; return T; } r -= CV_OUT;
    } else {
        const int j = lam - 2;
        if (j == 0) { if (r < CV_KV) { const int kb = r / 8, nb = r % 8;
            T.src = kp[15]; T.ld = 512; T.col0 = 64 * nb; T.K = D; T.k0 = 64 * kb; T.dst = (bf16_t*)(ws + WS_WQKV); T.drow0 = 2048 + 64 * nb; T.gain = kp[14]; return T; } r -= CV_KV; }
        if (r < CV_Q) { const int kb = r / 32, nb = r % 32;
            T.src = kp[16] + (size_t)j * D * D; T.ld = D; T.col0 = 64 * nb; T.K = D; T.k0 = 64 * kb; T.dst = (bf16_t*)(ws + (j == 0 ? WS_WQKV : WS_WQ1)); T.drow0 = 64 * nb; T.gain = kp[6] + (2 + j) * D; T.scale = QSCALE; return T; } r -= CV_Q;
        if (r < CV_Q) { const int kb = r / 32, nb = r % 32;
            T.src = kp[17] + (size_t)j * D * D; T.ld = D; T.col0 = 64 * nb; T.K = D; T.k0 = 64 * kb; T.dst = (bf16_t*)(ws + WS_WO) + (size_t)j * D * D; T.drow0 = 64 * nb; return T; } r -= CV_Q;
    }
    if (r < CV_GU) { const int kb = r / 176, nb = r % 176; const int c = 64 * nb;
        T.src = w_gu_; T.ld = GU; T.col0 = c; T.K = D; T.k0 = 64 * kb; T.dst = WGU;
        T.drow0 = c < FF ? 256 * (c >> 7) + (c & 127) : 256 * ((c - FF) >> 7) + 128 + ((c - FF) & 127); T.gain = kp[7] + lam * D; return T; } r -= CV_GU;
    { const int kb = r / 32, nb = r % 32;
        T.src = w_dn_; T.ld = D; T.col0 = 64 * nb; T.K = FF; T.k0 = 64 * kb; T.dst = WDN; T.drow0 = 64 * nb; return T; }
}
__device__ __forceinline__ void convert_range(KP_T kp, unsigned char* ws, int lam, int first, int count, int worker, int nworkers, LAS float* scr, int lane) {
    for (int it = worker; it < count; it += nworkers) {
        f32x4 va[16]; float ga[16];
        const TrItem T = tr_decode(kp, ws, lam, first + it);
        tr_load(T, va, ga, lane);
        tr_store(T, va, ga, scr, lane);
    }
}

__device__ __forceinline__ void row_to_bf16(const float* __restrict__ xrow, bf16_t* __restrict__ orow, float* ssq_out, int npart, int lane) {
    const f32x4* xr = (const f32x4*)xrow + lane;
    f32x4 v[8]; float s = 0.f;
#pragma unroll
    for (int j = 0; j < 8; ++j) { v[j] = xr[64 * j]; s += (v[j][0] * v[j][0] + v[j][1] * v[j][1]) + (v[j][2] * v[j][2] + v[j][3] * v[j][3]); }
    s = wave_sum(s);
    if (lane < npart) ssq_out[lane] = lane == 0 ? s : 0.f;
    u32x2* o8 = (u32x2*)orow + lane;
#pragma unroll
    for (int j = 0; j < 8; ++j) { u32x2 w; w.x = pk2(v[j][0], v[j][1]); w.y = pk2(v[j][2], v[j][3]); o8[64 * j] = w; }
}

template <bool PAIR, class F>
__device__ __forceinline__ void skinny_unit(const bf16_t* __restrict__ A, int lda, const bf16_t* __restrict__ B0, const bf16_t* __restrict__ B1, int ldb, int K,
                                            LAS float* red, int wid, int lane, int tid, F&& epi) {
    asm volatile("" : "+v"(tid), "+v"(lane));
    const int kw = K >> 3, kbeg = wid * kw;
    f32x16 acc0, acc1;
#pragma unroll
    for (int r = 0; r < 16; ++r) { acc0[r] = 0.f; acc1[r] = 0.f; }
    const bf16_t* ap = A + (size_t)(lane & 31) * lda + kbeg + 8 * (lane >> 5);
    const bf16_t* bp0 = B0 + (size_t)(lane & 31) * ldb + kbeg + 8 * (lane >> 5);
    const bf16_t* bp1 = (PAIR ? B1 : B0) + (size_t)(lane & 31) * ldb + kbeg + 8 * (lane >> 5);
    bf16x8 fa[4], fb0[4], fb1[4], ga[4], gb0[4], gb1[4];
#pragma unroll
    for (int i = 0; i < 4; ++i) { fa[i] = *(const bf16x8*)(ap + 16 * i); fb0[i] = *(const bf16x8*)(bp0 + 16 * i); if (PAIR) fb1[i] = *(const bf16x8*)(bp1 + 16 * i); }
    for (int k = 0; k < kw; k += 64) {
        const int kn = k + 64 < kw ? k + 64 : k;
#pragma unroll
        for (int i = 0; i < 4; ++i) { ga[i] = *(const bf16x8*)(ap + kn + 16 * i); gb0[i] = *(const bf16x8*)(bp0 + kn + 16 * i); if (PAIR) gb1[i] = *(const bf16x8*)(bp1 + kn + 16 * i); }
        __builtin_amdgcn_sched_barrier(0);
#pragma unroll
        for (int i = 0; i < 4; ++i) { acc0 = MFMA32(fa[i], fb0[i], acc0); if (PAIR) acc1 = MFMA32(fa[i], fb1[i], acc1); }
        __builtin_amdgcn_sched_barrier(0);
#pragma unroll
        for (int i = 0; i < 4; ++i) { fa[i] = ga[i]; fb0[i] = gb0[i]; if (PAIR) fb1[i] = gb1[i]; }
    }
#pragma unroll
    for (int r = 0; r < 16; ++r) { red[((wid * 2 + 0) * 16 + r) * 64 + lane] = acc0[r]; if (PAIR) red[((wid * 2 + 1) * 16 + r) * 64 + lane] = acc1[r]; }
    __syncthreads();
#pragma unroll
    for (int q = 0; q < 2; ++q) {
        const int e = tid + 512 * q, r = e >> 6, ln = e & 63;
        float v0 = 0.f, v1 = 0.f;
#pragma unroll
        for (int w = 0; w < 8; ++w) { v0 += red[((w * 2 + 0) * 16 + r) * 64 + ln]; if (PAIR) v1 += red[((w * 2 + 1) * 16 + r) * 64 + ln]; }
        epi(crow32(r, ln >> 5), ln & 31, v0, v1);
    }
    __syncthreads();
}

constexpr int PL_QN = 0, PL_KN = 18432, PL_KT = 36864, PL_VT = 55296, PL_AM = 92160, PL_TAB = 126976;
constexpr int PL_T = 0, PL_TP = 18432;
constexpr int NAT_LD = 136, TR_LD = 72, AM_LD = 68;


__host__ __device__ constexpr int ti_q(int idx) { int q = 0; while ((q + 1) * (q + 2) / 2 <= idx) ++q; return q; }
template <int IDX> __device__ __forceinline__ void ti_load(const LAS float* A, f32x4 (&buf)[4][4]) {
    constexpr int q = ti_q(IDX), g = IDX - q * (q + 1) / 2;
#pragma unroll
    for (int r = 0; r < 4; ++r) buf[IDX % 4][r] = *(const LAS f32x4*)(A + (4 * q + r) * AM_LD + 4 * g);
}
template <int IDX, int END> __device__ __forceinline__ void ti_prologue(const LAS float* A, f32x4 (&buf)[4][4]) {
    if constexpr (IDX < END) { ti_load<IDX>(A, buf); ti_prologue<IDX + 1, END>(A, buf); }
}
typedef float f32x2v __attribute__((ext_vector_type(2)));
template <int IDX, int END, int DEPTH> __device__ __forceinline__ void ti_steps(const LAS float* A, f32x4 (&buf)[4][4], f32x2v (&tn)[32], f32x2v (&acc)[4], int c) {
    if constexpr (IDX < END) {
        constexpr int q = ti_q(IDX), g = IDX - q * (q + 1) / 2;
        __builtin_amdgcn_sched_barrier(0);
        if constexpr (g == 0) {
#pragma unroll
            for (int r = 0; r < 4; ++r) acc[r] = (f32x2v){(c == 4 * q + r) ? 1.f : 0.f, 0.f};
        }
        if constexpr (g < q) {
#pragma unroll
            for (int r = 0; r < 4; ++r) { const f32x4 av = buf[IDX % 4][r];
                acc[r] = __builtin_elementwise_fma((f32x2v){av[0], av[1]}, tn[2 * g], acc[r]);
                acc[r] = __builtin_elementwise_fma((f32x2v){av[2], av[3]}, tn[2 * g + 1], acc[r]); }
        } else {
            const f32x4 a1 = buf[IDX % 4][1], a2 = buf[IDX % 4][2], a3 = buf[IDX % 4][3];
            const float t0 = acc[0][0] + acc[0][1];
            const float t1 = (acc[1][0] + acc[1][1]) - a1[0] * t0;
            const float t2 = (acc[2][0] + acc[2][1]) - (a2[0] * t0 + a2[1] * t1);
            const float t3 = (acc[3][0] + acc[3][1]) - ((a3[0] * t0 + a3[1] * t1) + a3[2] * t2);
            tn[2 * q] = (f32x2v){-t0, -t1}; tn[2 * q + 1] = (f32x2v){-t2, -t3};
        }
        __builtin_amdgcn_sched_barrier(0);
        if constexpr (IDX + DEPTH < END) ti_load<IDX + DEPTH>(A, buf);
        ti_steps<IDX + 1, END, DEPTH>(A, buf, tn, acc, c);
    }
}

struct PrepArgs { const bf16_t* proj; const float* beta; const float* g; const float* convw; unsigned char* prepa; unsigned char* prepu; float* egl; float* conv_p; int xf; };

struct PrepRaw { bf16_t h0, h1, h2; bf16_t raw[64]; float c0, c1, c2, c3; float gv, bt; };
__device__ __forceinline__ void prep_fetch(const PrepArgs& P, int b, int kh, int n, int tid, int wid, int lane, PrepRaw& R) {
    const int r0 = b * SEQ + n * 64, t = tid;
    const int gcol = t < 128 ? kh * 128 + t : (t < 256 ? 2048 + kh * 128 + (t - 128) : 4096 + kh * 256 + (t - 256));
    R.c0 = P.convw[gcol]; R.c1 = P.convw[CONVD + gcol]; R.c2 = P.convw[2 * CONVD + gcol]; R.c3 = P.convw[3 * CONVD + gcol];
    const bf16_t* pp = P.proj + (size_t)r0 * INW + gcol;
    R.h0 = 0; R.h1 = 0; R.h2 = 0;
    if (n > 0) { R.h0 = pp[-3 * (long)INW]; R.h1 = pp[-2 * (long)INW]; R.h2 = pp[-(long)INW]; }
#pragma unroll
    for (int j = 0; j < 64; ++j) R.raw[j] = pp[(size_t)j * INW];
    R.gv = 0.f; R.bt = 0.f;
    if (wid < 2) { const int hv = 2 * kh + wid; R.gv = P.g[(size_t)(r0 + lane) * 32 + hv]; R.bt = P.beta[(size_t)(r0 + lane) * 32 + hv]; }
}
__device__ __forceinline__ void prep_unit(const PrepArgs& P, LAS unsigned char* lds, int b, int kh, int n, int tid, int wid, int lane) {
    asm volatile("" : "+v"(tid), "+v"(lane));
    PrepRaw R; prep_fetch(P, b, kh, n, tid, wid, lane, R);
    LAS bf16_t* QN = (LAS bf16_t*)(lds + PL_QN); LAS bf16_t* KN = (LAS bf16_t*)(lds + PL_KN);
    LAS bf16_t* KT = (LAS bf16_t*)(lds + PL_KT); LAS bf16_t* VTt = (LAS bf16_t*)(lds + PL_VT);
    LAS float* AM = (LAS float*)(lds + PL_AM); LAS float* TAB = (LAS float*)(lds + PL_TAB);
    const int r0 = b * SEQ + n * 64;
    if (wid < 2) {
        float gv = R.gv;
#pragma unroll
        for (int o = 1; o < 64; o <<= 1) { const float t = __shfl_up(gv, o); if (lane >= o) gv += t; }
        TAB[wid * 64 + lane] = gv;
        TAB[128 + wid * 64 + lane] = R.bt;
    }
    __syncthreads();
    {
        const int t = tid;
        const int gcol = t < 128 ? kh * 128 + t : (t < 256 ? 2048 + kh * 128 + (t - 128) : 4096 + kh * 256 + (t - 256));
        const float c0 = R.c0, c1 = R.c1, c2 = R.c2, c3 = R.c3;
        float w0 = bf2f(R.h0), w1 = bf2f(R.h1), w2 = bf2f(R.h2);
        const int vh = (t - 256) >> 7;
#pragma unroll
        for (int jb = 0; jb < 8; ++jb) {
            float raw[8];
#pragma unroll
            for (int e = 0; e < 8; ++e) raw[e] = bf2f(R.raw[jb * 8 + e]);
            float ov[8];
#pragma unroll
            for (int e = 0; e < 8; ++e) { const float cv = w0 * c0 + w1 * c1 + w2 * c2 + raw[e] * c3; ov[e] = silu_f(cv); w0 = w1; w1 = w2; w2 = raw[e]; }
            if (t < 256) {
                LAS bf16_t* nat = (t < 128 ? QN : KN) + (t & 127);
#pragma unroll
                for (int e = 0; e < 8; ++e) nat[(jb * 8 + e) * NAT_LD] = f2bf(ov[e]);
                if (t >= 128) { u32x4 w; w.x = pk2(ov[0], ov[1]); w.y = pk2(ov[2], ov[3]); w.z = pk2(ov[4], ov[5]); w.w = pk2(ov[6], ov[7]);
                    *(LAS u32x4*)(KT + (t - 128) * TR_LD + jb * 8) = w; }
            } else {
                const LAS float* bt = TAB + 128 + vh * 64 + jb * 8;
                u32x4 w; w.x = pk2(ov[0] * bt[0], ov[1] * bt[1]); w.y = pk2(ov[2] * bt[2], ov[3] * bt[3]); w.z = pk2(ov[4] * bt[4], ov[5] * bt[5]); w.w = pk2(ov[6] * bt[6], ov[7] * bt[7]);
                *(LAS u32x4*)(VTt + (t - 256) * TR_LD + jb * 8) = w;
            }
            if (n == NCH - 1 && jb == 7) {
#pragma unroll
                for (int e = 5; e < 8; ++e) P.conv_p[((size_t)b * 3 + (e - 5)) * CONVD + gcol] = raw[e];
            }
        }
    }
    __syncthreads();
    if (P.xf & 512) return;
    {
        const int arr = tid >> 8, row = (tid >> 2) & 63, part = tid & 3;
        const LAS bf16_t* p = (arr ? KN : QN) + row * NAT_LD + part * 32;
        float s = 0.f;
#pragma unroll
        for (int c = 0; c < 4; ++c) { const bf16x8 v = *(const LAS bf16x8*)(p + c * 8);
#pragma unroll
            for (int e = 0; e < 8; ++e) { const float f = bf2f((bf16_t)v[e]); s += f * f; } }
        s += __shfl_xor(s, 1); s += __shfl_xor(s, 2);
        if (part == 0) TAB[256 + arr * 64 + row] = fast_rsq(s + EPS);
    }
    __syncthreads();
    const int m16 = lane & 15, q4 = lane >> 4;
    unsigned char* recA0 = P.prepa + (size_t)((b * 32 + 2 * kh) * NCH + n) * PREPA_REC;
    const size_t hstrideA = (size_t)NCH * PREPA_REC;
    {
        const int half = wid >> 2, it = wid & 3;
        f32x4 acc[4];
#pragma unroll
        for (int jt = 0; jt < 4; ++jt) acc[jt] = (f32x4){0.f, 0.f, 0.f, 0.f};
        if (half == 0) {
#pragma unroll
            for (int s = 0; s < 4; ++s) { const bf16x8 bq = *(const LAS bf16x8*)(QN + (16 * it + m16) * NAT_LD + 32 * s + 8 * q4);
#pragma unroll
                for (int jt = 0; jt < 4; ++jt) { const bf16x8 ak = *(const LAS bf16x8*)(KN + (16 * jt + m16) * NAT_LD + 32 * s + 8 * q4); acc[jt] = MFMA16(ak, bq, acc[jt]); } }
            const int i = 16 * it + m16; const float rqi = TAB[256 + i] * 0.08838834764831845f;
#pragma unroll
            for (int h = 0; h < 2; ++h) { const float gci = TAB[h * 64 + i];
#pragma unroll
                for (int s = 0; s < 2; ++s) { float o[8];
#pragma unroll
                    for (int e = 0; e < 8; ++e) { const int jt = 2 * s + (e >> 2), j = 16 * jt + 4 * q4 + (e & 3);
                        const float dec = fast_exp(gci - TAB[h * 64 + j]); o[e] = (i >= j) ? acc[jt][e & 3] * rqi * TAB[320 + j] * dec : 0.f; }
                    u32x4 w; w.x = pk2(o[0], o[1]); w.y = pk2(o[2], o[3]); w.z = pk2(o[4], o[5]); w.w = pk2(o[6], o[7]);
                    *(u32x4*)(recA0 + h * hstrideA + (48 + it * 2 + s) * 1024 + lane * 16) = w; } }
        } else {
#pragma unroll
            for (int s = 0; s < 4; ++s) { const bf16x8 ai = *(const LAS bf16x8*)(KN + (16 * it + m16) * NAT_LD + 32 * s + 8 * q4);
#pragma unroll
                for (int jt = 0; jt < 4; ++jt) { const bf16x8 bk = *(const LAS bf16x8*)(KN + (16 * jt + m16) * NAT_LD + 32 * s + 8 * q4); acc[jt] = MFMA16(ai, bk, acc[jt]); } }
#pragma unroll
            for (int jt = 0; jt < 4; ++jt) { const int j = 16 * jt + m16; const float rkj = TAB[320 + j];
#pragma unroll
                for (int e = 0; e < 4; ++e) { const int i = 16 * it + 4 * q4 + e; const float base = acc[jt][e] * rkj * TAB[320 + i];
#pragma unroll
                    for (int h = 0; h < 2; ++h) { const float dec = fast_exp(TAB[h * 64 + i] - TAB[h * 64 + j]);
                        AM[h * 64 * AM_LD + i * AM_LD + j] = (i > j) ? base * TAB[128 + h * 64 + i] * dec : 0.f; } } }
        }
        {
            const int h = wid >> 2, mt = wid & 3, i = 16 * mt + m16;
            const float sc = TAB[256 + i] * 0.08838834764831845f * fast_exp(TAB[h * 64 + i]);
#pragma unroll
            for (int s = 0; s < 4; ++s) {
                const bf16x4 lo = *(const LAS bf16x4*)(QN + i * NAT_LD + 32 * s + 4 * q4), hi = *(const LAS bf16x4*)(QN + i * NAT_LD + 32 * s + 16 + 4 * q4);
                u32x4 w; w.x = pk2(bf2f((bf16_t)lo[0]) * sc, bf2f((bf16_t)lo[1]) * sc); w.y = pk2(bf2f((bf16_t)lo[2]) * sc, bf2f((bf16_t)lo[3]) * sc);
                w.z = pk2(bf2f((bf16_t)hi[0]) * sc, bf2f((bf16_t)hi[1]) * sc); w.w = pk2(bf2f((bf16_t)hi[2]) * sc, bf2f((bf16_t)hi[3]) * sc);
                *(u32x4*)(recA0 + h * hstrideA + (16 + mt * 4 + s) * 1024 + lane * 16) = w;
            }
        }
    }
    __syncthreads();
    if (P.xf & 1024) return;
    asm volatile("" : "+v"(lane));
    if (wid < 2) {
        const int h = wid, c = lane;
        const LAS float* A = AM + h * 64 * AM_LD;
        f32x2v tn[32];
        constexpr int TIDEPTH = 4, NGRP = 136;
        f32x4 buf[TIDEPTH][4];
        ti_prologue<0, TIDEPTH>(A, buf);
        f32x2v acc[4];
        ti_steps<0, NGRP, TIDEPTH>(A, buf, tn, acc, c);
        const float scc = -TAB[320 + c] * TAB[128 + h * 64 + c] * fast_exp(TAB[h * 64 + c]);
        LAS bf16_t* T = (LAS bf16_t*)(lds + PL_T + h * 9216); LAS bf16_t* TP = (LAS bf16_t*)(lds + PL_TP + h * 9216);
#pragma unroll
        for (int i = 0; i < 64; ++i) { const float ti = -tn[i >> 1][i & 1]; T[i * TR_LD + c] = f2bf(ti); TP[i * TR_LD + c] = f2bf(ti * scc); }
    } else {
        for (int f = wid - 2; f < 32; f += 6) {
            const int h = f >> 4, mt = (f >> 1) & 7, s = f & 1, d = 16 * mt + m16;
            const float glast = TAB[h * 64 + 63];
            const bf16x4 lo = *(const LAS bf16x4*)(KT + d * TR_LD + 32 * s + 4 * q4), hi = *(const LAS bf16x4*)(KT + d * TR_LD + 32 * s + 16 + 4 * q4);
            float o[8];
#pragma unroll
            for (int e = 0; e < 8; ++e) { const int j = 32 * s + 16 * (e >> 2) + 4 * q4 + (e & 3);
                o[e] = bf2f((bf16_t)(e < 4 ? lo[e & 3] : hi[e & 3])) * TAB[320 + j] * fast_exp(glast - TAB[h * 64 + j]); }
            u32x4 w; w.x = pk2(o[0], o[1]); w.y = pk2(o[2], o[3]); w.z = pk2(o[4], o[5]); w.w = pk2(o[6], o[7]);
            *(u32x4*)(recA0 + h * hstrideA + (32 + mt * 2 + s) * 1024 + lane * 16) = w;
        }
    }
    __syncthreads();
    if (P.xf & 2048) return;
    {
        asm volatile("" : "+v"(lane)); const int m16 = lane & 15, q4 = lane >> 4;
        const int h = wid >> 2, it = wid & 3;
        const LAS bf16_t* T = (const LAS bf16_t*)(lds + PL_T + h * 9216); const LAS bf16_t* TP = (const LAS bf16_t*)(lds + PL_TP + h * 9216);
        bf16x8 tp[2], tt[2];
#pragma unroll
        for (int s = 0; s < 2; ++s) { tp[s] = *(const LAS bf16x8*)(TP + (16 * it + m16) * TR_LD + 32 * s + 8 * q4); tt[s] = *(const LAS bf16x8*)(T + (16 * it + m16) * TR_LD + 32 * s + 8 * q4); }
        unsigned char* recA = recA0 + h * hstrideA;
#pragma unroll
        for (int sp = 0; sp < 4; ++sp) {
            f32x4 a0 = (f32x4){0.f, 0.f, 0.f, 0.f}, a1 = a0;
#pragma unroll
            for (int s = 0; s < 2; ++s) {
                const bf16x8 k0 = *(const LAS bf16x8*)(KT + (32 * sp + m16) * TR_LD + 32 * s + 8 * q4), k1 = *(const LAS bf16x8*)(KT + (32 * sp + 16 + m16) * TR_LD + 32 * s + 8 * q4);
                a0 = MFMA16(k0, tp[s], a0); a1 = MFMA16(k1, tp[s], a1);
            }
            u32x4 w; w.x = pk2(a0[0], a0[1]); w.y = pk2(a0[2], a0[3]); w.z = pk2(a1[0], a1[1]); w.w = pk2(a1[2], a1[3]);
            *(u32x4*)(recA + (it * 4 + sp) * 1024 + lane * 16) = w;
        }
        unsigned char* recU = P.prepu + (size_t)((b * 32 + 2 * kh + h) * NCH + n) * PREPU_REC;
#pragma unroll
        for (int et = 0; et < 8; ++et) {
            f32x4 a = (f32x4){0.f, 0.f, 0.f, 0.f};
#pragma unroll
            for (int s = 0; s < 2; ++s) { const bf16x8 bv = *(const LAS bf16x8*)(VTt + (h * 128 + 16 * et + m16) * TR_LD + 32 * s + 8 * q4); a = MFMA16(tt[s], bv, a); }
            u32x2 w; w.x = pk2(a[0], a[1]); w.y = pk2(a[2], a[3]);
            *(u32x2*)(recU + (et * 4 + it) * 512 + lane * 8) = w;
        }
        if (tid < 2) P.egl[(b * 32 + 2 * kh + tid) * NCH + n] = fast_exp(TAB[tid * 64 + 63]);
    }
    __syncthreads();
}

#define BAR_LDS() do { asm volatile("s_waitcnt lgkmcnt(0)" ::: "memory"); __builtin_amdgcn_s_barrier(); asm volatile("" ::: "memory"); } while (0)

__device__ __forceinline__ float row16_sum(float v) {
    v += __builtin_bit_cast(float, __builtin_amdgcn_update_dpp(0, __builtin_bit_cast(int, v), 0x128, 0xf, 0xf, false));
    v += __builtin_bit_cast(float, __builtin_amdgcn_update_dpp(0, __builtin_bit_cast(int, v), 0x124, 0xf, 0xf, false));
    v += __builtin_bit_cast(float, __builtin_amdgcn_update_dpp(0, __builtin_bit_cast(int, v), 0x122, 0xf, 0xf, false));
    v += __builtin_bit_cast(float, __builtin_amdgcn_update_dpp(0, __builtin_bit_cast(int, v), 0x121, 0xf, 0xf, false));
    return v;
}
#define SCHED_FENCE() __builtin_amdgcn_sched_barrier(0)
struct ScanArgs { const unsigned char* prepa; const unsigned char* prepu; const float* egl; const bf16_t* proj; const float* gnorm; bf16_t* og; float* delta_out; int xf; };

__device__ __forceinline__ void scan_unit(const ScanArgs& P, LAS unsigned char* lds, int b, int hv, int tid, int wid, int lane) {
    asm volatile("" : "+v"(tid), "+v"(lane));
    const int m16 = lane & 15, q4 = lane >> 4;
    const unsigned char* recA = P.prepa + (size_t)((b * 32 + hv) * NCH) * PREPA_REC;
    const unsigned char* recU = P.prepu + (size_t)((b * 32 + hv) * NCH) * PREPU_REC;
    const float* eglp = P.egl + (b * 32 + hv) * NCH;
    LAS float* part = (LAS float*)(lds + 114688);
    LAS bf16_t* ogb = (LAS bf16_t*)(lds + 116736);
    constexpr int OG_LD = 136;
    const float gn = P.gnorm[16 * wid + m16];
    const bf16_t* zrow = P.proj + (size_t)(b * SEQ) * INW + 8192 + hv * 128;
    bf16_t* ogrow = P.og + (size_t)(b * SEQ) * VALD + hv * 128;
    f32x4 S[8];
#pragma unroll
    for (int dt = 0; dt < 8; ++dt) S[dt] = (f32x4){0.f, 0.f, 0.f, 0.f};
#define SCAN_DMA(n_, stage_) do { _Pragma("unroll") for (int k_ = 0; k_ < 7; ++k_) \
        __builtin_amdgcn_global_load_lds((const unsigned*)(recA + (size_t)(n_) * PREPA_REC + (k_ * 8 + wid) * 1024 + lane * 16), \
                                         (LAS unsigned*)(lds + (stage_) * PREPA_REC + (k_ * 8 + wid) * 1024), 16, 0, 0); } while (0)
#define SCAN_OGFLUSH(n_) do { _Pragma("unroll") for (int k_ = 0; k_ < 2; ++k_) { const int p_ = tid + 512 * k_, r_ = p_ >> 4, c_ = (p_ & 15) * 8; \
        const u32x4 v_ = *(const LAS u32x4*)(ogb + r_ * OG_LD + c_); u32x4 w_; \
        _Pragma("unroll") for (int e_ = 0; e_ < 4; ++e_) { const unsigned a_ = v_[e_], z_ = zq[k_][e_]; \
            w_[e_] = pk2(__uint_as_float(a_ << 16) * __uint_as_float(z_ << 16), __uint_as_float(a_ & 0xffff0000u) * __uint_as_float(z_ & 0xffff0000u)); } \
        *(u32x4*)(ogrow + (size_t)((n_) * 64 + r_) * VALD + c_) = w_; } } while (0)
#define SCAN_ZLOAD(n_) do { _Pragma("unroll") for (int k_ = 0; k_ < 2; ++k_) { const int p_ = tid + 512 * k_, r_ = p_ >> 4, c_ = (p_ & 15) * 8; \
        zq[k_] = *(const u32x4*)(zrow + (size_t)((n_) * 64 + r_) * INW + c_); } } while (0)
    u32x4 zq[2];
    SCAN_DMA(0, 0);
    u32x2 un[4]; float egn;
#pragma unroll
    for (int mt = 0; mt < 4; ++mt) un[mt] = *(const u32x2*)(recU + (wid * 4 + mt) * 512 + lane * 8);
    egn = eglp[0];
#pragma unroll 1
    for (int n = 0; n < NCH; ++n) {
        __builtin_amdgcn_s_waitcnt(0x0F70); VM_WAIT(); BAR_LDS();
        const float egl = egn;
        f32x4 vn[4], o[4];
#pragma unroll
        for (int mt = 0; mt < 4; ++mt) vn[mt] = (f32x4){__uint_as_float(un[mt].x << 16), __uint_as_float(un[mt].x & 0xffff0000u), __uint_as_float(un[mt].y << 16), __uint_as_float(un[mt].y & 0xffff0000u)};
        SCHED_FENCE();
        if (n > 0 && !(P.xf & 16)) SCAN_OGFLUSH(n - 1);
        SCHED_FENCE();
        {
            const int nn = n + 1 < NCH ? n + 1 : NCH - 1;
            if (!(P.xf & 8)) SCAN_DMA(nn, (n + 1) & 1);
#pragma unroll
            for (int mt = 0; mt < 4; ++mt) un[mt] = *(const u32x2*)(recU + (size_t)nn * PREPU_REC + (wid * 4 + mt) * 512 + lane * 8);
            egn = eglp[nn];
            if (!(P.xf & 16)) SCAN_ZLOAD(n);
        }
        const LAS unsigned char* st = lds + (n & 1) * PREPA_REC + lane * 16;
        bf16x8 sb[4];
#pragma unroll
        for (int s = 0; s < 4; ++s) { u32x4 w; w.x = pk2(S[2 * s][0], S[2 * s][1]); w.y = pk2(S[2 * s][2], S[2 * s][3]); w.z = pk2(S[2 * s + 1][0], S[2 * s + 1][1]); w.w = pk2(S[2 * s + 1][2], S[2 * s + 1][3]);
            sb[s] = __builtin_bit_cast(bf16x8, w); }
#define LDF(i_) (*(const LAS bf16x8*)(st + (i_) * 1024))
        bf16x8 fa[8], fb[8];
#pragma unroll
        for (int s = 0; s < 4; ++s) { fa[s] = LDF(s); fa[4 + s] = LDF(16 + s); }
#pragma unroll
        for (int mt = 0; mt < 4; ++mt) {
            o[mt] = (f32x4){0.f, 0.f, 0.f, 0.f};
            if (mt < 3) {
#pragma unroll
                for (int s = 0; s < 4; ++s) { fb[s] = LDF((mt + 1) * 4 + s); fb[4 + s] = LDF(16 + (mt + 1) * 4 + s); }
            } else {
#pragma unroll
                for (int i = 0; i < 8; ++i) fb[i] = LDF(48 + i);
            }
            SCHED_FENCE();
#pragma unroll
            for (int s = 0; s < 4; ++s) { vn[mt] = MFMA16(fa[s], sb[s], vn[mt]); o[mt] = MFMA16(fa[4 + s], sb[s], o[mt]); }
            SCHED_FENCE();
#pragma unroll
            for (int i = 0; i < 8; ++i) fa[i] = fb[i];
        }
        bf16x8 vb[2];
#pragma unroll
        for (int sp = 0; sp < 2; ++sp) { u32x4 w; w.x = pk2(vn[2 * sp][0], vn[2 * sp][1]); w.y = pk2(vn[2 * sp][2], vn[2 * sp][3]); w.z = pk2(vn[2 * sp + 1][0], vn[2 * sp + 1][1]); w.w = pk2(vn[2 * sp + 1][2], vn[2 * sp + 1][3]);
            vb[sp] = __builtin_bit_cast(bf16x8, w); }
#pragma unroll
        for (int i = 0; i < 8; ++i) fb[i] = LDF(32 + i);
        SCHED_FENCE();
#pragma unroll
        for (int mt = 0; mt < 4; ++mt)
#pragma unroll
            for (int sp = 0; sp < 2; ++sp) o[mt] = MFMA16(fa[mt * 2 + sp], vb[sp], o[mt]);
        SCHED_FENCE();
#pragma unroll
        for (int i = 0; i < 8; ++i) fa[i] = LDF(40 + i);
#pragma unroll
        for (int mt = 0; mt < 4; ++mt)
#pragma unroll
            for (int jj = 0; jj < 4; ++jj) { const float s = row16_sum(o[mt][jj] * o[mt][jj]); if (m16 == 0) part[(16 * mt + 4 * q4 + jj) * 8 + wid] = s; }
        SCHED_FENCE();
#pragma unroll
        for (int dt = 0; dt < 4; ++dt) { S[dt] = S[dt] * egl;
#pragma unroll
            for (int sp = 0; sp < 2; ++sp) S[dt] = MFMA16(fb[dt * 2 + sp], vb[sp], S[dt]); }
#pragma unroll
        for (int dt = 4; dt < 8; ++dt) { S[dt] = S[dt] * egl;
#pragma unroll
            for (int sp = 0; sp < 2; ++sp) S[dt] = MFMA16(fa[(dt - 4) * 2 + sp], vb[sp], S[dt]); }
#undef LDF
        BAR_LDS();
        {
            LAS float* rtab = (LAS float*)(lds + 134144) + wid * 64;
            const f32x4 p0 = *(const LAS f32x4*)(part + lane * 8), p1 = *(const LAS f32x4*)(part + lane * 8 + 4);
            const float tot = ((p0[0] + p0[1]) + (p0[2] + p0[3])) + ((p1[0] + p1[1]) + (p1[2] + p1[3]));
            rtab[lane] = __builtin_amdgcn_rsqf(tot * (1.0f / 128.0f) + EPS);
            LDS_WAIT();
            f32x4 rv[4];
#pragma unroll
            for (int mt = 0; mt < 4; ++mt) rv[mt] = *(const LAS f32x4*)(rtab + 16 * mt + 4 * q4);
            SCHED_FENCE();
#pragma unroll
            for (int mt = 0; mt < 4; ++mt)
#pragma unroll
                for (int jj = 0; jj < 4; ++jj) ogb[(16 * mt + 4 * q4 + jj) * OG_LD + 16 * wid + m16] = f2bf(o[mt][jj] * rv[mt][jj] * gn);
        }
    }
    BAR_LDS();
    SCAN_OGFLUSH(NCH - 1);
#undef SCAN_DMA
#undef SCAN_OGFLUSH
#undef SCAN_ZLOAD
    float* so = P.delta_out + ((size_t)(b * 32 + hv) * 128) * 128 + 16 * wid + m16;
#pragma unroll
    for (int dt = 0; dt < 8; ++dt)
#pragma unroll
        for (int jj = 0; jj < 4; ++jj) so[(size_t)(16 * dt + 4 * q4 + jj) * 128] = S[dt][jj];
    VM_WAIT(); BAR_LDS();
}

struct SConvArgs { const float* projs; const float* sconv; const float* convw; const float* a_log; const float* dt_bias; float* qkvs; float* betas; float* gs; float* conv_s; };
__device__ __forceinline__ void sconv_item(const SConvArgs& P, int b, int cg, int lane) {
    float v[2];
#pragma unroll
    for (int hh = 0; hh < 2; ++hh) {
        const int c = cg * 128 + lane + 64 * hh;
        const float raw = P.projs[(size_t)b * INDIM + c];
        const float p0 = P.sconv[((size_t)b * 3 + 0) * CONVD + c], p1 = P.sconv[((size_t)b * 3 + 1) * CONVD + c], p2 = P.sconv[((size_t)b * 3 + 2) * CONVD + c];
        const float acc = p0 * P.convw[c] + p1 * P.convw[CONVD + c] + p2 * P.convw[2 * CONVD + c] + raw * P.convw[3 * CONVD + c];
        P.conv_s[((size_t)b * 3 + 0) * CONVD + c] = p1; P.conv_s[((size_t)b * 3 + 1) * CONVD + c] = p2; P.conv_s[((size_t)b * 3 + 2) * CONVD + c] = raw;
        v[hh] = silu_f(acc);
    }
    if (cg < 32) {
        const float s = wave_sum(v[0] * v[0] + v[1] * v[1]);
        float r = fast_rsq(s + EPS); if (cg < 16) r *= 0.08838834764831845f;
        v[0] *= r; v[1] *= r;
    }
    P.qkvs[(size_t)b * CONVD + cg * 128 + lane] = v[0]; P.qkvs[(size_t)b * CONVD + cg * 128 + lane + 64] = v[1];
    if (cg == 0 && lane < 32) {
        const float braw = P.projs[(size_t)b * INDIM + 12288 + lane], araw = P.projs[(size_t)b * INDIM + 12320 + lane];
        const float xx = araw + P.dt_bias[lane];
        P.betas[b * 32 + lane] = sigmoid_f(braw); P.gs[b * 32 + lane] = -fast_exp(P.a_log[lane]) * softplus_f(xx);
    }
}

struct SRecArgs { const float* qkvs; const float* betas; const float* gs; const float* projs; const float* gnorm; const float* S0; float* Sout; bf16_t* ogs; };
__device__ __forceinline__ void srec_unit(const SRecArgs& P, LAS unsigned char* lds, int b, int hv, int tid) {
    asm volatile("" : "+v"(tid));
    LAS float* qs = (LAS float*)lds; LAS float* ks = qs + 128; LAS float* red = qs + 256; LAS float* wsm = qs + 768;
    const int e = tid & 127, dq = tid >> 7, hk = hv >> 1;
    if (tid < 128) qs[tid] = P.qkvs[(size_t)b * CONVD + hk * 128 + tid]; else if (tid < 256) ks[tid - 128] = P.qkvs[(size_t)b * CONVD + 2048 + hk * 128 + (tid - 128)];
    const float ve = P.qkvs[(size_t)b * CONVD + 4096 + hv * 128 + e], beta = P.betas[b * 32 + hv], dec = fast_exp(P.gs[b * 32 + hv]);
    const size_t sbase = ((size_t)(b * 32 + hv) * 128 + 32 * dq) * 128 + e;
    float S[32];
#pragma unroll
    for (int d = 0; d < 32; ++d) S[d] = P.S0[sbase + (size_t)d * 128];
    __syncthreads();
    float kvp = 0.f;
#pragma unroll
    for (int d = 0; d < 32; ++d) { S[d] *= dec; kvp += S[d] * ks[32 * dq + d]; }
    red[dq * 128 + e] = kvp;
    __syncthreads();
    const float kv = (red[e] + red[128 + e]) + (red[256 + e] + red[384 + e]);
    const float dl = (ve - kv) * beta;
    float op = 0.f;
#pragma unroll
    for (int d = 0; d < 32; ++d) { S[d] += ks[32 * dq + d] * dl; op += S[d] * qs[32 * dq + d]; }
    __syncthreads();
    red[dq * 128 + e] = op;
#pragma unroll
    for (int d = 0; d < 32; ++d) P.Sout[sbase + (size_t)d * 128] = S[d];
    __syncthreads();
    const float o = (red[e] + red[128 + e]) + (red[256 + e] + red[384 + e]);
    if (tid < 128) { const float s = wave_sum(o * o); if ((tid & 63) == 0) wsm[tid >> 6] = s; }
    __syncthreads();
    if (tid < 128) {
        const float ri = fast_rsq((wsm[0] + wsm[1]) * (1.0f / 128.0f) + EPS);
        const float z = P.projs[(size_t)b * INDIM + 8192 + hv * 128 + e];
        P.ogs[(size_t)b * VALD + hv * 128 + e] = f2bf(o * ri * P.gnorm[e] * silu_f(z));
    }
    __syncthreads();
}

__device__ __forceinline__ int t5_bucket(int d) {
    if (d < 16) return d;
    const int v = 16 + (int)(fast_log2((float)d * 0.0625f) * (16.0f / 3.0f));
    return v < 31 ? v : 31;
}
struct AttnArgs { const bf16_t* Q; const bf16_t* KB; const bf16_t* VT; bf16_t* AO; const float* sinks; };
__device__ __forceinline__ void attn_unit(const AttnArgs& P, const LAS float* bias2, int b, int h, int qb, int lane, int wave_id) {
    asm volatile("" : "+v"(lane));
    const int n32 = lane & 31, hi = lane >> 5, kvh = h >> 3, q0 = 32 * qb;
    const int kt0 = q0 >= 128 ? 0 : (128 - q0) >> 5;
    const float sink2 = P.sinks[h] * LOG2E;
    bf16x8 qf[4], kf[5][4];
    const bf16_t* qp = P.Q + (size_t)(b * SEQ + q0 + n32) * D + h * 64 + 8 * hi;
#pragma unroll
    for (int s = 0; s < 4; ++s) qf[s] = *(const bf16x8*)(qp + 16 * s);
#pragma unroll
    for (int kt = 0; kt < 5; ++kt) {
        const int j0 = q0 - 128 + 32 * kt, jc = j0 >= 0 ? j0 : 0;
        const bf16_t* kp = P.KB + (size_t)(b * SEQ + jc + n32) * 256 + kvh * 64 + 8 * hi;
#pragma unroll
        for (int s = 0; s < 4; ++s) kf[kt][s] = *(const bf16x8*)(kp + 16 * s);
    }
    SCHED_FENCE();
    f32x16 st[5];
#pragma unroll
    for (int kt = 0; kt < 5; ++kt) {
#pragma unroll
        for (int r = 0; r < 16; ++r) st[kt][r] = 0.f;
#pragma unroll
        for (int s = 0; s < 4; ++s) st[kt] = MFMA32(kf[kt][s], qf[s], st[kt]);
    }
    SCHED_FENCE();
    u32x2 vlo[5][2][2], vhi[5][2][2];
#pragma unroll
    for (int kt = 0; kt < 5; ++kt) {
        const int j0 = q0 - 128 + 32 * kt, jc = j0 >= 0 ? j0 : 0;
#pragma unroll
        for (int s2 = 0; s2 < 2; ++s2)
#pragma unroll
            for (int dh = 0; dh < 2; ++dh) {
                const bf16_t* vp = P.VT + ((size_t)(b * 4 + kvh) * 64 + 32 * dh + n32) * SEQ + jc + 16 * s2 + 4 * hi;
                vlo[kt][s2][dh] = *(const u32x2*)vp; vhi[kt][s2][dh] = *(const u32x2*)(vp + 8);
            }
    }
    SCHED_FENCE();
    float mx = sink2;
#pragma unroll
    for (int kt = 0; kt < 5; ++kt)
#pragma unroll
        for (int r = 0; r < 16; ++r) {
            const int dist = 128 - 32 * kt + n32 - crow32(r, hi);
            const bool valid = (kt >= kt0) && dist >= 0 && dist < 128;
            const float sc = valid ? st[kt][r] + bias2[h * 128 + (dist & 127)] : -INFINITY;
            st[kt][r] = sc; mx = fmaxf(mx, sc);
        }
    mx = fmaxf(mx, __shfl_xor(mx, 32));
    float l = 0.f;
#pragma unroll
    for (int kt = 0; kt < 5; ++kt)
#pragma unroll
        for (int r = 0; r < 16; ++r) { const float p = fast_exp2(st[kt][r] - mx); st[kt][r] = p; l += p; }
    l += __shfl_xor(l, 32);
    l += fast_exp2(sink2 - mx);
    const float linv = fast_rcp(l);
    f32x16 o[2];
#pragma unroll
    for (int r = 0; r < 16; ++r) { o[0][r] = 0.f; o[1][r] = 0.f; }
#pragma unroll
    for (int kt = 0; kt < 5; ++kt)
#pragma unroll
        for (int s2 = 0; s2 < 2; ++s2) {
            u32x4 w; w.x = pk2(st[kt][8 * s2 + 0], st[kt][8 * s2 + 1]); w.y = pk2(st[kt][8 * s2 + 2], st[kt][8 * s2 + 3]);
            w.z = pk2(st[kt][8 * s2 + 4], st[kt][8 * s2 + 5]); w.w = pk2(st[kt][8 * s2 + 6], st[kt][8 * s2 + 7]);
            const bf16x8 pa = __builtin_bit_cast(bf16x8, w);
#pragma unroll
            for (int dh = 0; dh < 2; ++dh) {
                u32x4 vw; vw.x = vlo[kt][s2][dh].x; vw.y = vlo[kt][s2][dh].y; vw.z = vhi[kt][s2][dh].x; vw.w = vhi[kt][s2][dh].y;
                o[dh] = MFMA32(pa, __builtin_bit_cast(bf16x8, vw), o[dh]);
            }
        }
    LAS float* ltab = (LAS float*)((LAS unsigned char*)bias2 + 16384) + (__builtin_amdgcn_readfirstlane(wave_id) * 32);
    if (hi == 0) ltab[n32] = linv;
    LDS_WAIT();
    f32x4 lv[4];
#pragma unroll
    for (int g = 0; g < 4; ++g) lv[g] = *(const LAS f32x4*)(ltab + 8 * g + 4 * hi);
    bf16_t* op = P.AO + (size_t)(b * SEQ + q0) * D + h * 64 + n32;
#pragma unroll
    for (int r = 0; r < 16; ++r) {
        const int m = crow32(r, hi);
        const float li = lv[r >> 2][r & 3];
        op[(size_t)m * D] = f2bf(o[0][r] * li); op[(size_t)m * D + 32] = f2bf(o[1][r] * li);
    }
    LDS_WAIT();
}

struct SAttnArgs { const float* qs; const float* kvs; const float* ck; const float* cv; const float* sinks; bf16_t* aos; };
__device__ __forceinline__ void sattn_unit(const SAttnArgs& P, const LAS float* bias2, int b, int h, int lane) {
    const int kvh = h >> 3;
    const float qd = P.qs[(size_t)b * D + h * 64 + lane];
    const float sink2 = P.sinks[h] * LOG2E;
    float sc[2];
#pragma unroll
    for (int hh = 0; hh < 2; ++hh) {
        const int c = lane + 64 * hh + 1;
        const float* kp = (c < 128) ? P.ck + ((size_t)(b * 128 + c) * 4 + kvh) * 64 : P.kvs + (size_t)b * 512 + kvh * 64;
        float s = 0.f;
#pragma unroll
        for (int d4 = 0; d4 < 16; ++d4) { const f32x4 kv = *(const f32x4*)(kp + 4 * d4);
#pragma unroll
            for (int x = 0; x < 4; ++x) s += __uint_as_float(__builtin_amdgcn_readlane(__float_as_uint(qd), 4 * d4 + x)) * kv[x]; }
        sc[hh] = s + bias2[h * 128 + (128 - c)];
    }
    float mx = fmaxf(sc[0], sc[1]);
#pragma unroll
    for (int o = 1; o < 64; o <<= 1) mx = fmaxf(mx, __shfl_xor(mx, o));
    mx = fmaxf(mx, sink2);
    const float p0 = fast_exp2(sc[0] - mx), p1 = fast_exp2(sc[1] - mx);
    const float l = wave_sum(p0 + p1) + fast_exp2(sink2 - mx);
    float acc = 0.f;
#pragma unroll 8
    for (int cc = 0; cc < 64; ++cc) {
        const float pa = __uint_as_float(__builtin_amdgcn_readlane(__float_as_uint(p0), cc));
        const float pb = __uint_as_float(__builtin_amdgcn_readlane(__float_as_uint(p1), cc));
        const int ca = cc + 1, cb = cc + 65;
        const float* va = P.cv + ((size_t)(b * 128 + ca) * 4 + kvh) * 64;
        const float* vb = (cb < 128) ? P.cv + ((size_t)(b * 128 + cb) * 4 + kvh) * 64 : P.kvs + (size_t)b * 512 + 256 + kvh * 64;
        acc += pa * va[lane] + pb * vb[lane];
    }
    P.aos[(size_t)b * D + h * 64 + lane] = f2bf(acc / l);
}
#define XB_TMO      128
#define XB_XCNT(j)  (256  + 64 * (j))
#define XB_XSUB(j)  (1280 + 64 * (j))
#define XB_XGEN(j)  (2304 + 64 * (j))
#define XB_TOP      3328
#define XB_TOPGEN   3392
#define XCD_BAR_WORDS 3456
#define XB_SPIN_CAP (1u << 18)

__device__ __forceinline__ unsigned xb_ld(unsigned* p)              { return __hip_atomic_load(p, __ATOMIC_RELAXED, __HIP_MEMORY_SCOPE_AGENT); }
__device__ __forceinline__ unsigned xb_add(unsigned* p, unsigned v) { return __hip_atomic_fetch_add(p, v, __ATOMIC_RELAXED, __HIP_MEMORY_SCOPE_AGENT); }
__device__ __forceinline__ unsigned xb_xcc_id() { return (unsigned)__builtin_amdgcn_s_getreg((3 << 11) | 20) & 0xFu; }
#define XB_SPIN(cond, bar) do { unsigned _sp = 0; while (cond) { __builtin_amdgcn_s_sleep(1); \
    if ((++_sp & 255u) == 0u) { if (xb_ld(&(bar)[XB_TMO])) break; if (_sp > XB_SPIN_CAP) { atomicAdd(&(bar)[XB_TMO], 1u); break; } } } } while (0)

struct XcdBarrier {
    unsigned* bar; unsigned x;
    volatile LAS unsigned* st;
};

__device__ __forceinline__ XcdBarrier xcd_barrier_post(unsigned* bar, volatile LAS unsigned* st) {
    XcdBarrier b; b.bar = bar; b.x = xb_xcc_id(); b.st = st;
    if (threadIdx.x == 0) (void)xb_add(&bar[XB_XCNT(b.x)], 1u);
    return b;
}
__device__ __forceinline__ void xcd_barrier_complete(unsigned* bar, unsigned x, unsigned& nloc, unsigned& nx) {
    const unsigned G = gridDim.x * gridDim.y * gridDim.z;
    unsigned sum, cnt, mine, sp = 0u;
    for (;;) {
        sum = 0u; cnt = 0u; mine = 0u;
#pragma unroll
        for (unsigned j = 0; j < 16; ++j) { const unsigned c = xb_ld(&bar[XB_XCNT(j)]); sum += c; cnt += (c > 0u) ? 1u : 0u; mine = (j == x) ? c : mine; }
        if (sum == G) break;
        __builtin_amdgcn_s_sleep(1);
        if ((++sp & 255u) == 0u) { if (xb_ld(&bar[XB_TMO])) break; if (sp > XB_SPIN_CAP) { atomicAdd(&bar[XB_TMO], 1u); break; } }
    }
    nloc = mine > 0u ? mine : 1u; nx = cnt > 0u ? cnt : 1u;
}

__device__ __forceinline__ void xcd_barrier(const XcdBarrier& b, int tid_) {
    asm volatile("s_waitcnt vmcnt(0)" ::: "memory");
    __syncthreads();
    if (tid_ == 0) {
        unsigned* bar = b.bar; unsigned bx = b.x;
        asm volatile("" : "+s"(bar), "+s"(bx));
        __builtin_amdgcn_s_waitcnt(0);
        unsigned nloc = b.st[0], nx = b.st[1];
        if (nloc == 0u) { xcd_barrier_complete(bar, bx, nloc, nx); b.st[0] = nloc; b.st[1] = nx; }
        const unsigned old = xb_add(&bar[XB_XSUB(bx)], 1u);
        const unsigned gen = old / nloc;
        if (old + 1u == (gen + 1u) * nloc) {
            __builtin_amdgcn_fence(__ATOMIC_RELEASE, "agent");
            asm volatile("s_waitcnt vmcnt(0)" ::: "memory");
            const unsigned og = xb_add(&bar[XB_TOP], 1u);
            const unsigned tg = og / nx;
            if (og + 1u == (tg + 1u) * nx) xb_add(&bar[XB_TOPGEN], 1u);
            else XB_SPIN(xb_ld(&bar[XB_TOPGEN]) == tg, bar);
            __builtin_amdgcn_fence(__ATOMIC_ACQUIRE, "agent");
            xb_add(&bar[XB_XGEN(bx)], 1u);
            asm volatile("s_waitcnt vmcnt(0)" ::: "memory");
        } else {
            XB_SPIN(xb_ld(&bar[XB_XGEN(bx)]) == gen, bar);
            __builtin_amdgcn_fence(__ATOMIC_ACQUIRE, "agent");
            asm volatile("s_waitcnt vmcnt(0)" ::: "memory");
        }
    }
    __syncthreads();
}

constexpr int CW_BARBASE = 131072, BAR_REGION_WORDS = 4096;
constexpr int PH_FINAL = 25, N_PHASES = 26;
#ifndef MK_EN
#define MK_EN 0xffff
#endif
#define EN(k) (((MK_EN) >> (k)) & 1)
struct Args { const float* in[23]; float* out; unsigned char* ws; int ph_lo, ph_hi, li, pad; };

constexpr size_t O_Y = 0, O_YS = 16777216, O_DP = 16842752, O_CP = 21037056, O_KP = 21233664, O_VP = 21364736, O_DS = 21495808, O_CS = 55050240, O_KS = 56623104, O_VS = 57671680;

__global__ void __launch_bounds__(NTHR, 2) mk_fwd(Args args) {
    extern __shared__ __attribute__((aligned(16))) unsigned char lds_raw[];
    LAS unsigned char* lds = (LAS unsigned char*)lds_raw;
    volatile LAS unsigned* MISC = (volatile LAS unsigned*)(lds + MISC_OFF);
    const int G = gridDim.x, bid = blockIdx.x;
    const int wid0 = __builtin_amdgcn_readfirstlane((int)threadIdx.x >> 6);
    if (threadIdx.x < 64) MISC[threadIdx.x] = 0u;
    __syncthreads();
    XcdBarrier bar = xcd_barrier_post((unsigned*)(args.ws + WS_CTL) + CW_BARBASE + args.li * BAR_REGION_WORDS, MISC + 8);
    const int lo = args.ph_lo, hi = args.ph_hi;
#define IN(k) (lo <= (k) && (k) < hi)
#define SEAM(knext) do { if (IN(knext)) { xcd_barrier(bar, tid); if (args.pad & 4096) xcd_barrier(bar, tid); } } while (0)
#define KARG(k) (kp[(k)])
#define PH_LOCALS \
    int tid; asm volatile("v_mbcnt_lo_u32_b32 %0, -1, 0\n\tv_mbcnt_hi_u32_b32 %0, -1, %0" : "=v"(tid)); tid += wid0 * 64;     \
    const int lane = tid & 63, wid = __builtin_amdgcn_readfirstlane(tid >> 6); \
    KP_T kp = (KP_T)__builtin_amdgcn_kernarg_segment_ptr(); asm volatile("" : "+s"(kp)); \
    unsigned char* ws = (unsigned char*)KARG(24); \
    float* out = (float*)KARG(23); \
    const int gw = bid * NWAVES + wid, NGW = G * NWAVES; \
    float* ssq = (float*)(ws + WS_SSQP); float* ssqs = (float*)(ws + WS_SSQSP); \
    LAS float* red = (LAS float*)lds; \
    (void)gw; (void)NGW; (void)lane; (void)out; (void)ssq; (void)ssqs; (void)red;
#define CV_SPLIT(lam) ((lam) == 1 ? 7900 : ((lam) == 2 ? 5100 : 5200))
#define RINVS ((LAS float*)(lds + 131072))
#define BUILD_RINVS(site_ptr) do { if (tid < 32) { const float* p_ = (site_ptr) + tid * 64; float s_ = 0.f; for (int i_ = 0; i_ < 64; ++i_) s_ += p_[i_]; RINVS[tid] = rinv_of(s_); } __syncthreads(); } while (0)
#define ssq_in (ssq + (size_t)(2 * L) * MP * 32)
#define ssqs_in (ssqs + (2 * L) * SB * 64)
#define ssq_mid (ssq + (size_t)(2 * L + 1) * MP * 32)
#define ssqs_mid (ssqs + (2 * L + 1) * SB * 64)
#define ssq_out (ssq + (size_t)(2 * L + 2) * MP * 32)
#define ssqs_out (ssqs + (2 * L + 2) * SB * 64)
#define x_prompt (KARG(0))
#define x_sample (KARG(1))
#define state_delta (KARG(2))
#define state_conv (KARG(3))
#define cache_k (KARG(4))
#define cache_v (KARG(5))
#define norm_mix (KARG(6))
#define norm_ffn (KARG(7))
#define w_in (KARG(8))
#define conv_w (KARG(9))
#define a_log (KARG(10))
#define dt_bias (KARG(11))
#define gnorm (KARG(12))
#define w_out (KARG(13))
#define norm_kv (KARG(14))
#define w_kv (KARG(15))
#define w_q (KARG(16))
#define w_o (KARG(17))
#define sinks (KARG(18))
#define rel_bias (KARG(19))
#define w_gu (KARG(20))
#define w_dn (KARG(21))
#define norm_final (KARG(22))
#define WIN_T ((bf16_t*)(ws + WS_WIN))
#define WBA_T ((bf16_t*)(ws + WS_WBA))
#define WOUT_T ((bf16_t*)(ws + WS_WOUT))
#define WGU_T ((bf16_t*)(ws + WS_WGU))
#define WDN_T ((bf16_t*)(ws + WS_WDN))
#define WQKV_T ((bf16_t*)(ws + WS_WQKV))
#define WQ1_T ((bf16_t*)(ws + WS_WQ1))
#define WO_T ((bf16_t*)(ws + WS_WO))
#define X ((float*)(ws + WS_X))
#define XB ((bf16_t*)(ws + WS_XB))
#define PROJ ((bf16_t*)(ws + WS_PROJ))
#define BETA ((float*)(ws + WS_BETA))
#define GG ((float*)(ws + WS_G))
#define OG ((bf16_t*)(ws + WS_OG))
#define MID ((bf16_t*)(ws + WS_MID))
#define QB ((bf16_t*)(ws + WS_Q))
#define KB ((bf16_t*)(ws + WS_K))
#define VT ((bf16_t*)(ws + WS_VT))
#define AO ((bf16_t*)(ws + WS_AO))
#define XS ((float*)(ws + WS_SMP + SM_XS))
#define XSB ((bf16_t*)(ws + WS_SMP + SM_XSB))
#define PROJS ((float*)(ws + WS_SMP + SM_PROJS))
#define QKVS ((float*)(ws + WS_SMP + SM_QKVS))
#define BETAS ((float*)(ws + WS_SMP + SM_BETAS))
#define GS ((float*)(ws + WS_SMP + SM_GS))
#define OGS ((bf16_t*)(ws + WS_SMP + SM_OGS))
#define MIDS ((bf16_t*)(ws + WS_SMP + SM_MIDS))
#define QS ((float*)(ws + WS_SMP + SM_QS))
#define KVS ((float*)(ws + WS_SMP + SM_KVS))
#define AOS ((bf16_t*)(ws + WS_SMP + SM_AOS))

    if (EN(0) && IN(0)) {
        PH_LOCALS
        LAS float* scr = (LAS float*)(lds + wid * 16640);
        convert_range(kp, ws, 0, 0, CV_IN + CV_BA, gw, NGW, scr, lane);
        for (int m = gw; m < MP + SB; m += NGW) {
            if (m < MP) row_to_bf16(x_prompt + (size_t)m * D, XB + (size_t)m * D, ssq + (size_t)m * 32, 32, lane);
            else row_to_bf16(x_sample + (size_t)(m - MP) * D, XSB + (size_t)(m - MP) * D, ssqs + (size_t)(m - MP) * 64, 64, lane);
        }
        for (int i = bid * NTHR + tid; i < 2 * SB * 127 * 64; i += G * NTHR) {
            const int which = i / (SB * 127 * 64), r = i % (SB * 127 * 64), b = r / (127 * 64), o = r % (127 * 64);
            const f32x4 v = *(const f32x4*)((which ? cache_v : cache_k) + (size_t)b * 128 * 256 + 256 + 4 * o);
            *(f32x4*)(out + (which ? O_VS : O_KS) + (size_t)b * 128 * 256 + 4 * o) = v;
        }
        SEAM(1);
    }

#pragma unroll 1
    for (int L = 0; L < 4; ++L) {
        const int pb = 1 + 6 * L; const bool isA = L < 2; const int j = L - 2;
        int lo = args.ph_lo, hi = args.ph_hi; asm volatile("" : "+s"(lo), "+s"(hi));
        if (IN(pb)) {
            PH_LOCALS
            if (EN(1) && isA) {
                const bf16_t* Wt = WIN_T + (size_t)L * INW * D; const bf16_t* Wba = WBA_T + (size_t)L * 64 * D;
                { pg8::Gemm g{XB, Wt, MP, INW, D}; pg8::StaticOrder S; S.init(MP, INW, G, bid);
                  pg8::EpiProj E{PROJ, INW, ssq_in, 32};
                  pg8::gemm_phase<pg8::EpiProj, pg8::StaticOrder, true, true>(lds, g, S, E, tid); }
                const float* al = a_log + L * 32; const float* dtb = dt_bias + L * 32;
                BUILD_RINVS(ssqs_in);
                for (int su = bid; su < 384 + 1 + 256; su += G) {
                    if (su < 384) {
                        skinny_unit<false>(XSB, D, Wt + (size_t)su * 32 * D, nullptr, D, D, red, wid, lane, tid,
                            [&](int m, int n, float v0, float) { PROJS[(size_t)m * INDIM + su * 32 + n] = v0 * RINVS[m]; });
                    } else if (su == 384) {
                        skinny_unit<true>(XSB, D, Wba, Wba + 32 * D, D, D, red, wid, lane, tid,
                            [&](int m, int n, float v0, float v1) { const float ri = RINVS[m]; PROJS[(size_t)m * INDIM + INW + n] = v0 * ri; PROJS[(size_t)m * INDIM + INW + 32 + n] = v1 * ri; });
                    } else {
                        const int u = su - 385;
                        skinny_unit<true>(XB + (size_t)u * 32 * D, D, Wba, Wba + 32 * D, D, D, red, wid, lane, tid,
                            [&](int m, int n, float v0, float v1) { const int row = 32 * u + m; const float ri = rinv_row_full(ssq_in, row);
                                const float braw = v0 * ri, xx = v1 * ri + dtb[n];
                                BETA[(size_t)row * 32 + n] = sigmoid_f(braw); GG[(size_t)row * 32 + n] = -fast_exp(al[n]) * softplus_f(xx); });
                    }
                }
            } else if (EN(2) && !isA) {
                const bf16_t* Wt = j == 0 ? WQKV_T : WQ1_T; const int N = j == 0 ? 2560 : 2048;
                { pg8::Gemm g{XB, Wt, MP, N, D}; pg8::StaticOrder S; S.init(MP, N, G, bid);
                  pg8::EpiQKVT<false> E{QB, KB, VT, out + O_KP, out + O_VP, ssq_in};
                  pg8::gemm_phase<pg8::EpiQKVT<false>, pg8::StaticOrder, true, true>(lds, g, S, E, tid); }
                BUILD_RINVS(ssqs_in);
                for (int su = bid; su < N / 32; su += G) {
                    skinny_unit<false>(XSB, D, Wt + (size_t)su * 32 * D, nullptr, D, D, red, wid, lane, tid,
                        [&](int m, int n, float v0, float) { const float v = v0 * RINVS[m]; const int c = su * 32 + n;
                            if (c < 2048) QS[(size_t)m * D + c] = v;
                            else { KVS[(size_t)m * 512 + (c - 2048)] = v;
                                   if (c < 2304) out[O_KS + ((size_t)m * 128 + 127) * 256 + (c - 2048)] = v; else out[O_VS + ((size_t)m * 128 + 127) * 256 + (c - 2304)] = v; } });
                }
                if (j == 0) {
                    const int nwg_ = (MP / 256) * (N / 256), rounds = (nwg_ + G - 1) / G, nidle = rounds * G - nwg_;
                    if (nidle > 0 && bid >= G - nidle) {
                        __syncthreads();
                        convert_range(kp, ws, 2, CV_KV + CV_Q, CV_B0 - (CV_KV + CV_Q), (bid - (G - nidle)) * NWAVES + wid, nidle * NWAVES, (LAS float*)(lds + wid * 16640), lane);
                    }
                }
            }
            SEAM(isA ? pb + 1 : pb + 2);
        }
        if (EN(3) && isA && IN(pb + 1)) {
            PH_LOCALS
            PrepArgs P{PROJ, BETA, GG, conv_w + (size_t)L * 4 * CONVD, ws + WS_PREPA, ws + WS_PREPU, (float*)(ws + WS_EGL), out + O_CP + (size_t)L * BATCH * 3 * CONVD, args.pad};
            for (int u = bid; u < BATCH * 16 * NCH; u += G) { const int n = u & 31, kh = (u >> 5) & 15, b = u >> 9; prep_unit(P, lds, b, kh, n, tid, wid, lane); }
            SConvArgs SP{PROJS, state_conv + (size_t)L * SB * 3 * CONVD, conv_w + (size_t)L * 4 * CONVD, a_log + L * 32, dt_bias + L * 32, QKVS, BETAS, GS, out + O_CS + (size_t)L * SB * 3 * CONVD};
            for (int it = gw; it < SB * 64; it += NGW) sconv_item(SP, it >> 6, it & 63, lane);
            SEAM(pb + 2);
        }
        if (IN(pb + 2)) {
            PH_LOCALS
            if (EN(4) && isA) {
                ScanArgs P{ws + WS_PREPA, ws + WS_PREPU, (const float*)(ws + WS_EGL), PROJ, gnorm + L * 128, (args.pad & 4) ? MID : OG, (args.pad & 4) ? (float*)QB : out + O_DP + (size_t)L * BATCH * 32 * 128 * 128, args.pad};
                if (!(args.pad & 1)) for (int u = bid; u < BATCH * 32; u += G) scan_unit(P, lds, u >> 5, u & 31, tid, wid, lane);
                SRecArgs R{QKVS, BETAS, GS, PROJS, gnorm + L * 128, state_delta + (size_t)L * SB * 32 * 128 * 128, out + O_DS + (size_t)L * SB * 32 * 128 * 128, OGS};
                const int base = G > 128 ? 128 : 0, nb = G > 128 ? G - 128 : G;
                if (!(args.pad & 2) && bid >= base) for (int su = bid - base; su < SB * 32; su += nb) srec_unit(R, lds, su >> 5, su & 31, tid);
                if (G > 128 && bid >= 128) {
                    __syncthreads();
                    convert_range(kp, ws, L, CV_IN + CV_BA, CV_A - (CV_IN + CV_BA), (bid - 128) * NWAVES + wid, (G - 128) * NWAVES, (LAS float*)(lds + wid * 16640), lane);
                }
            } else if (EN(5) && !isA) {
                LAS float* bias2 = (LAS float*)lds;
                for (int i = tid; i < 32 * 128; i += NTHR) { const int h = i >> 7, dist = i & 127; bias2[i] = rel_bias[t5_bucket(dist) * 32 + h] * LOG2E; }
                __syncthreads();
                AttnArgs P{QB, KB, VT, AO, sinks + j * 32};
                if (!(args.pad & 64)) for (int u = gw; u < BATCH * 32 * 64; u += NGW) { const int g8 = u & 7, qb = (u >> 3) & 63, kvh = (u >> 9) & 3, b = u >> 11; attn_unit(P, bias2, b, kvh * 8 + g8, qb, lane, wid); }
                SAttnArgs SP{QS, KVS, cache_k, cache_v, sinks + j * 32, AOS};
                if (!(args.pad & 32)) for (int u = gw; u < SB * 32; u += NGW) sattn_unit(SP, bias2, u >> 5, u & 31, lane);
                __syncthreads();
            }
            SEAM(pb + 3);
        }
        if (EN(6) && IN(pb + 3)) {
            PH_LOCALS
            const bf16_t* A = isA ? OG : AO; const int K = isA ? VALD : D;
            const bf16_t* Wt = isA ? WOUT_T + (size_t)L * D * VALD : WO_T + (size_t)j * D * D;
            const float* base = L == 0 ? x_prompt : X; const float* bases = L == 0 ? x_sample : XS;
            { pg8::Gemm g{A, Wt, MP, D, K}; pg8::StaticOrder S; S.init(MP, D, G, bid);
              pg8::EpiRes E{base, X, XB, ssq_mid};
              pg8::gemm_phase<pg8::EpiRes, pg8::StaticOrder, true, true>(lds, g, S, E, tid); }
            const bf16_t* As = isA ? OGS : AOS;
            for (int su = bid; su < 64; su += G) {
                skinny_unit<false>(As, K, Wt + (size_t)su * 32 * K, nullptr, K, K, red, wid, lane, tid,
                    [&](int m, int n, float v0, float) { const size_t o = (size_t)m * D + su * 32 + n; const float v = bases[o] + v0; XS[o] = v; XSB[o] = f2bf(v);
                        float s = v * v; s += __shfl_xor(s, 1); s += __shfl_xor(s, 2); s += __shfl_xor(s, 4); s += __shfl_xor(s, 8); s += __shfl_xor(s, 16);
                        if (n == 0) ssqs_mid[m * 64 + su] = s; });
            }
            SEAM(pb + 4);
        }
        if (EN(7) && IN(pb + 4)) {
            PH_LOCALS
            const bf16_t* Wt = WGU_T + (size_t)L * GU * D;
            { pg8::Gemm g{XB, Wt, MP, GU, D}; pg8::StaticOrder S; S.init(MP, GU, G, bid);
              pg8::EpiSwigluT<false> E{MID, ssq_mid};
              pg8::gemm_phase<pg8::EpiSwigluT<false>, pg8::StaticOrder, true, true>(lds, g, S, E, tid); }
            BUILD_RINVS(ssqs_mid);
            for (int su = bid; su < FF / 32; su += G) {
                const int t = su >> 2, s4 = su & 3;
                skinny_unit<true>(XSB, D, Wt + (size_t)(256 * t + 32 * s4) * D, Wt + (size_t)(256 * t + 128 + 32 * s4) * D, D, D, red, wid, lane, tid,
                    [&](int m, int n, float v0, float v1) { const float ri = RINVS[m]; const float gt = v0 * ri, up = v1 * ri;
                        MIDS[(size_t)m * FF + su * 32 + n] = f2bf(silu_f(gt) * up); });
            }
            if (L < 3) {
                const int nwg_ = (MP / 256) * (GU / 256), rounds = (nwg_ + G - 1) / G, nidle = rounds * G - nwg_;
                if (nidle > 0 && bid >= G - nidle) {
                    __syncthreads();
                    const int cnt = L == 0 ? CV_IN + CV_BA : (L == 1 ? CV_KV + CV_Q : CV_B1);
                    convert_range(kp, ws, L + 1, 0, cnt, (bid - (G - nidle)) * NWAVES + wid, nidle * NWAVES, (LAS float*)(lds + wid * 16640), lane);
                }
            }
            SEAM(pb + 5);
        }
        if (EN(8) && IN(pb + 5)) {
            PH_LOCALS
            const bf16_t* Wt = WDN_T + (size_t)L * D * FF;
            { pg8::Gemm g{MID, Wt, MP, D, FF}; pg8::StaticOrder S; S.init(MP, D, G, bid);
              const bool dm = (args.pad & 128) != 0;
              pg8::EpiRes E{X, dm ? (float*)PROJ : X, dm ? (bf16_t*)((char*)PROJ + 64 * MiB) : XB, dm ? (float*)((char*)PROJ + 100 * MiB) : ssq_out};
              pg8::gemm_phase<pg8::EpiRes, pg8::StaticOrder, true, true>(lds, g, S, E, tid); }
            for (int su = bid; su < 64; su += G) {
                skinny_unit<false>(MIDS, FF, Wt + (size_t)su * 32 * FF, nullptr, FF, FF, red, wid, lane, tid,
                    [&](int m, int n, float v0, float) { const size_t o = (size_t)m * D + su * 32 + n; const float v = XS[o] + v0; XS[o] = v; XSB[o] = f2bf(v);
                        float s = v * v; s += __shfl_xor(s, 1); s += __shfl_xor(s, 2); s += __shfl_xor(s, 4); s += __shfl_xor(s, 8); s += __shfl_xor(s, 16);
                        if (n == 0) ssqs_out[m * 64 + su] = s; });
            }
            SEAM(L == 3 ? PH_FINAL : pb + 6);
        }
    }
    if (EN(9) && IN(PH_FINAL)) {
        PH_LOCALS
        const float* sq = ssq + (size_t)8 * MP * 32; const float* sqs = ssqs + 8 * SB * 64;
        for (int m = gw; m < MP + SB; m += NGW) {
            const bool sp = m >= MP; const int r = sp ? m - MP : m;
            const float ri = rinv_of(wave_sum(sp ? sqs[r * 64 + lane] : (lane < 32 ? sq[(size_t)r * 32 + lane] : 0.f)));
            const f32x4* xr = (const f32x4*)((sp ? XS : X) + (size_t)r * D) + lane; f32x4* yr = (f32x4*)(out + (sp ? O_YS : O_Y) + (size_t)r * D) + lane; const f32x4* gr = (const f32x4*)norm_final + lane;
#pragma unroll
            for (int q = 0; q < 8; ++q) yr[64 * q] = xr[64 * q] * ri * gr[64 * q];
        }
    }
#undef IN
#undef SEAM
}
#undef RINVS
#undef CV_SPLIT
#undef BUILD_RINVS
#undef x_prompt
#undef x_sample
#undef state_delta
#undef state_conv
#undef cache_k
#undef cache_v
#undef norm_mix
#undef norm_ffn
#undef w_in
#undef conv_w
#undef a_log
#undef dt_bias
#undef gnorm
#undef w_out
#undef norm_kv
#undef w_kv
#undef w_q
#undef w_o
#undef sinks
#undef rel_bias
#undef w_gu
#undef w_dn
#undef norm_final
#undef WIN_T
#undef WBA_T
#undef WOUT_T
#undef WGU_T
#undef WDN_T
#undef WQKV_T
#undef WQ1_T
#undef WO_T
#undef X
#undef XB
#undef PROJ
#undef BETA
#undef GG
#undef OG
#undef MID
#undef QB
#undef KB
#undef VT
#undef AO
#undef XS
#undef XSB
#undef PROJS
#undef QKVS
#undef BETAS
#undef GS
#undef OGS
#undef MIDS
#undef QS
#undef KVS
#undef AOS
#undef ssq_in
#undef ssqs_in
#undef ssq_mid
#undef ssqs_mid
#undef ssq_out
#undef ssqs_out
#undef PH_LOCALS
#undef KARG

#ifndef MK_PER_PHASE
#define MK_PER_PHASE 0
#endif
static int mk_grid = 0;
static bool mk_setup(int n_in, size_t ws_size) {
    if (mk_grid == 0) {
        if (n_in != 23 || ws_size < WS_END) { fprintf(stderr, "kernel_launch: unexpected inputs (%d) or workspace (%zu < %zu)\n", n_in, ws_size, (size_t)WS_END); mk_grid = -1; return false; }
        int dev = 0, cus = 0, per_cu = 0;
        if (hipGetDevice(&dev) != hipSuccess || hipDeviceGetAttribute(&cus, hipDeviceAttributeMultiprocessorCount, dev) != hipSuccess) { mk_grid = -1; return false; }
        if (hipFuncSetAttribute((const void*)mk_fwd, hipFuncAttributeMaxDynamicSharedMemorySize, LDS_BYTES) != hipSuccess) { fprintf(stderr, "kernel_launch: hipFuncSetAttribute failed\n"); mk_grid = -1; return false; }
        if (hipOccupancyMaxActiveBlocksPerMultiprocessor(&per_cu, (const void*)mk_fwd, NTHR, LDS_BYTES) != hipSuccess || per_cu < 1) { fprintf(stderr, "kernel_launch: occupancy query says %d\n", per_cu); }
        (void)hipGetLastError();
        mk_grid = cus;
    }
    return mk_grid > 0;
}
static void mk_run(void* const* d_in, void* d_out, void* d_ws, hipStream_t stream, int p_lo, int p_hi, bool per_phase, int flags = 0) {
    (void)hipMemsetAsync((char*)d_ws + WS_CTL, 0, CTL_ZERO_BYTES, stream);
    Args a{};
    for (int i = 0; i < 23; ++i) a.in[i] = (const float*)d_in[i];
    a.out = (float*)d_out; a.ws = (unsigned char*)d_ws; a.pad = flags;
    if (per_phase) {
        int li = 0;
        for (int p = p_lo; p < p_hi; ++p) {
            if (p >= 14 && p <= 24 && ((p - 1) % 6) == 1) continue;
            a.ph_lo = p; a.ph_hi = p + 1; a.li = li++;
            hipLaunchKernelGGL(mk_fwd, dim3(mk_grid), dim3(NTHR), LDS_BYTES, stream, a);
        }
    } else {
        a.ph_lo = p_lo; a.ph_hi = p_hi; a.li = 0;
        hipLaunchKernelGGL(mk_fwd, dim3(mk_grid), dim3(NTHR), LDS_BYTES, stream, a);
    }
}
#ifndef MK_NO_ENTRY
extern "C" void kernel_launch(void* const* d_in, const int* in_sizes, int n_in, void* d_out, int out_size, void* d_ws, size_t ws_size, hipStream_t stream) {
    if (!mk_setup(n_in, ws_size)) return;
    mk_run(d_in, d_out, d_ws, stream, 0, N_PHASES, MK_PER_PHASE != 0);
}
#endif
```

```cpp
#include <hip/hip_runtime.h>
#include <cstdio>
#include <cstdint>
#include <cmath>
namespace pg8 {
#define PG8_LAS __attribute__((address_space(3)))
typedef unsigned short bf16_t;
typedef short bf16x8 __attribute__((ext_vector_type(8)));
typedef float f32x4 __attribute__((ext_vector_type(4)));
typedef unsigned u32x4 __attribute__((ext_vector_type(4)));
constexpr int BM = 256, BK = 64, HALF = 128, HTB = HALF * BK * 2  , STAGE_BYTES = 8 * HTB, NXCD = 8, WGM = 8;

__host__ __device__ __forceinline__ int lds_byte(int r, int c) { const int st = (r >> 4) * 2 + (c >> 5), rr = r & 15, cc = c & 31, ob = rr * 64 + cc * 2; return st * 1024 + (ob ^ (((ob >> 9) & 1) << 5)); }
__host__ __device__ __forceinline__ void stage_rc(int b, int& R, int& C) { const int st = b / 1024, sb = b % 1024, swz = sb ^ (((sb >> 9) & 1) << 5); R = (st >> 1) * 16 + swz / 64; C = (st & 1) * 32 + (swz % 64) / 2; }
__host__ __device__ __forceinline__ int perm32(int rho) { const int n = rho >> 4, i = rho & 15; return 8 * (i >> 2) + 4 * n + (i & 3); }

struct Unit { int pm, pn; };
struct Gemm { const bf16_t* A; const bf16_t* Bt; int M, N, K; };

struct StaticOrder {
    int nM, nN, nwg, G, c, lim;
    __host__ __device__ void init(int M, int N, int G_, int c_) { nM = M / BM; nN = N / BM; nwg = nM * nN; G = G_; c = c_; lim = nwg; }
    __host__ __device__ void map(int L, Unit& u) const {
        int wgid = L; { const int q = nwg / NXCD, r = nwg % NXCD, xcd = wgid % NXCD, off = wgid / NXCD; wgid = (xcd < r ? xcd * (q + 1) : r * (q + 1) + (xcd - r) * q) + off; }
        const int nig = WGM * nN, gid = wgid / nig, fm = gid * WGM, gsz = (nM - fm) < WGM ? (nM - fm) : WGM;
        u.pm = fm + ((wgid % nig) % gsz); u.pn = (wgid % nig) / gsz;
    }
    __host__ __device__ bool next(int i, Unit& u) const {
        const long L = (long)i * G + c; if (L >= lim) return false;
        map((int)L, u); return true;
    }
    __device__ __forceinline__ void a_ready(const Unit&) const {}
    __device__ __forceinline__ void done(const Unit&) const {}
};
struct TailOrder {
    StaticOrder base; int first;
    __host__ __device__ bool next(int i, Unit& u) const {
        const long t = (long)i * base.G + base.c; if (t >= 2L * (base.nwg - first)) return false;
        Unit f; base.map(first + (int)(t >> 1), f); u.pm = 2 * f.pm + (int)(t & 1); u.pn = f.pn; return true;
    }
    __device__ __forceinline__ void a_ready(const Unit&) const {}
    __device__ __forceinline__ void done(const Unit&) const {}
};

__device__ __forceinline__ unsigned cvt_pk_bf16(float lo, float hi) { unsigned r; asm volatile("v_cvt_pk_bf16_f32 %0, %1, %2" : "=v"(r) : "v"(lo), "v"(hi)); return r; }
typedef float f32x2 __attribute__((ext_vector_type(2)));
template <class Epi, class Sched, bool ALIGN_EPI = false, bool SP2 = false, bool HALFM = false>
__device__ __forceinline__ void gemm_phase(PG8_LAS unsigned char* lds, const Gemm g, const Sched& S, const Epi& E, int tid_in) {
    int tid = tid_in; asm volatile("" : "+v"(tid));
    const int wid = __builtin_amdgcn_readfirstlane(tid >> 6), lane = tid & 63, wr = wid >> 2, wc = wid & 3, fr = lane & 15, fq = lane >> 4;
    const int K = g.K, nt = K / BK;
    unsigned voffA[2], voffB[2];
#pragma unroll
    for (int i = 0; i < 2; ++i) { int R, C; stage_rc(tid * 16 + i * 8192, R, C); const int Rb = Epi::PERM ? ((R & ~31) + perm32(R & 31)) : R;
        voffA[i] = (unsigned)(R * K + C) * 2u; voffB[i] = (unsigned)(Rb * K + C) * 2u; }
    const size_t kstep = (size_t)(BK * 2);
    const size_t hstep = (size_t)HALF * K * 2;
    const size_t tstep = 2 * hstep;
    const size_t tstepA = HALFM ? hstep : tstep;
    const unsigned ldsw = (unsigned)wid * 1024u;
    const int aoff = lds_byte(wr * 64 + fr, fq * 8), boff = lds_byte(wc * 32 + fr, fq * 8);
#define PG8_SA(b, h) (((b) * 2 + (h)) * HTB)
#define PG8_SB(b, h) ((4 + (b) * 2 + (h)) * HTB)
#define PG8_STAGE(bufoff, gbase, voff) do { _Pragma("unroll") for (int _i = 0; _i < 2; ++_i) \
        __builtin_amdgcn_global_load_lds((const unsigned*)((const char*)(gbase) + (voff)[_i]), (PG8_LAS unsigned*)(lds + (bufoff) + ldsw + _i * 8192), 16, 0, 0); } while (0)
#define PG8_LDA(dst, b, h) do { _Pragma("unroll") for (int m = 0; m < 4; ++m) _Pragma("unroll") for (int k = 0; k < 2; ++k) dst[m][k] = *(const PG8_LAS bf16x8*)(lds + PG8_SA(b, h) + aoff + m * 2048 + k * 1024); } while (0)
#define PG8_LDB(dst, b, h) do { _Pragma("unroll") for (int n = 0; n < 2; ++n) _Pragma("unroll") for (int k = 0; k < 2; ++k) dst[n][k] = *(const PG8_LAS bf16x8*)(lds + PG8_SB(b, h) + boff + n * 2048 + k * 1024); } while (0)
#define PG8_MMA(ai, bj, At, Bt) do { __builtin_amdgcn_s_setprio(1); _Pragma("unroll") for (int m = 0; m < 4; ++m) _Pragma("unroll") for (int n = 0; n < 2; ++n) _Pragma("unroll") for (int k = 0; k < 2; ++k) \
        acc[ai][bj][m][n] = __builtin_amdgcn_mfma_f32_16x16x32_bf16(Bt[n][k], At[m][k], acc[ai][bj][m][n], 0, 0, 0); __builtin_amdgcn_s_setprio(0); } while (0)
#define PG8_WAIT_V(n) asm volatile("s_waitcnt vmcnt(" #n ")" ::: "memory")
#define PG8_WAIT_L(n) asm volatile("s_waitcnt lgkmcnt(" #n ")" ::: "memory")
#define PG8_BAR __builtin_amdgcn_s_barrier()
#define PG8_SCHED __builtin_amdgcn_sched_barrier(0)
    Unit cur, nxt; int ui = 0;
    if (!S.next(0, cur)) return;
    f32x4 acc[2][2][4][2];
#pragma unroll
    for (int a = 0; a < 2; ++a)
#pragma unroll
        for (int b = 0; b < 2; ++b)
#pragma unroll
            for (int m = 0; m < 4; ++m)
#pragma unroll
                for (int n = 0; n < 2; ++n) acc[a][b][m][n] = (f32x4){0.f, 0.f, 0.f, 0.f};
    bf16x8 At[4][2], B0[2][2], B1[2][2];
    const char* cA = (const char*)g.A + (size_t)cur.pm * tstepA; const char* cB = (const char*)g.Bt + (size_t)cur.pn * tstep;
    S.a_ready(cur);
    if constexpr (SP2) {
        PG8_STAGE(PG8_SB(0, 0), cB, voffB); PG8_STAGE(PG8_SB(0, 1), cB + hstep, voffB); PG8_STAGE(PG8_SA(0, 0), cA, voffA); PG8_STAGE(PG8_SA(0, 1), cA + hstep, voffA);
        if (wr == 1) PG8_BAR;
        PG8_WAIT_V(2); PG8_BAR;
        PG8_STAGE(PG8_SB(1, 0), cB + kstep, voffB); PG8_STAGE(PG8_SA(1, 0), cA + kstep, voffA); PG8_STAGE(PG8_SB(1, 1), cB + hstep + kstep, voffB);
        PG8_WAIT_V(6); PG8_BAR;
    } else {
        PG8_STAGE(PG8_SB(0, 0), cB, voffB); PG8_STAGE(PG8_SA(0, 0), cA, voffA); PG8_STAGE(PG8_SB(0, 1), cB + hstep, voffB); PG8_STAGE(PG8_SA(0, 1), cA + hstep, voffA);
        if (wr == 1) PG8_BAR;
        PG8_WAIT_V(4); PG8_BAR;
        PG8_STAGE(PG8_SB(1, 0), cB + kstep, voffB); PG8_STAGE(PG8_SA(1, 0), cA + kstep, voffA); PG8_STAGE(PG8_SB(1, 1), cB + hstep + kstep, voffB);
        PG8_WAIT_V(6); PG8_BAR;
    }
    for (;;) {
        const bool has_next = S.next(ui + 1, nxt);
        const char* nA = has_next ? (const char*)g.A + (size_t)nxt.pm * tstepA : cA; const char* nB = has_next ? (const char*)g.Bt + (size_t)nxt.pn * tstep : cB;
        for (int t = 0; t < nt; t += 2) {
            const bool last = (t == nt - 2);
            const char* a1 = cA + (size_t)(t + 1) * kstep;
            const char* a2 = last ? nA : cA + (size_t)(t + 2) * kstep; const char* b2 = last ? nB : cB + (size_t)(t + 2) * kstep;
            const char* a3 = a2 + kstep; const char* b3 = b2 + kstep;
            if (last && has_next) S.a_ready(nxt);
            if constexpr (SP2) {
            PG8_LDB(B0, 0, 0); PG8_LDB(B1, 0, 1); PG8_SCHED; PG8_LDA(At, 0, 0); PG8_STAGE(PG8_SA(1, 1), a1 + hstep, voffA);
            PG8_WAIT_V(8); PG8_WAIT_L(0); PG8_BAR; PG8_MMA(0, 0, At, B0); PG8_MMA(0, 1, At, B1); PG8_BAR; PG8_SCHED;
            if constexpr (!HALFM) { PG8_LDA(At, 0, 1); } PG8_STAGE(PG8_SB(0, 0), b2, voffB); PG8_STAGE(PG8_SB(0, 1), b2 + hstep, voffB); PG8_STAGE(PG8_SA(0, 0), a2, voffA);
            PG8_WAIT_V(8); PG8_WAIT_L(0); PG8_BAR; if constexpr (!HALFM) { PG8_MMA(1, 0, At, B0); PG8_MMA(1, 1, At, B1); } PG8_BAR; PG8_SCHED;
            PG8_LDB(B0, 1, 0); PG8_LDB(B1, 1, 1); PG8_SCHED; PG8_LDA(At, 1, 0); PG8_STAGE(PG8_SA(0, 1), a2 + hstep, voffA);
            PG8_WAIT_V(8); PG8_WAIT_L(0); PG8_BAR; PG8_MMA(0, 0, At, B0); PG8_MMA(0, 1, At, B1); PG8_BAR; PG8_SCHED;
            if constexpr (!HALFM) { PG8_LDA(At, 1, 1); } PG8_STAGE(PG8_SB(1, 0), b3, voffB); PG8_STAGE(PG8_SB(1, 1), b3 + hstep, voffB); PG8_STAGE(PG8_SA(1, 0), a3, voffA);
            PG8_WAIT_V(8); PG8_WAIT_L(0); PG8_BAR; if constexpr (!HALFM) { PG8_MMA(1, 0, At, B0); PG8_MMA(1, 1, At, B1); } PG8_BAR; PG8_SCHED;
            } else {
            PG8_LDB(B0, 0, 0); PG8_SCHED; PG8_LDA(At, 0, 0); PG8_STAGE(PG8_SA(1, 1), a1 + hstep, voffA);
            PG8_WAIT_L(8); PG8_BAR; PG8_WAIT_L(0); PG8_MMA(0, 0, At, B0); PG8_BAR; PG8_SCHED;
            PG8_LDB(B1, 0, 1); PG8_STAGE(PG8_SB(0, 0), b2, voffB);
            PG8_BAR; PG8_WAIT_L(0); PG8_MMA(0, 1, At, B1); PG8_BAR;
            PG8_LDA(At, 0, 1); PG8_STAGE(PG8_SA(0, 0), a2, voffA);
            PG8_BAR; PG8_WAIT_L(0); PG8_MMA(1, 0, At, B0); PG8_BAR; PG8_SCHED;
            PG8_STAGE(PG8_SB(0, 1), b2 + hstep, voffB);
            PG8_WAIT_V(6); PG8_BAR; PG8_MMA(1, 1, At, B1); PG8_BAR;
            PG8_LDB(B0, 1, 0); PG8_SCHED; PG8_LDA(At, 1, 0); PG8_STAGE(PG8_SA(0, 1), a2 + hstep, voffA);
            PG8_WAIT_L(8); PG8_BAR; PG8_WAIT_L(0); PG8_MMA(0, 0, At, B0); PG8_BAR; PG8_SCHED;
            PG8_LDB(B1, 1, 1); PG8_STAGE(PG8_SB(1, 0), b3, voffB);
            PG8_BAR; PG8_WAIT_L(0); PG8_MMA(0, 1, At, B1); PG8_BAR;
            PG8_LDA(At, 1, 1); PG8_STAGE(PG8_SA(1, 0), a3, voffA);
            PG8_BAR; PG8_WAIT_L(0); PG8_MMA(1, 0, At, B0); PG8_BAR; PG8_SCHED;
            PG8_STAGE(PG8_SB(1, 1), b3 + hstep, voffB);
            PG8_WAIT_V(6); PG8_BAR; PG8_MMA(1, 1, At, B1); PG8_BAR;
            }
        }
        if constexpr (ALIGN_EPI) { if (wr == 0) PG8_BAR; }
        if constexpr (!Epi::AFTER_DRAIN) { E(acc, cur, wr, wc, fr, fq); S.done(cur); }
        if (!has_next) break;
#pragma unroll
        for (int a = 0; a < 2; ++a)
#pragma unroll
            for (int b = 0; b < 2; ++b)
#pragma unroll
                for (int m = 0; m < 4; ++m)
#pragma unroll
                    for (int n = 0; n < 2; ++n) acc[a][b][m][n] = (f32x4){0.f, 0.f, 0.f, 0.f};
        cur = nxt; cA = nA; cB = nB; ++ui;
        if constexpr (ALIGN_EPI) { if (wr == 1) PG8_BAR; }
    }
    PG8_WAIT_V(0);
    if constexpr (!ALIGN_EPI) { if (wr == 0) PG8_BAR; }
    PG8_BAR;
    if constexpr (Epi::AFTER_DRAIN) { E.fused(acc, cur, wr, wc, fr, fq, lds, wid, lane); S.done(cur); }
#undef PG8_SA
#undef PG8_SB
#undef PG8_STAGE
#undef PG8_LDA
#undef PG8_LDB
#undef PG8_MMA
#undef PG8_WAIT_V
#undef PG8_WAIT_L
#undef PG8_BAR
#undef PG8_SCHED
}
}

constexpr int D = 2048, BATCH = 4, SEQ = 2048, MP = BATCH * SEQ, SB = 32;
constexpr int INW = 12288, INDIM = 12352, CONVD = 8192, VALD = 4096, FF = 5632, GU = 2 * FF;
constexpr int NCH = 32;
constexpr float EPS = 1e-6f;
constexpr float LOG2E = 1.4426950408889634f;
constexpr float QSCALE = 0.125f * LOG2E;
constexpr int NWAVES = 8, NTHR = 512;

constexpr size_t MiB = 1u << 20;
constexpr size_t WS_CTL = 0, CTL_ZERO_BYTES = 4 * MiB;
constexpr size_t WS_WIN = 4 * MiB;
constexpr size_t WS_WBA = 100 * MiB;
constexpr size_t WS_WOUT = 101 * MiB;
constexpr size_t WS_WGU = 133 * MiB;
constexpr size_t WS_WDN = 309 * MiB;
constexpr size_t WS_WQKV = 397 * MiB;
constexpr size_t WS_WQ1 = 407 * MiB;
constexpr size_t WS_WO = 415 * MiB;
constexpr size_t WS_X = 431 * MiB;
constexpr size_t WS_XB = 495 * MiB;
constexpr size_t WS_PROJ = 527 * MiB;
constexpr size_t WS_BETA = 719 * MiB;
constexpr size_t WS_G = 720 * MiB;
constexpr size_t WS_PREPA = 721 * MiB;
constexpr size_t WS_PREPU = 945 * MiB;
constexpr size_t WS_EGL = 1009 * MiB;
constexpr size_t WS_OG = 1010 * MiB;
constexpr size_t WS_MID = 1074 * MiB;
constexpr size_t WS_Q = 1162 * MiB;
constexpr size_t WS_K = 1194 * MiB;
constexpr size_t WS_VT = 1198 * MiB;
constexpr size_t WS_AO = 1202 * MiB;
constexpr size_t WS_SMP = 1234 * MiB;
constexpr size_t WS_SSQP = 1242 * MiB;
constexpr size_t WS_SSQSP = 1251 * MiB;
constexpr size_t WS_END = 1252 * MiB;
constexpr size_t SM_XS = 0;
constexpr size_t SM_XSB = 262144;
constexpr size_t SM_PROJS = 393216;
constexpr size_t SM_QKVS = 2 * MiB;
constexpr size_t SM_BETAS = 3 * MiB;
constexpr size_t SM_GS = 3 * MiB + 4096;
constexpr size_t SM_OGS = 3 * MiB + 8192;
constexpr size_t SM_MIDS = 4 * MiB;
constexpr size_t SM_QS = 5 * MiB;
constexpr size_t SM_KVS = 5 * MiB + 262144;
constexpr size_t SM_AOS = 6 * MiB;
constexpr int CW_BAR = 4096;
constexpr int CW_SSQ = 16384;
constexpr int CW_SSQS = 16384 + 9 * 8192;
constexpr int PREPA_REC = 57344, PREPU_REC = 16384;

constexpr int LDS_BYTES = 147456, MISC_OFF = LDS_BYTES - 256;

#define GAS __attribute__((address_space(1)))
#define LAS __attribute__((address_space(3)))
typedef unsigned short bf16_t;
typedef unsigned u32x4 __attribute__((ext_vector_type(4)));
typedef unsigned u32x2 __attribute__((ext_vector_type(2)));
typedef float f32x4 __attribute__((ext_vector_type(4)));
typedef float f32x16 __attribute__((ext_vector_type(16)));
typedef short bf16x8 __attribute__((ext_vector_type(8)));
typedef short bf16x4 __attribute__((ext_vector_type(4)));
#define LDS_WAIT() asm volatile("s_waitcnt lgkmcnt(0)" ::: "memory")
#define VM_WAIT() asm volatile("s_waitcnt vmcnt(0)" ::: "memory")
#define MFMA16(a, b, c) __builtin_amdgcn_mfma_f32_16x16x32_bf16((a), (b), (c), 0, 0, 0)
#define MFMA32(a, b, c) __builtin_amdgcn_mfma_f32_32x32x16_bf16((a), (b), (c), 0, 0, 0)

__device__ __forceinline__ float bf2f(bf16_t v) { return __uint_as_float((unsigned)v << 16); }
typedef float f32x2_t __attribute__((ext_vector_type(2))); typedef __bf16 bf16x2_t __attribute__((ext_vector_type(2)));
__device__ __forceinline__ unsigned pk2(float lo, float hi) { const f32x2_t v = {lo, hi}; const bf16x2_t b = __builtin_convertvector(v, bf16x2_t); return __builtin_bit_cast(unsigned, b); }
__device__ __forceinline__ bf16_t f2bf(float f) { return (bf16_t)(pk2(f, 0.f) & 0xffffu); }
__device__ __forceinline__ float fast_exp2(float x) { return __builtin_amdgcn_exp2f(x); }
__device__ __forceinline__ float fast_exp(float x) { return __builtin_amdgcn_exp2f(x * LOG2E); }
__device__ __forceinline__ float fast_rcp(float x) { return __builtin_amdgcn_rcpf(x); }
__device__ __forceinline__ float silu_f(float x) { return x * fast_rcp(1.0f + fast_exp(-x)); }
__device__ __forceinline__ float fast_rsq(float x) { return __builtin_amdgcn_rsqf(x); }
__device__ __forceinline__ float fast_log2(float x) { return __builtin_amdgcn_logf(x); }
__device__ __forceinline__ float sigmoid_f(float x) { return fast_rcp(1.0f + fast_exp(-x)); }
__device__ __forceinline__ float softplus_f(float x) { return x > 15.f ? x : fast_log2(1.0f + fast_exp(x)) * 0.6931471805599453f; }
__device__ __forceinline__ float rinv_of(float ssq) { return fast_rsq(ssq * (1.0f / D) + EPS); }
__device__ __forceinline__ float wave_sum(float v) {
#pragma unroll
    for (int o = 1; o < 64; o <<= 1) v += __shfl_xor(v, o);
    return v;
}
__device__ __forceinline__ float sum_fq4(float s) {
    { const auto r = __builtin_amdgcn_permlane16_swap(__float_as_uint(s), __float_as_uint(s), false, false); s = __uint_as_float(r[0]) + __uint_as_float(r[1]); }
    { const auto r = __builtin_amdgcn_permlane32_swap(__float_as_uint(s), __float_as_uint(s), false, false); s = __uint_as_float(r[0]) + __uint_as_float(r[1]); }
    return s;
}
__device__ __forceinline__ float rinv_row4(const float* ssqp, int row, int fq) {
    const f32x4* p = (const f32x4*)(ssqp + (size_t)row * 32 + 8 * fq); const f32x4 a = p[0], b = p[1];
    float s = ((a[0] + a[1]) + (a[2] + a[3])) + ((b[0] + b[1]) + (b[2] + b[3]));
    return rinv_of(sum_fq4(s));
}
__device__ __forceinline__ float rinv_row_full(const float* ssqp, int row) {
    const f32x4* p = (const f32x4*)(ssqp + (size_t)row * 32); float s = 0.f;
#pragma unroll
    for (int i = 0; i < 8; ++i) { const f32x4 a = p[i]; s += (a[0] + a[1]) + (a[2] + a[3]); }
    return rinv_of(s);
}
__device__ __forceinline__ int crow32(int r, int hi) { return (r & 3) + 8 * (r >> 2) + 4 * hi; }

namespace pg8 {
struct EpiProj {
    static constexpr bool PERM = true, AFTER_DRAIN = false;
    bf16_t* O; int ldc; const float* ssq; int silu_from;
    __device__ __forceinline__ void operator()(const f32x4 (&acc)[2][2][4][2], const Unit& u, int wr, int wc, int fr, int fq) const {
        asm volatile("" : "+v"(fr), "+v"(fq));
        const int row0 = u.pm * BM + wr * 64 + fr, col0 = u.pn * BM + wc * 32 + 8 * fq;
#pragma unroll
        for (int ai = 0; ai < 2; ++ai)
#pragma unroll
            for (int m = 0; m < 4; ++m) { const int row = row0 + ai * HALF + m * 16; const float ri = rinv_row4(ssq, row, fq); bf16_t* rowp = O + (size_t)row * ldc + col0;
#pragma unroll
                for (int bj = 0; bj < 2; ++bj) { f32x4 v0 = acc[ai][bj][m][0] * ri, v1 = acc[ai][bj][m][1] * ri;
                    if (u.pn >= silu_from) {
#pragma unroll
                        for (int e = 0; e < 4; ++e) { v0[e] = silu_f(v0[e]); v1[e] = silu_f(v1[e]); } }
                    u32x4 w; w.x = cvt_pk_bf16(v0[0], v0[1]); w.y = cvt_pk_bf16(v0[2], v0[3]); w.z = cvt_pk_bf16(v1[0], v1[1]); w.w = cvt_pk_bf16(v1[2], v1[3]);
                    *(u32x4*)(rowp + bj * HALF) = w; } }
    }
};
struct EpiRes {
    static constexpr bool PERM = true, AFTER_DRAIN = false;
    const float* base32; bf16_t* XB; float* ssq;
    __device__ __forceinline__ void operator()(const f32x4 (&acc)[2][2][4][2], const Unit& u, int wr, int wc, int fr, int fq) const {
        asm volatile("" : "+v"(fr), "+v"(fq));
        const int row0 = u.pm * BM + wr * 64 + fr, col0 = u.pn * BM + wc * 32 + 8 * fq;
#pragma unroll
        for (int ai = 0; ai < 2; ++ai)
#pragma unroll
            for (int m = 0; m < 4; ++m) { const int row = row0 + ai * HALF + m * 16; const size_t off = (size_t)row * D + col0; float s = 0.f;
#pragma unroll
                for (int bj = 0; bj < 2; ++bj) { f32x4 b0, b1;
                    if (base32) { b0 = *(const f32x4*)(base32 + off + bj * HALF); b1 = *(const f32x4*)(base32 + off + bj * HALF + 4); }
                    else { const u32x4 q = *(const u32x4*)(XB + off + bj * HALF);
                        b0 = (f32x4){__uint_as_float(q.x << 16), __uint_as_float(q.x & 0xffff0000u), __uint_as_float(q.y << 16), __uint_as_float(q.y & 0xffff0000u)};
                        b1 = (f32x4){__uint_as_float(q.z << 16), __uint_as_float(q.z & 0xffff0000u), __uint_as_float(q.w << 16), __uint_as_float(q.w & 0xffff0000u)}; }
                    const f32x4 v0 = acc[ai][bj][m][0] + b0, v1 = acc[ai][bj][m][1] + b1;
                    u32x4 w; w.x = cvt_pk_bf16(v0[0], v0[1]); w.y = cvt_pk_bf16(v0[2], v0[3]); w.z = cvt_pk_bf16(v1[0], v1[1]); w.w = cvt_pk_bf16(v1[2], v1[3]);
                    *(u32x4*)(XB + off + bj * HALF) = w;
                    s += (v0[0] * v0[0] + v0[1] * v0[1]) + (v0[2] * v0[2] + v0[3] * v0[3]) + (v1[0] * v1[0] + v1[1] * v1[1]) + (v1[2] * v1[2] + v1[3] * v1[3]); }
                s = sum_fq4(s);
                if (fq == 0) ssq[(size_t)row * 32 + u.pn * 4 + wc] = s; }
    }
};
template <bool HALFM> struct EpiSwigluT {
    static constexpr bool PERM = true, AFTER_DRAIN = false;
    bf16_t* O; const float* ssq;
    __device__ __forceinline__ void operator()(const f32x4 (&acc)[2][2][4][2], const Unit& u, int wr, int wc, int fr, int fq) const {
        asm volatile("" : "+v"(fr), "+v"(fq));
        const int row0 = u.pm * (HALFM ? HALF : BM) + wr * 64 + fr, col0 = u.pn * HALF + wc * 32 + 8 * fq;
#pragma unroll
        for (int ai = 0; ai < (HALFM ? 1 : 2); ++ai)
#pragma unroll
            for (int m = 0; m < 4; ++m) { const int row = row0 + ai * HALF + m * 16; const float ri = rinv_row4(ssq, row, fq); float o[8];
#pragma unroll
                for (int n = 0; n < 2; ++n)
#pragma unroll
                    for (int e = 0; e < 4; ++e) { const float g = acc[ai][0][m][n][e] * ri, up = acc[ai][1][m][n][e] * ri; o[4 * n + e] = silu_f(g) * up; }
                u32x4 w; w.x = cvt_pk_bf16(o[0], o[1]); w.y = cvt_pk_bf16(o[2], o[3]); w.z = cvt_pk_bf16(o[4], o[5]); w.w = cvt_pk_bf16(o[6], o[7]);
                *(u32x4*)(O + (size_t)row * FF + col0) = w; }
    }
};
template <bool HALFM> struct EpiQKVT {
    static constexpr bool PERM = true, AFTER_DRAIN = false;
    bf16_t* Q; bf16_t* KB; bf16_t* VT; float* kwin; float* vwin; const float* ssq;
    __device__ __forceinline__ void operator()(const f32x4 (&acc)[2][2][4][2], const Unit& u, int wr, int wc, int fr, int fq) const {
        asm volatile("" : "+v"(fr), "+v"(fq));
        const int row0 = u.pm * (HALFM ? HALF : BM) + wr * 64 + fr, cl0 = wc * 32 + 8 * fq;
#pragma unroll
        for (int ai = 0; ai < (HALFM ? 1 : 2); ++ai)
#pragma unroll
            for (int m = 0; m < 4; ++m) { const int row = row0 + ai * HALF + m * 16; const float ri = rinv_row4(ssq, row, fq); const int b = row >> 11, t = row & 2047;
#pragma unroll
                for (int bj = 0; bj < 2; ++bj) { const f32x4 v0 = acc[ai][bj][m][0] * ri, v1 = acc[ai][bj][m][1] * ri; const int cl = cl0 + bj * HALF;
                    if (u.pn < 8) {
                        u32x4 w; w.x = cvt_pk_bf16(v0[0], v0[1]); w.y = cvt_pk_bf16(v0[2], v0[3]); w.z = cvt_pk_bf16(v1[0], v1[1]); w.w = cvt_pk_bf16(v1[2], v1[3]);
                        *(u32x4*)(Q + (size_t)row * D + u.pn * BM + cl) = w;
                    } else if (u.pn == 8) {
                        u32x4 w; w.x = cvt_pk_bf16(v0[0], v0[1]); w.y = cvt_pk_bf16(v0[2], v0[3]); w.z = cvt_pk_bf16(v1[0], v1[1]); w.w = cvt_pk_bf16(v1[2], v1[3]);
                        *(u32x4*)(KB + (size_t)row * 256 + cl) = w;
                        if (t >= SEQ - 128) { float* o = kwin + ((size_t)(b * 128 + t - (SEQ - 128))) * 256 + cl; *(f32x4*)o = v0; *(f32x4*)(o + 4) = v1; }
                    } else {
                        const float vv[8] = {v0[0], v0[1], v0[2], v0[3], v1[0], v1[1], v1[2], v1[3]};
#pragma unroll
                        for (int e = 0; e < 8; ++e) { const int c = cl + e; VT[((size_t)(b * 4 + (c >> 6)) * 64 + (c & 63)) * SEQ + t] = (bf16_t)(cvt_pk_bf16(vv[e], 0.f) & 0xffffu); }
                        if (t >= SEQ - 128) { float* o = vwin + ((size_t)(b * 128 + t - (SEQ - 128))) * 256 + cl; *(f32x4*)o = v0; *(f32x4*)(o + 4) = v1; }
                    } } }
    }
};
}

struct TrItem { const float* src; bf16_t* dst; const float* gain; int ld, col0, K, k0, drow0; float scale; };
__device__ __forceinline__ void tr_load(const TrItem& T, f32x4 (&v)[16], float (&g)[16], int lane) {
#pragma unroll
    for (int i = 0; i < 16; ++i) {
        const int kk = 4 * i + (lane >> 4);
        v[i] = *(const f32x4*)(T.src + (size_t)(T.k0 + kk) * T.ld + T.col0 + 4 * (lane & 15));
        g[i] = T.gain ? T.gain[T.k0 + kk] : 1.0f;
    }
}
__device__ __forceinline__ void tr_store(const TrItem& T, const f32x4 (&v)[16], const float (&g)[16], LAS float* scr, int lane) {
#pragma unroll
    for (int i = 0; i < 16; ++i) {
        const int kk = 4 * i + (lane >> 4); const float gg = g[i] * T.scale;
        LAS float* p = scr + kk * 65 + 4 * (lane & 15);
        p[0] = v[i][0] * gg; p[1] = v[i][1] * gg; p[2] = v[i][2] * gg; p[3] = v[i][3] * gg;
    }
    LDS_WAIT();
#pragma unroll
    for (int j = 0; j < 8; ++j) {
        const int idx = j * 64 + lane, n = idx >> 3, kc = idx & 7;
        const LAS float* s = scr + (8 * kc) * 65 + n;
        u32x4 o; o.x = pk2(s[0], s[65]); o.y = pk2(s[2 * 65], s[3 * 65]); o.z = pk2(s[4 * 65], s[5 * 65]); o.w = pk2(s[6 * 65], s[7 * 65]);
        *(u32x4*)(T.dst + (size_t)(T.drow0 + n) * T.K + T.k0 + 8 * kc) = o;
    }
    LDS_WAIT();
}

typedef const float* const __attribute__((address_space(4)))* KP_T;
constexpr int CV_IN = 32 * 192, CV_BA = 32, CV_OUT = 64 * 32, CV_GU = 32 * 176, CV_DN = 88 * 32, CV_KV = 32 * 8, CV_Q = 32 * 32;
constexpr int CV_A = CV_IN + CV_BA + CV_OUT + CV_GU + CV_DN;
constexpr int CV_B0 = CV_KV + 2 * CV_Q + CV_GU + CV_DN;
constexpr int CV_B1 = 2 * CV_Q + CV_GU + CV_DN;
__host__ __device__ constexpr int cv_count(int lam) { return lam < 2 ? CV_A : (lam == 2 ? CV_B0 : CV_B1); }
__device__ __forceinline__ TrItem tr_decode(KP_T kp, unsigned char* ws, int lam, int r) {
    TrItem T; T.scale = 1.f; T.gain = nullptr;
    const float* w_gu_ = kp[20] + (size_t)lam * D * GU; const float* w_dn_ = kp[21] + (size_t)lam * FF * D;
    bf16_t* WGU = (bf16_t*)(ws + WS_WGU) + (size_t)lam * GU * D; bf16_t* WDN = (bf16_t*)(ws + WS_WDN) + (size_t)lam * D * FF;
    if (lam < 2) {
        const float* w_in_ = kp[8] + (size_t)lam * D * INDIM; const float* nm = kp[6] + lam * D;
        if (r < CV_IN) { const int kb = r / 192, nb = r % 192;
            T.src = w_in_; T.ld = INDIM; T.col0 = 64 * nb; T.K = D; T.k0 = 64 * kb; T.dst = (bf16_t*)(ws + WS_WIN) + (size_t)lam * INW * D; T.drow0 = 64 * nb; T.gain = nm; return T; } r -= CV_IN;
        if (r < CV_BA) { T.src = w_in_; T.ld = INDIM; T.col0 = INW; T.K = D; T.k0 = 64 * r; T.dst = (bf16_t*)(ws + WS_WBA) + (size_t)lam * 64 * D; T.drow0 = 0; T.gain = nm; return T; } r -= CV_BA;
        if (r < CV_OUT) { const int kb = r / 32, nb = r % 32;
            T.src = kp[13] + (size_t)lam * VALD * D; T.ld = D; T.col0 = 64 * nb; T.K = VALD; T.k0 = 64 * kb; T.dst = (bf16_t*)(ws + WS_WOUT) + (size_t)lam * D * VALD; T.drow0 = 64 * nb; return T; } r -= CV_OUT;
    } else {
        const int j = lam - 2;
        if (j == 0) { if (r < CV_KV) { const int kb = r / 8, nb = r % 8;
            T.src = kp[15]; T.ld = 512; T.col0 = 64 * nb; T.K = D; T.k0 = 64 * kb; T.dst = (bf16_t*)(ws + WS_WQKV); T.drow0 = 2048 + 64 * nb; T.gain = kp[14]; return T; } r -= CV_KV; }
        if (r < CV_Q) { const int kb = r / 32, nb = r % 32;
            T.src = kp[16] + (size_t)j * D * D; T.ld = D; T.col0 = 64 * nb; T.K = D; T.k0 = 64 * kb; T.dst = (bf16_t*)(ws + (j == 0 ? WS_WQKV : WS_WQ1)); T.drow0 = 64 * nb; T.gain = kp[6] + (2 + j) * D; T.scale = QSCALE; return T; } r -= CV_Q;
        if (r < CV_Q) { const int kb = r / 32, nb = r % 32;
            T.src = kp[17] + (size_t)j * D * D; T.ld = D; T.col0 = 64 * nb; T.K = D; T.k0 = 64 * kb; T.dst = (bf16_t*)(ws + WS_WO) + (size_t)j * D * D; T.drow0 = 64 * nb; return T; } r -= CV_Q;
    }
    if (r < CV_GU) { const int kb = r / 176, nb = r % 176; const int c = 64 * nb;
        T.src = w_gu_; T.ld = GU; T.col0 = c; T.K = D; T.k0 = 64 * kb; T.dst = WGU;
        T.drow0 = c < FF ? 256 * (c >> 7) + (c & 127) : 256 * ((c - FF) >> 7) + 128 + ((c - FF) & 127); T.gain = kp[7] + lam * D; return T; } r -= CV_GU;
    { const int kb = r / 32, nb = r % 32;
        T.src = w_dn_; T.ld = D; T.col0 = 64 * nb; T.K = FF; T.k0 = 64 * kb; T.dst = WDN; T.drow0 = 64 * nb; return T; }
}
__device__ __forceinline__ void convert_range(KP_T kp, unsigned char* ws, int lam, int first, int count, int worker, int nworkers, LAS float* scr, int lane) {
    for (int it = worker; it < count; it += nworkers) {
        f32x4 va[16]; float ga[16];
        const TrItem T = tr_decode(kp, ws, lam, first + it);
        tr_load(T, va, ga, lane);
        tr_store(T, va, ga, scr, lane);
    }
}

__device__ __forceinline__ void row_to_bf16(const float* __restrict__ xrow, bf16_t* __restrict__ orow, float* ssq_out, int npart, int lane) {
    const f32x4* xr = (const f32x4*)xrow + lane;
    f32x4 v[8]; float s = 0.f;
#pragma unroll
    for (int j = 0; j < 8; ++j) { v[j] = xr[64 * j]; s += (v[j][0] * v[j][0] + v[j][1] * v[j][1]) + (v[j][2] * v[j][2] + v[j][3] * v[j][3]); }
    s = wave_sum(s);
    if (lane < npart) ssq_out[lane] = lane == 0 ? s : 0.f;
    u32x2* o8 = (u32x2*)orow + lane;
#pragma unroll
    for (int j = 0; j < 8; ++j) { u32x2 w; w.x = pk2(v[j][0], v[j][1]); w.y = pk2(v[j][2], v[j][3]); o8[64 * j] = w; }
}

template <bool PAIR, class F>
__device__ __forceinline__ void skinny_unit(const bf16_t* __restrict__ A, int lda, const bf16_t* __restrict__ B0, const bf16_t* __restrict__ B1, int ldb, int K,
                                            LAS float* red, int wid, int lane, int tid, F&& epi) {
    asm volatile("" : "+v"(tid), "+v"(lane));
    const int kw = K >> 3, kbeg = wid * kw;
    f32x16 acc0, acc1;
#pragma unroll
    for (int r = 0; r < 16; ++r) { acc0[r] = 0.f; acc1[r] = 0.f; }
    const bf16_t* ap = A + (size_t)(lane & 31) * lda + kbeg + 8 * (lane >> 5);
    const bf16_t* bp0 = B0 + (size_t)(lane & 31) * ldb + kbeg + 8 * (lane >> 5);
    const bf16_t* bp1 = (PAIR ? B1 : B0) + (size_t)(lane & 31) * ldb + kbeg + 8 * (lane >> 5);
    bf16x8 fa[4], fb0[4], fb1[4], ga[4], gb0[4], gb1[4];
#pragma unroll
    for (int i = 0; i < 4; ++i) { fa[i] = *(const bf16x8*)(ap + 16 * i); fb0[i] = *(const bf16x8*)(bp0 + 16 * i); if (PAIR) fb1[i] = *(const bf16x8*)(bp1 + 16 * i); }
    for (int k = 0; k < kw; k += 64) {
        const int kn = k + 64 < kw ? k + 64 : k;
#pragma unroll
        for (int i = 0; i < 4; ++i) { ga[i] = *(const bf16x8*)(ap + kn + 16 * i); gb0[i] = *(const bf16x8*)(bp0 + kn + 16 * i); if (PAIR) gb1[i] = *(const bf16x8*)(bp1 + kn + 16 * i); }
        __builtin_amdgcn_sched_barrier(0);
#pragma unroll
        for (int i = 0; i < 4; ++i) { acc0 = MFMA32(fa[i], fb0[i], acc0); if (PAIR) acc1 = MFMA32(fa[i], fb1[i], acc1); }
        __builtin_amdgcn_sched_barrier(0);
#pragma unroll
        for (int i = 0; i < 4; ++i) { fa[i] = ga[i]; fb0[i] = gb0[i]; if (PAIR) fb1[i] = gb1[i]; }
    }
#pragma unroll
    for (int r = 0; r < 16; ++r) { red[((wid * 2 + 0) * 16 + r) * 64 + lane] = acc0[r]; if (PAIR) red[((wid * 2 + 1) * 16 + r) * 64 + lane] = acc1[r]; }
    __syncthreads();
#pragma unroll
    for (int q = 0; q < 2; ++q) {
        const int e = tid + 512 * q, r = e >> 6, ln = e & 63;
        float v0 = 0.f, v1 = 0.f;
#pragma unroll
        for (int w = 0; w < 8; ++w) { v0 += red[((w * 2 + 0) * 16 + r) * 64 + ln]; if (PAIR) v1 += red[((w * 2 + 1) * 16 + r) * 64 + ln]; }
        epi(crow32(r, ln >> 5), ln & 31, v0, v1);
    }
    __syncthreads();
}

constexpr int PL_QN = 0, PL_KN = 18432, PL_KT = 36864, PL_VT = 55296, PL_AM = 92160, PL_TAB = 126976;
constexpr int PL_T = 0, PL_TP = 18432;
constexpr int NAT_LD = 136, TR_LD = 72, AM_LD = 68;


__host__ __device__ constexpr int ti_q(int idx) { int q = 0; while ((q + 1) * (q + 2) / 2 <= idx) ++q; return q; }
template <int IDX> __device__ __forceinline__ void ti_load(const LAS float* A, f32x4 (&buf)[4][4]) {
    constexpr int q = ti_q(IDX), g = IDX - q * (q + 1) / 2;
#pragma unroll
    for (int r = 0; r < 4; ++r) buf[IDX % 4][r] = *(const LAS f32x4*)(A + (4 * q + r) * AM_LD + 4 * g);
}
template <int IDX, int END> __device__ __forceinline__ void ti_prologue(const LAS float* A, f32x4 (&buf)[4][4]) {
    if constexpr (IDX < END) { ti_load<IDX>(A, buf); ti_prologue<IDX + 1, END>(A, buf); }
}
typedef float f32x2v __attribute__((ext_vector_type(2)));
template <int IDX, int END, int DEPTH> __device__ __forceinline__ void ti_steps(const LAS float* A, f32x4 (&buf)[4][4], f32x2v (&tn)[32], f32x2v (&acc)[4], int c) {
    if constexpr (IDX < END) {
        constexpr int q = ti_q(IDX), g = IDX - q * (q + 1) / 2;
        __builtin_amdgcn_sched_barrier(0);
        if constexpr (g == 0) {
#pragma unroll
            for (int r = 0; r < 4; ++r) acc[r] = (f32x2v){(c == 4 * q + r) ? 1.f : 0.f, 0.f};
        }
        if constexpr (g < q) {
#pragma unroll
            for (int r = 0; r < 4; ++r) { const f32x4 av = buf[IDX % 4][r];
                acc[r] = __builtin_elementwise_fma((f32x2v){av[0], av[1]}, tn[2 * g], acc[r]);
                acc[r] = __builtin_elementwise_fma((f32x2v){av[2], av[3]}, tn[2 * g + 1], acc[r]); }
        } else {
            const f32x4 a1 = buf[IDX % 4][1], a2 = buf[IDX % 4][2], a3 = buf[IDX % 4][3];
            const float t0 = acc[0][0] + acc[0][1];
            const float t1 = (acc[1][0] + acc[1][1]) - a1[0] * t0;
            const float t2 = (acc[2][0] + acc[2][1]) - (a2[0] * t0 + a2[1] * t1);
            const float t3 = (acc[3][0] + acc[3][1]) - ((a3[0] * t0 + a3[1] * t1) + a3[2] * t2);
            tn[2 * q] = (f32x2v){-t0, -t1}; tn[2 * q + 1] = (f32x2v){-t2, -t3};
        }
        __builtin_amdgcn_sched_barrier(0);
        if constexpr (IDX + DEPTH < END) ti_load<IDX + DEPTH>(A, buf);
        ti_steps<IDX + 1, END, DEPTH>(A, buf, tn, acc, c);
    }
}

struct PrepArgs { const bf16_t* proj; const float* beta; const float* g; const float* convw; unsigned char* prepa; unsigned char* prepu; float* egl; float* conv_p; int xf; };

struct PrepRaw { bf16_t h0, h1, h2; bf16_t raw[64]; float c0, c1, c2, c3; float gv, bt; };
__device__ __forceinline__ void prep_fetch(const PrepArgs& P, int b, int kh, int n, int tid, int wid, int lane, PrepRaw& R) {
    const int r0 = b * SEQ + n * 64, t = tid;
    const int gcol = t < 128 ? kh * 128 + t : (t < 256 ? 2048 + kh * 128 + (t - 128) : 4096 + kh * 256 + (t - 256));
    R.c0 = P.convw[gcol]; R.c1 = P.convw[CONVD + gcol]; R.c2 = P.convw[2 * CONVD + gcol]; R.c3 = P.convw[3 * CONVD + gcol];
    const bf16_t* pp = P.proj + (size_t)r0 * INW + gcol;
    R.h0 = 0; R.h1 = 0; R.h2 = 0;
    if (n > 0) { R.h0 = pp[-3 * (long)INW]; R.h1 = pp[-2 * (long)INW]; R.h2 = pp[-(long)INW]; }
#pragma unroll
    for (int j = 0; j < 64; ++j) R.raw[j] = pp[(size_t)j * INW];
    R.gv = 0.f; R.bt = 0.f;
    if (wid < 2) { const int hv = 2 * kh + wid; R.gv = P.g[(size_t)(r0 + lane) * 32 + hv]; R.bt = P.beta[(size_t)(r0 + lane) * 32 + hv]; }
}
__device__ __forceinline__ void prep_unit(const PrepArgs& P, LAS unsigned char* lds, int b, int kh, int n, int tid, int wid, int lane) {
    asm volatile("" : "+v"(tid), "+v"(lane));
    PrepRaw R; prep_fetch(P, b, kh, n, tid, wid, lane, R);
    LAS bf16_t* QN = (LAS bf16_t*)(lds + PL_QN); LAS bf16_t* KN = (LAS bf16_t*)(lds + PL_KN);
    LAS bf16_t* KT = (LAS bf16_t*)(lds + PL_KT); LAS bf16_t* VTt = (LAS bf16_t*)(lds + PL_VT);
    LAS float* AM = (LAS float*)(lds + PL_AM); LAS float* TAB = (LAS float*)(lds + PL_TAB);
    const int r0 = b * SEQ + n * 64;
    if (wid < 2) {
        float gv = R.gv;
#pragma unroll
        for (int o = 1; o < 64; o <<= 1) { const float t = __shfl_up(gv, o); if (lane >= o) gv += t; }
        TAB[wid * 64 + lane] = gv;
        TAB[128 + wid * 64 + lane] = R.bt;
    }
    __syncthreads();
    {
        const int t = tid;
        const int gcol = t < 128 ? kh * 128 + t : (t < 256 ? 2048 + kh * 128 + (t - 128) : 4096 + kh * 256 + (t - 256));
        const float c0 = R.c0, c1 = R.c1, c2 = R.c2, c3 = R.c3;
        float w0 = bf2f(R.h0), w1 = bf2f(R.h1), w2 = bf2f(R.h2);
        const int vh = (t - 256) >> 7;
#pragma unroll
        for (int jb = 0; jb < 8; ++jb) {
            float raw[8];
#pragma unroll
            for (int e = 0; e < 8; ++e) raw[e] = bf2f(R.raw[jb * 8 + e]);
            float ov[8];
#pragma unroll
            for (int e = 0; e < 8; ++e) { const float cv = w0 * c0 + w1 * c1 + w2 * c2 + raw[e] * c3; ov[e] = silu_f(cv); w0 = w1; w1 = w2; w2 = raw[e]; }
            if (t < 256) {
                LAS bf16_t* nat = (t < 128 ? QN : KN) + (t & 127);
#pragma unroll
                for (int e = 0; e < 8; ++e) nat[(jb * 8 + e) * NAT_LD] = f2bf(ov[e]);
                if (t >= 128) { u32x4 w; w.x = pk2(ov[0], ov[1]); w.y = pk2(ov[2], ov[3]); w.z = pk2(ov[4], ov[5]); w.w = pk2(ov[6], ov[7]);
                    *(LAS u32x4*)(KT + (t - 128) * TR_LD + jb * 8) = w; }
            } else {
                const LAS float* bt = TAB + 128 + vh * 64 + jb * 8;
                u32x4 w; w.x = pk2(ov[0] * bt[0], ov[1] * bt[1]); w.y = pk2(ov[2] * bt[2], ov[3] * bt[3]); w.z = pk2(ov[4] * bt[4], ov[5] * bt[5]); w.w = pk2(ov[6] * bt[6], ov[7] * bt[7]);
                *(LAS u32x4*)(VTt + (t - 256) * TR_LD + jb * 8) = w;
            }
            if (n == NCH - 1 && jb == 7) {
#pragma unroll
                for (int e = 5; e < 8; ++e) P.conv_p[((size_t)b * 3 + (e - 5)) * CONVD + gcol] = raw[e];
            }
        }
    }
    __syncthreads();
    if (P.xf & 512) return;
    {
        const int arr = tid >> 8, row = (tid >> 2) & 63, part = tid & 3;
        const LAS bf16_t* p = (arr ? KN : QN) + row * NAT_LD + part * 32;
        float s = 0.f;
#pragma unroll
        for (int c = 0; c < 4; ++c) { const bf16x8 v = *(const LAS bf16x8*)(p + c * 8);
#pragma unroll
            for (int e = 0; e < 8; ++e) { const float f = bf2f((bf16_t)v[e]); s += f * f; } }
        s += __shfl_xor(s, 1); s += __shfl_xor(s, 2);
        if (part == 0) TAB[256 + arr * 64 + row] = fast_rsq(s + EPS);
    }
    __syncthreads();
    const int m16 = lane & 15, q4 = lane >> 4;
    unsigned char* recA0 = P.prepa + (size_t)((b * 32 + 2 * kh) * NCH + n) * PREPA_REC;
    const size_t hstrideA = (size_t)NCH * PREPA_REC;
    {
        const int half = wid >> 2, it = wid & 3;
        f32x4 acc[4];
#pragma unroll
        for (int jt = 0; jt < 4; ++jt) acc[jt] = (f32x4){0.f, 0.f, 0.f, 0.f};
        if (half == 0) {
#pragma unroll
            for (int s = 0; s < 4; ++s) { const bf16x8 bq = *(const LAS bf16x8*)(QN + (16 * it + m16) * NAT_LD + 32 * s + 8 * q4);
#pragma unroll
                for (int jt = 0; jt < 4; ++jt) { const bf16x8 ak = *(const LAS bf16x8*)(KN + (16 * jt + m16) * NAT_LD + 32 * s + 8 * q4); acc[jt] = MFMA16(ak, bq, acc[jt]); } }
            const int i = 16 * it + m16; const float rqi = TAB[256 + i] * 0.08838834764831845f;
#pragma unroll
            for (int h = 0; h < 2; ++h) { const float gci = TAB[h * 64 + i];
#pragma unroll
                for (int s = 0; s < 2; ++s) { float o[8];
#pragma unroll
                    for (int e = 0; e < 8; ++e) { const int jt = 2 * s + (e >> 2), j = 16 * jt + 4 * q4 + (e & 3);
                        const float dec = fast_exp(gci - TAB[h * 64 + j]); o[e] = (i >= j) ? acc[jt][e & 3] * rqi * TAB[320 + j] * dec : 0.f; }
                    u32x4 w; w.x = pk2(o[0], o[1]); w.y = pk2(o[2], o[3]); w.z = pk2(o[4], o[5]); w.w = pk2(o[6], o[7]);
                    *(u32x4*)(recA0 + h * hstrideA + (48 + it * 2 + s) * 1024 + lane * 16) = w; } }
        } else {
#pragma unroll
            for (int s = 0; s < 4; ++s) { const bf16x8 ai = *(const LAS bf16x8*)(KN + (16 * it + m16) * NAT_LD + 32 * s + 8 * q4);
#pragma unroll
                for (int jt = 0; jt < 4; ++jt) { const bf16x8 bk = *(const LAS bf16x8*)(KN + (16 * jt + m16) * NAT_LD + 32 * s + 8 * q4); acc[jt] = MFMA16(ai, bk, acc[jt]); } }
#pragma unroll
            for (int jt = 0; jt < 4; ++jt) { const int j = 16 * jt + m16; const float rkj = TAB[320 + j];
#pragma unroll
                for (int e = 0; e < 4; ++e) { const int i = 16 * it + 4 * q4 + e; const float base = acc[jt][e] * rkj * TAB[320 + i];
#pragma unroll
                    for (int h = 0; h < 2; ++h) { const float dec = fast_exp(TAB[h * 64 + i] - TAB[h * 64 + j]);
                        AM[h * 64 * AM_LD + i * AM_LD + j] = (i > j) ? base * TAB[128 + h * 64 + i] * dec : 0.f; } } }
        }
        {
            const int h = wid >> 2, mt = wid & 3, i = 16 * mt + m16;
            const float sc = TAB[256 + i] * 0.08838834764831845f * fast_exp(TAB[h * 64 + i]);
#pragma unroll
            for (int s = 0; s < 4; ++s) {
                const bf16x4 lo = *(const LAS bf16x4*)(QN + i * NAT_LD + 32 * s + 4 * q4), hi = *(const LAS bf16x4*)(QN + i * NAT_LD + 32 * s + 16 + 4 * q4);
                u32x4 w; w.x = pk2(bf2f((bf16_t)lo[0]) * sc, bf2f((bf16_t)lo[1]) * sc); w.y = pk2(bf2f((bf16_t)lo[2]) * sc, bf2f((bf16_t)lo[3]) * sc);
                w.z = pk2(bf2f((bf16_t)hi[0]) * sc, bf2f((bf16_t)hi[1]) * sc); w.w = pk2(bf2f((bf16_t)hi[2]) * sc, bf2f((bf16_t)hi[3]) * sc);
                *(u32x4*)(recA0 + h * hstrideA + (16 + mt * 4 + s) * 1024 + lane * 16) = w;
            }
        }
    }
    __syncthreads();
    if (P.xf & 1024) return;
    asm volatile("" : "+v"(lane));
    if (wid < 2) {
        const int h = wid, c = lane;
        const LAS float* A = AM + h * 64 * AM_LD;
        f32x2v tn[32];
        constexpr int TIDEPTH = 4, NGRP = 136;
        f32x4 buf[TIDEPTH][4];
        ti_prologue<0, TIDEPTH>(A, buf);
        f32x2v acc[4];
        ti_steps<0, NGRP, TIDEPTH>(A, buf, tn, acc, c);
        const float scc = -TAB[320 + c] * TAB[128 + h * 64 + c] * fast_exp(TAB[h * 64 + c]);
        LAS bf16_t* T = (LAS bf16_t*)(lds + PL_T + h * 9216); LAS bf16_t* TP = (LAS bf16_t*)(lds + PL_TP + h * 9216);
#pragma unroll
        for (int i = 0; i < 64; ++i) { const float ti = -tn[i >> 1][i & 1]; T[i * TR_LD + c] = f2bf(ti); TP[i * TR_LD + c] = f2bf(ti * scc); }
    } else {
        for (int f = wid - 2; f < 32; f += 6) {
            const int h = f >> 4, mt = (f >> 1) & 7, s = f & 1, d = 16 * mt + m16;
            const float glast = TAB[h * 64 + 63];
            const bf16x4 lo = *(const LAS bf16x4*)(KT + d * TR_LD + 32 * s + 4 * q4), hi = *(const LAS bf16x4*)(KT + d * TR_LD + 32 * s + 16 + 4 * q4);
            float o[8];
#pragma unroll
            for (int e = 0; e < 8; ++e) { const int j = 32 * s + 16 * (e >> 2) + 4 * q4 + (e & 3);
                o[e] = bf2f((bf16_t)(e < 4 ? lo[e & 3] : hi[e & 3])) * TAB[320 + j] * fast_exp(glast - TAB[h * 64 + j]); }
            u32x4 w; w.x = pk2(o[0], o[1]); w.y = pk2(o[2], o[3]); w.z = pk2(o[4], o[5]); w.w = pk2(o[6], o[7]);
            *(u32x4*)(recA0 + h * hstrideA + (32 + mt * 2 + s) * 1024 + lane * 16) = w;
        }
    }
    __syncthreads();
    if (P.xf & 2048) return;
    {
        asm volatile("" : "+v"(lane)); const int m16 = lane & 15, q4 = lane >> 4;
        const int h = wid >> 2, it = wid & 3;
        const LAS bf16_t* T = (const LAS bf16_t*)(lds + PL_T + h * 9216); const LAS bf16_t* TP = (const LAS bf16_t*)(lds + PL_TP + h * 9216);
        bf16x8 tp[2], tt[2];
#pragma unroll
        for (int s = 0; s < 2; ++s) { tp[s] = *(const LAS bf16x8*)(TP + (16 * it + m16) * TR_LD + 32 * s + 8 * q4); tt[s] = *(const LAS bf16x8*)(T + (16 * it + m16) * TR_LD + 32 * s + 8 * q4); }
        unsigned char* recA = recA0 + h * hstrideA;
#pragma unroll
        for (int sp = 0; sp < 4; ++sp) {
            f32x4 a0 = (f32x4){0.f, 0.f, 0.f, 0.f}, a1 = a0;
#pragma unroll
            for (int s = 0; s < 2; ++s) {
                const bf16x8 k0 = *(const LAS bf16x8*)(KT + (32 * sp + m16) * TR_LD + 32 * s + 8 * q4), k1 = *(const LAS bf16x8*)(KT + (32 * sp + 16 + m16) * TR_LD + 32 * s + 8 * q4);
                a0 = MFMA16(k0, tp[s], a0); a1 = MFMA16(k1, tp[s], a1);
            }
            u32x4 w; w.x = pk2(a0[0], a0[1]); w.y = pk2(a0[2], a0[3]); w.z = pk2(a1[0], a1[1]); w.w = pk2(a1[2], a1[3]);
            *(u32x4*)(recA + (it * 4 + sp) * 1024 + lane * 16) = w;
        }
        unsigned char* recU = P.prepu + (size_t)((b * 32 + 2 * kh + h) * NCH + n) * PREPU_REC;
#pragma unroll
        for (int et = 0; et < 8; ++et) {
            f32x4 a = (f32x4){0.f, 0.f, 0.f, 0.f};
#pragma unroll
            for (int s = 0; s < 2; ++s) { const bf16x8 bv = *(const LAS bf16x8*)(VTt + (h * 128 + 16 * et + m16) * TR_LD + 32 * s + 8 * q4); a = MFMA16(tt[s], bv, a); }
            u32x2 w; w.x = pk2(a[0], a[1]); w.y = pk2(a[2], a[3]);
            *(u32x2*)(recU + (et * 4 + it) * 512 + lane * 8) = w;
        }
        if (tid < 2) P.egl[(b * 32 + 2 * kh + tid) * NCH + n] = fast_exp(TAB[tid * 64 + 63]);
    }
    __syncthreads();
}

#define BAR_LDS() do { asm volatile("s_waitcnt lgkmcnt(0)" ::: "memory"); __builtin_amdgcn_s_barrier(); asm volatile("" ::: "memory"); } while (0)

__device__ __forceinline__ float row16_sum(float v) {
    v += __builtin_bit_cast(float, __builtin_amdgcn_update_dpp(0, __builtin_bit_cast(int, v), 0x128, 0xf, 0xf, false));
    v += __builtin_bit_cast(float, __builtin_amdgcn_update_dpp(0, __builtin_bit_cast(int, v), 0x124, 0xf, 0xf, false));
    v += __builtin_bit_cast(float, __builtin_amdgcn_update_dpp(0, __builtin_bit_cast(int, v), 0x122, 0xf, 0xf, false));
    v += __builtin_bit_cast(float, __builtin_amdgcn_update_dpp(0, __builtin_bit_cast(int, v), 0x121, 0xf, 0xf, false));
    return v;
}
#define SCHED_FENCE() __builtin_amdgcn_sched_barrier(0)
struct ScanArgs { const unsigned char* prepa; const unsigned char* prepu; const float* egl; const bf16_t* proj; const float* gnorm; bf16_t* og; float* delta_out; int xf; };

__device__ __forceinline__ void scan_unit(const ScanArgs& P, LAS unsigned char* lds, int b, int hv, int tid, int wid, int lane) {
    asm volatile("" : "+v"(tid), "+v"(lane));
    const int m16 = lane & 15, q4 = lane >> 4;
    const unsigned char* recA = P.prepa + (size_t)((b * 32 + hv) * NCH) * PREPA_REC;
    const unsigned char* recU = P.prepu + (size_t)((b * 32 + hv) * NCH) * PREPU_REC;
    const float* eglp = P.egl + (b * 32 + hv) * NCH;
    LAS float* part = (LAS float*)(lds + 114688);
    LAS bf16_t* ogb = (LAS bf16_t*)(lds + 116736);
    constexpr int OG_LD = 136;
    const float gn = P.gnorm[16 * wid + m16];
    const bf16_t* zrow = P.proj + (size_t)(b * SEQ) * INW + 8192 + hv * 128;
    bf16_t* ogrow = P.og + (size_t)(b * SEQ) * VALD + hv * 128;
    f32x4 S[8];
#pragma unroll
    for (int dt = 0; dt < 8; ++dt) S[dt] = (f32x4){0.f, 0.f, 0.f, 0.f};
#define SCAN_DMA(n_, stage_) do { _Pragma("unroll") for (int k_ = 0; k_ < 7; ++k_) \
        __builtin_amdgcn_global_load_lds((const unsigned*)(recA + (size_t)(n_) * PREPA_REC + (k_ * 8 + wid) * 1024 + lane * 16), \
                                         (LAS unsigned*)(lds + (stage_) * PREPA_REC + (k_ * 8 + wid) * 1024), 16, 0, 0); } while (0)
#define SCAN_OGFLUSH(n_) do { _Pragma("unroll") for (int k_ = 0; k_ < 2; ++k_) { const int p_ = tid + 512 * k_, r_ = p_ >> 4, c_ = (p_ & 15) * 8; \
        const u32x4 v_ = *(const LAS u32x4*)(ogb + r_ * OG_LD + c_); u32x4 w_; \
        _Pragma("unroll") for (int e_ = 0; e_ < 4; ++e_) { const unsigned a_ = v_[e_], z_ = zq[k_][e_]; \
            w_[e_] = pk2(__uint_as_float(a_ << 16) * __uint_as_float(z_ << 16), __uint_as_float(a_ & 0xffff0000u) * __uint_as_float(z_ & 0xffff0000u)); } \
        *(u32x4*)(ogrow + (size_t)((n_) * 64 + r_) * VALD + c_) = w_; } } while (0)
#define SCAN_ZLOAD(n_) do { _Pragma("unroll") for (int k_ = 0; k_ < 2; ++k_) { const int p_ = tid + 512 * k_, r_ = p_ >> 4, c_ = (p_ & 15) * 8; \
        zq[k_] = *(const u32x4*)(zrow + (size_t)((n_) * 64 + r_) * INW + c_); } } while (0)
    u32x4 zq[2];
    SCAN_DMA(0, 0);
    u32x2 un[4]; float egn;
#pragma unroll
    for (int mt = 0; mt < 4; ++mt) un[mt] = *(const u32x2*)(recU + (wid * 4 + mt) * 512 + lane * 8);
    egn = eglp[0];
#pragma unroll 1
    for (int n = 0; n < NCH; ++n) {
        __builtin_amdgcn_s_waitcnt(0x0F70); VM_WAIT(); BAR_LDS();
        const float egl = egn;
        f32x4 vn[4], o[4];
#pragma unroll
        for (int mt = 0; mt < 4; ++mt) vn[mt] = (f32x4){__uint_as_float(un[mt].x << 16), __uint_as_float(un[mt].x & 0xffff0000u), __uint_as_float(un[mt].y << 16), __uint_as_float(un[mt].y & 0xffff0000u)};
        SCHED_FENCE();
        if (n > 0 && !(P.xf & 16)) SCAN_OGFLUSH(n - 1);
        SCHED_FENCE();
        {
            const int nn = n + 1 < NCH ? n + 1 : NCH - 1;
            if (!(P.xf & 8)) SCAN_DMA(nn, (n + 1) & 1);
#pragma unroll
            for (int mt = 0; mt < 4; ++mt) un[mt] = *(const u32x2*)(recU + (size_t)nn * PREPU_REC + (wid * 4 + mt) * 512 + lane * 8);
            egn = eglp[nn];
            if (!(P.xf & 16)) SCAN_ZLOAD(n);
        }
        const LAS unsigned char* st = lds + (n & 1) * PREPA_REC + lane * 16;
        bf16x8 sb[4];
#pragma unroll
        for (int s = 0; s < 4; ++s) { u32x4 w; w.x = pk2(S[2 * s][0], S[2 * s][1]); w.y = pk2(S[2 * s][2], S[2 * s][3]); w.z = pk2(S[2 * s + 1][0], S[2 * s + 1][1]); w.w = pk2(S[2 * s + 1][2], S[2 * s + 1][3]);
            sb[s] = __builtin_bit_cast(bf16x8, w); }
#define LDF(i_) (*(const LAS bf16x8*)(st + (i_) * 1024))
        bf16x8 fa[8], fb[8];
#pragma unroll
        for (int s = 0; s < 4; ++s) { fa[s] = LDF(s); fa[4 + s] = LDF(16 + s); }
#pragma unroll
        for (int mt = 0; mt < 4; ++mt) {
            o[mt] = (f32x4){0.f, 0.f, 0.f, 0.f};
            if (mt < 3) {
#pragma unroll
                for (int s = 0; s < 4; ++s) { fb[s] = LDF((mt + 1) * 4 + s); fb[4 + s] = LDF(16 + (mt + 1) * 4 + s); }
            } else {
#pragma unroll
                for (int i = 0; i < 8; ++i) fb[i] = LDF(48 + i);
            }
            SCHED_FENCE();
#pragma unroll
            for (int s = 0; s < 4; ++s) { vn[mt] = MFMA16(fa[s], sb[s], vn[mt]); o[mt] = MFMA16(fa[4 + s], sb[s], o[mt]); }
            SCHED_FENCE();
#pragma unroll
            for (int i = 0; i < 8; ++i) fa[i] = fb[i];
        }
        bf16x8 vb[2];
#pragma unroll
        for (int sp = 0; sp < 2; ++sp) { u32x4 w; w.x = pk2(vn[2 * sp][0], vn[2 * sp][1]); w.y = pk2(vn[2 * sp][2], vn[2 * sp][3]); w.z = pk2(vn[2 * sp + 1][0], vn[2 * sp + 1][1]); w.w = pk2(vn[2 * sp + 1][2], vn[2 * sp + 1][3]);
            vb[sp] = __builtin_bit_cast(bf16x8, w); }
#pragma unroll
        for (int i = 0; i < 8; ++i) fb[i] = LDF(32 + i);
        SCHED_FENCE();
#pragma unroll
        for (int mt = 0; mt < 4; ++mt)
#pragma unroll
            for (int sp = 0; sp < 2; ++sp) o[mt] = MFMA16(fa[mt * 2 + sp], vb[sp], o[mt]);
        SCHED_FENCE();
#pragma unroll
        for (int i = 0; i < 8; ++i) fa[i] = LDF(40 + i);
#pragma unroll
        for (int mt = 0; mt < 4; ++mt)
#pragma unroll
            for (int jj = 0; jj < 4; ++jj) { const float s = row16_sum(o[mt][jj] * o[mt][jj]); if (m16 == 0) part[(16 * mt + 4 * q4 + jj) * 8 + wid] = s; }
        SCHED_FENCE();
#pragma unroll
        for (int dt = 0; dt < 4; ++dt) { S[dt] = S[dt] * egl;
#pragma unroll
            for (int sp = 0; sp < 2; ++sp) S[dt] = MFMA16(fb[dt * 2 + sp], vb[sp], S[dt]); }
#pragma unroll
        for (int dt = 4; dt < 8; ++dt) { S[dt] = S[dt] * egl;
#pragma unroll
            for (int sp = 0; sp < 2; ++sp) S[dt] = MFMA16(fa[(dt - 4) * 2 + sp], vb[sp], S[dt]); }
#undef LDF
        BAR_LDS();
        {
            LAS float* rtab = (LAS float*)(lds + 134144) + wid * 64;
            const f32x4 p0 = *(const LAS f32x4*)(part + lane * 8), p1 = *(const LAS f32x4*)(part + lane * 8 + 4);
            const float tot = ((p0[0] + p0[1]) + (p0[2] + p0[3])) + ((p1[0] + p1[1]) + (p1[2] + p1[3]));
            rtab[lane] = __builtin_amdgcn_rsqf(tot * (1.0f / 128.0f) + EPS);
            LDS_WAIT();
            f32x4 rv[4];
#pragma unroll
            for (int mt = 0; mt < 4; ++mt) rv[mt] = *(const LAS f32x4*)(rtab + 16 * mt + 4 * q4);
            SCHED_FENCE();
#pragma unroll
            for (int mt = 0; mt < 4; ++mt)
#pragma unroll
                for (int jj = 0; jj < 4; ++jj) ogb[(16 * mt + 4 * q4 + jj) * OG_LD + 16 * wid + m16] = f2bf(o[mt][jj] * rv[mt][jj] * gn);
        }
    }
    BAR_LDS();
    SCAN_OGFLUSH(NCH - 1);
#undef SCAN_DMA
#undef SCAN_OGFLUSH
#undef SCAN_ZLOAD
    float* so = P.delta_out + ((size_t)(b * 32 + hv) * 128) * 128 + 16 * wid + m16;
#pragma unroll
    for (int dt = 0; dt < 8; ++dt)
#pragma unroll
        for (int jj = 0; jj < 4; ++jj) so[(size_t)(16 * dt + 4 * q4 + jj) * 128] = S[dt][jj];
    VM_WAIT(); BAR_LDS();
}

struct SConvArgs { const float* projs; const float* sconv; const float* convw; const float* a_log; const float* dt_bias; float* qkvs; float* betas; float* gs; float* conv_s; };
__device__ __forceinline__ void sconv_item(const SConvArgs& P, int b, int cg, int lane) {
    float v[2];
#pragma unroll
    for (int hh = 0; hh < 2; ++hh) {
        const int c = cg * 128 + lane + 64 * hh;
        const float raw = P.projs[(size_t)b * INDIM + c];
        const float p0 = P.sconv[((size_t)b * 3 + 0) * CONVD + c], p1 = P.sconv[((size_t)b * 3 + 1) * CONVD + c], p2 = P.sconv[((size_t)b * 3 + 2) * CONVD + c];
        const float acc = p0 * P.convw[c] + p1 * P.convw[CONVD + c] + p2 * P.convw[2 * CONVD + c] + raw * P.convw[3 * CONVD + c];
        P.conv_s[((size_t)b * 3 + 0) * CONVD + c] = p1; P.conv_s[((size_t)b * 3 + 1) * CONVD + c] = p2; P.conv_s[((size_t)b * 3 + 2) * CONVD + c] = raw;
        v[hh] = silu_f(acc);
    }
    if (cg < 32) {
        const float s = wave_sum(v[0] * v[0] + v[1] * v[1]);
        float r = fast_rsq(s + EPS); if (cg < 16) r *= 0.08838834764831845f;
        v[0] *= r; v[1] *= r;
    }
    P.qkvs[(size_t)b * CONVD + cg * 128 + lane] = v[0]; P.qkvs[(size_t)b * CONVD + cg * 128 + lane + 64] = v[1];
    if (cg == 0 && lane < 32) {
        const float braw = P.projs[(size_t)b * INDIM + 12288 + lane], araw = P.projs[(size_t)b * INDIM + 12320 + lane];
        const float xx = araw + P.dt_bias[lane];
        P.betas[b * 32 + lane] = sigmoid_f(braw); P.gs[b * 32 + lane] = -fast_exp(P.a_log[lane]) * softplus_f(xx);
    }
}

struct SRecArgs { const float* qkvs; const float* betas; const float* gs; const float* projs; const float* gnorm; const float* S0; float* Sout; bf16_t* ogs; };
__device__ __forceinline__ void srec_unit(const SRecArgs& P, LAS unsigned char* lds, int b, int hv, int tid) {
    asm volatile("" : "+v"(tid));
    LAS float* qs = (LAS float*)lds; LAS float* ks = qs + 128; LAS float* red = qs + 256; LAS float* wsm = qs + 768;
    const int e = tid & 127, dq = tid >> 7, hk = hv >> 1;
    if (tid < 128) qs[tid] = P.qkvs[(size_t)b * CONVD + hk * 128 + tid]; else if (tid < 256) ks[tid - 128] = P.qkvs[(size_t)b * CONVD + 2048 + hk * 128 + (tid - 128)];
    const float ve = P.qkvs[(size_t)b * CONVD + 4096 + hv * 128 + e], beta = P.betas[b * 32 + hv], dec = fast_exp(P.gs[b * 32 + hv]);
    const size_t sbase = ((size_t)(b * 32 + hv) * 128 + 32 * dq) * 128 + e;
    float S[32];
#pragma unroll
    for (int d = 0; d < 32; ++d) S[d] = P.S0[sbase + (size_t)d * 128];
    __syncthreads();
    float kvp = 0.f;
#pragma unroll
    for (int d = 0; d < 32; ++d) { S[d] *= dec; kvp += S[d] * ks[32 * dq + d]; }
    red[dq * 128 + e] = kvp;
    __syncthreads();
    const float kv = (red[e] + red[128 + e]) + (red[256 + e] + red[384 + e]);
    const float dl = (ve - kv) * beta;
    float op = 0.f;
#pragma unroll
    for (int d = 0; d < 32; ++d) { S[d] += ks[32 * dq + d] * dl; op += S[d] * qs[32 * dq + d]; }
    __syncthreads();
    red[dq * 128 + e] = op;
#pragma unroll
    for (int d = 0; d < 32; ++d) P.Sout[sbase + (size_t)d * 128] = S[d];
    __syncthreads();
    const float o = (red[e] + red[128 + e]) + (red[256 + e] + red[384 + e]);
    if (tid < 128) { const float s = wave_sum(o * o); if ((tid & 63) == 0) wsm[tid >> 6] = s; }
    __syncthreads();
    if (tid < 128) {
        const float ri = fast_rsq((wsm[0] + wsm[1]) * (1.0f / 128.0f) + EPS);
        const float z = P.projs[(size_t)b * INDIM + 8192 + hv * 128 + e];
        P.ogs[(size_t)b * VALD + hv * 128 + e] = f2bf(o * ri * P.gnorm[e] * silu_f(z));
    }
    __syncthreads();
}

__device__ __forceinline__ int t5_bucket(int d) {
    if (d < 16) return d;
    const int v = 16 + (int)(fast_log2((float)d * 0.0625f) * (16.0f / 3.0f));
    return v < 31 ? v : 31;
}
struct AttnArgs { const bf16_t* Q; const bf16_t* KB; const bf16_t* VT; bf16_t* AO; const float* sinks; };
__device__ __forceinline__ void attn_unit(const AttnArgs& P, const LAS float* bias2, int b, int h, int qb, int lane, int wave_id) {
    asm volatile("" : "+v"(lane));
    const int n32 = lane & 31, hi = lane >> 5, kvh = h >> 3, q0 = 32 * qb;
    const int kt0 = q0 >= 128 ? 0 : (128 - q0) >> 5;
    const float sink2 = P.sinks[h] * LOG2E;
    bf16x8 qf[4], kf[5][4];
    const bf16_t* qp = P.Q + (size_t)(b * SEQ + q0 + n32) * D + h * 64 + 8 * hi;
#pragma unroll
    for (int s = 0; s < 4; ++s) qf[s] = *(const bf16x8*)(qp + 16 * s);
#pragma unroll
    for (int kt = 0; kt < 5; ++kt) {
        const int j0 = q0 - 128 + 32 * kt, jc = j0 >= 0 ? j0 : 0;
        const bf16_t* kp = P.KB + (size_t)(b * SEQ + jc + n32) * 256 + kvh * 64 + 8 * hi;
#pragma unroll
        for (int s = 0; s < 4; ++s) kf[kt][s] = *(const bf16x8*)(kp + 16 * s);
    }
    SCHED_FENCE();
    f32x16 st[5];
#pragma unroll
    for (int kt = 0; kt < 5; ++kt) {
#pragma unroll
        for (int r = 0; r < 16; ++r) st[kt][r] = 0.f;
#pragma unroll
        for (int s = 0; s < 4; ++s) st[kt] = MFMA32(kf[kt][s], qf[s], st[kt]);
    }
    SCHED_FENCE();
    u32x2 vlo[5][2][2], vhi[5][2][2];
#pragma unroll
    for (int kt = 0; kt < 5; ++kt) {
        const int j0 = q0 - 128 + 32 * kt, jc = j0 >= 0 ? j0 : 0;
#pragma unroll
        for (int s2 = 0; s2 < 2; ++s2)
#pragma unroll
            for (int dh = 0; dh < 2; ++dh) {
                const bf16_t* vp = P.VT + ((size_t)(b * 4 + kvh) * 64 + 32 * dh + n32) * SEQ + jc + 16 * s2 + 4 * hi;
                vlo[kt][s2][dh] = *(const u32x2*)vp; vhi[kt][s2][dh] = *(const u32x2*)(vp + 8);
            }
    }
    SCHED_FENCE();
    float mx = sink2;
#pragma unroll
    for (int kt = 0; kt < 5; ++kt)
#pragma unroll
        for (int r = 0; r < 16; ++r) {
            const int dist = 128 - 32 * kt + n32 - crow32(r, hi);
            const bool valid = (kt >= kt0) && dist >= 0 && dist < 128;
            const float sc = valid ? st[kt][r] + bias2[h * 128 + (dist & 127)] : -INFINITY;
            st[kt][r] = sc; mx = fmaxf(mx, sc);
        }
    mx = fmaxf(mx, __shfl_xor(mx, 32));
    float l = 0.f;
#pragma unroll
    for (int kt = 0; kt < 5; ++kt)
#pragma unroll
        for (int r = 0; r < 16; ++r) { const float p = fast_exp2(st[kt][r] - mx); st[kt][r] = p; l += p; }
    l += __shfl_xor(l, 32);
    l += fast_exp2(sink2 - mx);
    const float linv = fast_rcp(l);
    f32x16 o[2];
#pragma unroll
    for (int r = 0; r < 16; ++r) { o[0][r] = 0.f; o[1][r] = 0.f; }
#pragma unroll
    for (int kt = 0; kt < 5; ++kt)
#pragma unroll
        for (int s2 = 0; s2 < 2; ++s2) {
            u32x4 w; w.x = pk2(st[kt][8 * s2 + 0], st[kt][8 * s2 + 1]); w.y = pk2(st[kt][8 * s2 + 2], st[kt][8 * s2 + 3]);
            w.z = pk2(st[kt][8 * s2 + 4], st[kt][8 * s2 + 5]); w.w = pk2(st[kt][8 * s2 + 6], st[kt][8 * s2 + 7]);
            const bf16x8 pa = __builtin_bit_cast(bf16x8, w);
#pragma unroll
            for (int dh = 0; dh < 2; ++dh) {
                u32x4 vw; vw.x = vlo[kt][s2][dh].x; vw.y = vlo[kt][s2][dh].y; vw.z = vhi[kt][s2][dh].x; vw.w = vhi[kt][s2][dh].y;
                o[dh] = MFMA32(pa, __builtin_bit_cast(bf16x8, vw), o[dh]);
            }
        }
    LAS float* ltab = (LAS float*)((LAS unsigned char*)bias2 + 16384) + (__builtin_amdgcn_readfirstlane(wave_id) * 32);
    if (hi == 0) ltab[n32] = linv;
    LDS_WAIT();
    f32x4 lv[4];
#pragma unroll
    for (int g = 0; g < 4; ++g) lv[g] = *(const LAS f32x4*)(ltab + 8 * g + 4 * hi);
    bf16_t* op = P.AO + (size_t)(b * SEQ + q0) * D + h * 64 + n32;
#pragma unroll
    for (int r = 0; r < 16; ++r) {
        const int m = crow32(r, hi);
        const float li = lv[r >> 2][r & 3];
        op[(size_t)m * D] = f2bf(o[0][r] * li); op[(size_t)m * D + 32] = f2bf(o[1][r] * li);
    }
    LDS_WAIT();
}

struct SAttnArgs { const float* qs; const float* kvs; const float* ck; const float* cv; const float* sinks; bf16_t* aos; };
__device__ __forceinline__ void sattn_unit(const SAttnArgs& P, const LAS float* bias2, int b, int h, int lane) {
    const int kvh = h >> 3;
    const float qd = P.qs[(size_t)b * D + h * 64 + lane];
    const float sink2 = P.sinks[h] * LOG2E;
    float sc[2];
#pragma unroll
    for (int hh = 0; hh < 2; ++hh) {
        const int c = lane + 64 * hh + 1;
        const float* kp = (c < 128) ? P.ck + ((size_t)(b * 128 + c) * 4 + kvh) * 64 : P.kvs + (size_t)b * 512 + kvh * 64;
        float s = 0.f;
#pragma unroll
        for (int d4 = 0; d4 < 16; ++d4) { const f32x4 kv = *(const f32x4*)(kp + 4 * d4);
#pragma unroll
            for (int x = 0; x < 4; ++x) s += __uint_as_float(__builtin_amdgcn_readlane(__float_as_uint(qd), 4 * d4 + x)) * kv[x]; }
        sc[hh] = s + bias2[h * 128 + (128 - c)];
    }
    float mx = fmaxf(sc[0], sc[1]);
#pragma unroll
    for (int o = 1; o < 64; o <<= 1) mx = fmaxf(mx, __shfl_xor(mx, o));
    mx = fmaxf(mx, sink2);
    const float p0 = fast_exp2(sc[0] - mx), p1 = fast_exp2(sc[1] - mx);
    const float l = wave_sum(p0 + p1) + fast_exp2(sink2 - mx);
    float acc = 0.f;
#pragma unroll 8
    for (int cc = 0; cc < 64; ++cc) {
        const float pa = __uint_as_float(__builtin_amdgcn_readlane(__float_as_uint(p0), cc));
        const float pb = __uint_as_float(__builtin_amdgcn_readlane(__float_as_uint(p1), cc));
        const int ca = cc + 1, cb = cc + 65;
        const float* va = P.cv + ((size_t)(b * 128 + ca) * 4 + kvh) * 64;
        const float* vb = (cb < 128) ? P.cv + ((size_t)(b * 128 + cb) * 4 + kvh) * 64 : P.kvs + (size_t)b * 512 + 256 + kvh * 64;
        acc += pa * va[lane] + pb * vb[lane];
    }
    P.aos[(size_t)b * D + h * 64 + lane] = f2bf(acc / l);
}
#define XB_TMO      128
#define XB_XCNT(j)  (256  + 64 * (j))
#define XB_XSUB(j)  (1280 + 64 * (j))
#define XB_XGEN(j)  (2304 + 64 * (j))
#define XB_TOP      3328
#define XB_TOPGEN   3392
#define XCD_BAR_WORDS 3456
#define XB_SPIN_CAP (1u << 18)

__device__ __forceinline__ unsigned xb_ld(unsigned* p)              { return __hip_atomic_load(p, __ATOMIC_RELAXED, __HIP_MEMORY_SCOPE_AGENT); }
__device__ __forceinline__ unsigned xb_add(unsigned* p, unsigned v) { return __hip_atomic_fetch_add(p, v, __ATOMIC_RELAXED, __HIP_MEMORY_SCOPE_AGENT); }
__device__ __forceinline__ unsigned xb_xcc_id() { return (unsigned)__builtin_amdgcn_s_getreg((3 << 11) | 20) & 0xFu; }
#define XB_SPIN(cond, bar) do { unsigned _sp = 0; while (cond) { __builtin_amdgcn_s_sleep(1); \
    if ((++_sp & 255u) == 0u) { if (xb_ld(&(bar)[XB_TMO])) break; if (_sp > XB_SPIN_CAP) { atomicAdd(&(bar)[XB_TMO], 1u); break; } } } } while (0)

struct XcdBarrier {
    unsigned* bar; unsigned x;
    volatile LAS unsigned* st;
};

__device__ __forceinline__ XcdBarrier xcd_barrier_post(unsigned* bar, volatile LAS unsigned* st) {
    XcdBarrier b; b.bar = bar; b.x = xb_xcc_id(); b.st = st;
    if (threadIdx.x == 0) (void)xb_add(&bar[XB_XCNT(b.x)], 1u);
    return b;
}
__device__ __forceinline__ void xcd_barrier_complete(unsigned* bar, unsigned x, unsigned& nloc, unsigned& nx) {
    const unsigned G = gridDim.x * gridDim.y * gridDim.z;
    unsigned sum, cnt, mine, sp = 0u;
    for (;;) {
        sum = 0u; cnt = 0u; mine = 0u;
#pragma unroll
        for (unsigned j = 0; j < 16; ++j) { const unsigned c = xb_ld(&bar[XB_XCNT(j)]); sum += c; cnt += (c > 0u) ? 1u : 0u; mine = (j == x) ? c : mine; }
        if (sum == G) break;
        __builtin_amdgcn_s_sleep(1);
        if ((++sp & 255u) == 0u) { if (xb_ld(&bar[XB_TMO])) break; if (sp > XB_SPIN_CAP) { atomicAdd(&bar[XB_TMO], 1u); break; } }
    }
    nloc = mine > 0u ? mine : 1u; nx = cnt > 0u ? cnt : 1u;
}

__device__ __forceinline__ void xcd_barrier(const XcdBarrier& b, int tid_) {
    asm volatile("s_waitcnt vmcnt(0)" ::: "memory");
    __syncthreads();
    if (tid_ == 0) {
        unsigned* bar = b.bar; unsigned bx = b.x;
        asm volatile("" : "+s"(bar), "+s"(bx));
        __builtin_amdgcn_s_waitcnt(0);
        unsigned nloc = b.st[0], nx = b.st[1];
        if (nloc == 0u) { xcd_barrier_complete(bar, bx, nloc, nx); b.st[0] = nloc; b.st[1] = nx; }
        const unsigned old = xb_add(&bar[XB_XSUB(bx)], 1u);
        const unsigned gen = old / nloc;
        if (old + 1u == (gen + 1u) * nloc) {
            __builtin_amdgcn_fence(__ATOMIC_RELEASE, "agent");
            asm volatile("s_waitcnt vmcnt(0)" ::: "memory");
            const unsigned og = xb_add(&bar[XB_TOP], 1u);
            const unsigned tg = og / nx;
            if (og + 1u == (tg + 1u) * nx) xb_add(&bar[XB_TOPGEN], 1u);
            else XB_SPIN(xb_ld(&bar[XB_TOPGEN]) == tg, bar);
            __builtin_amdgcn_fence(__ATOMIC_ACQUIRE, "agent");
            xb_add(&bar[XB_XGEN(bx)], 1u);
            asm volatile("s_waitcnt vmcnt(0)" ::: "memory");
        } else {
            XB_SPIN(xb_ld(&bar[XB_XGEN(bx)]) == gen, bar);
            __builtin_amdgcn_fence(__ATOMIC_ACQUIRE, "agent");
            asm volatile("s_waitcnt vmcnt(0)" ::: "memory");
        }
    }
    __syncthreads();
}

constexpr int CW_BARBASE = 131072, BAR_REGION_WORDS = 4096;
constexpr int PH_FINAL = 25, N_PHASES = 26;
#ifndef MK_EN
#define MK_EN 0xffff
#endif
#define EN(k) (((MK_EN) >> (k)) & 1)
struct Args { const float* in[23]; float* out; unsigned char* ws; int ph_lo, ph_hi, li, pad; };

constexpr size_t O_Y = 0, O_YS = 16777216, O_DP = 16842752, O_CP = 21037056, O_KP = 21233664, O_VP = 21364736, O_DS = 21495808, O_CS = 55050240, O_KS = 56623104, O_VS = 57671680;

__global__ void __launch_bounds__(NTHR, 2) mk_fwd(Args args) {
    extern __shared__ __attribute__((aligned(16))) unsigned char lds_raw[];
    LAS unsigned char* lds = (LAS unsigned char*)lds_raw;
    volatile LAS unsigned* MISC = (volatile LAS unsigned*)(lds + MISC_OFF);
    const int G = gridDim.x, bid = blockIdx.x;
    const int wid0 = __builtin_amdgcn_readfirstlane((int)threadIdx.x >> 6);
    if (threadIdx.x < 64) MISC[threadIdx.x] = 0u;
    __syncthreads();
    XcdBarrier bar = xcd_barrier_post((unsigned*)(args.ws + WS_CTL) + CW_BARBASE + args.li * BAR_REGION_WORDS, MISC + 8);
    const int lo = args.ph_lo, hi = args.ph_hi;
#define IN(k) (lo <= (k) && (k) < hi)
#define SEAM(knext) do { if (IN(knext)) { xcd_barrier(bar, tid); if (args.pad & 4096) xcd_barrier(bar, tid); } } while (0)
#define KARG(k) (kp[(k)])
#define PH_LOCALS \
    int tid; asm volatile("v_mbcnt_lo_u32_b32 %0, -1, 0\n\tv_mbcnt_hi_u32_b32 %0, -1, %0" : "=v"(tid)); tid += wid0 * 64;     \
    const int lane = tid & 63, wid = __builtin_amdgcn_readfirstlane(tid >> 6); \
    KP_T kp = (KP_T)__builtin_amdgcn_kernarg_segment_ptr(); asm volatile("" : "+s"(kp)); \
    unsigned char* ws = (unsigned char*)KARG(24); \
    float* out = (float*)KARG(23); \
    const int gw = bid * NWAVES + wid, NGW = G * NWAVES; \
    float* ssq = (float*)(ws + WS_SSQP); float* ssqs = (float*)(ws + WS_SSQSP); \
    LAS float* red = (LAS float*)lds; \
    (void)gw; (void)NGW; (void)lane; (void)out; (void)ssq; (void)ssqs; (void)red;
#define CV_SPLIT(lam) ((lam) == 1 ? 7900 : ((lam) == 2 ? 5100 : 5200))
#define RINVS ((LAS float*)(lds + 131072))
#define BUILD_RINVS(site_ptr) do { if (tid < 32) { const float* p_ = (site_ptr) + tid * 64; float s_ = 0.f; for (int i_ = 0; i_ < 64; ++i_) s_ += p_[i_]; RINVS[tid] = rinv_of(s_); } __syncthreads(); } while (0)
#define ssq_in (ssq + (size_t)(2 * L) * MP * 32)
#define ssqs_in (ssqs + (2 * L) * SB * 64)
#define ssq_mid (ssq + (size_t)(2 * L + 1) * MP * 32)
#define ssqs_mid (ssqs + (2 * L + 1) * SB * 64)
#define ssq_out (ssq + (size_t)(2 * L + 2) * MP * 32)
#define ssqs_out (ssqs + (2 * L + 2) * SB * 64)
#define x_prompt (KARG(0))
#define x_sample (KARG(1))
#define state_delta (KARG(2))
#define state_conv (KARG(3))
#define cache_k (KARG(4))
#define cache_v (KARG(5))
#define norm_mix (KARG(6))
#define norm_ffn (KARG(7))
#define w_in (KARG(8))
#define conv_w (KARG(9))
#define a_log (KARG(10))
#define dt_bias (KARG(11))
#define gnorm (KARG(12))
#define w_out (KARG(13))
#define norm_kv (KARG(14))
#define w_kv (KARG(15))
#define w_q (KARG(16))
#define w_o (KARG(17))
#define sinks (KARG(18))
#define rel_bias (KARG(19))
#define w_gu (KARG(20))
#define w_dn (KARG(21))
#define norm_final (KARG(22))
#define WIN_T ((bf16_t*)(ws + WS_WIN))
#define WBA_T ((bf16_t*)(ws + WS_WBA))
#define WOUT_T ((bf16_t*)(ws + WS_WOUT))
#define WGU_T ((bf16_t*)(ws + WS_WGU))
#define WDN_T ((bf16_t*)(ws + WS_WDN))
#define WQKV_T ((bf16_t*)(ws + WS_WQKV))
#define WQ1_T ((bf16_t*)(ws + WS_WQ1))
#define WO_T ((bf16_t*)(ws + WS_WO))
#define X ((float*)(ws + WS_X))
#define XB ((bf16_t*)(ws + WS_XB))
#define PROJ ((bf16_t*)(ws + WS_PROJ))
#define BETA ((float*)(ws + WS_BETA))
#define GG ((float*)(ws + WS_G))
#define OG ((bf16_t*)(ws + WS_OG))
#define MID ((bf16_t*)(ws + WS_MID))
#define QB ((bf16_t*)(ws + WS_Q))
#define KB ((bf16_t*)(ws + WS_K))
#define VT ((bf16_t*)(ws + WS_VT))
#define AO ((bf16_t*)(ws + WS_AO))
#define XS ((float*)(ws + WS_SMP + SM_XS))
#define XSB ((bf16_t*)(ws + WS_SMP + SM_XSB))
#define PROJS ((float*)(ws + WS_SMP + SM_PROJS))
#define QKVS ((float*)(ws + WS_SMP + SM_QKVS))
#define BETAS ((float*)(ws + WS_SMP + SM_BETAS))
#define GS ((float*)(ws + WS_SMP + SM_GS))
#define OGS ((bf16_t*)(ws + WS_SMP + SM_OGS))
#define MIDS ((bf16_t*)(ws + WS_SMP + SM_MIDS))
#define QS ((float*)(ws + WS_SMP + SM_QS))
#define KVS ((float*)(ws + WS_SMP + SM_KVS))
#define AOS ((bf16_t*)(ws + WS_SMP + SM_AOS))

    if (EN(0) && IN(0)) {
        PH_LOCALS
        LAS float* scr = (LAS float*)(lds + wid * 16640);
        convert_range(kp, ws, 0, 0, CV_IN + CV_BA, gw, NGW, scr, lane);
        for (int m = gw; m < MP + SB; m += NGW) {
            if (m < MP) row_to_bf16(x_prompt + (size_t)m * D, XB + (size_t)m * D, ssq + (size_t)m * 32, 32, lane);
            else row_to_bf16(x_sample + (size_t)(m - MP) * D, XSB + (size_t)(m - MP) * D, ssqs + (size_t)(m - MP) * 64, 64, lane);
        }
        for (int i = bid * NTHR + tid; i < 2 * SB * 127 * 64; i += G * NTHR) {
            const int which = i / (SB * 127 * 64), r = i % (SB * 127 * 64), b = r / (127 * 64), o = r % (127 * 64);
            const f32x4 v = *(const f32x4*)((which ? cache_v : cache_k) + (size_t)b * 128 * 256 + 256 + 4 * o);
            *(f32x4*)(out + (which ? O_VS : O_KS) + (size_t)b * 128 * 256 + 4 * o) = v;
        }
        SEAM(1);
    }

#pragma unroll 1
    for (int L = 0; L < 4; ++L) {
        const int pb = 1 + 6 * L; const bool isA = L < 2; const int j = L - 2;
        int lo = args.ph_lo, hi = args.ph_hi; asm volatile("" : "+s"(lo), "+s"(hi));
        if (IN(pb)) {
            PH_LOCALS
            if (EN(1) && isA) {
                const bf16_t* Wt = WIN_T + (size_t)L * INW * D; const bf16_t* Wba = WBA_T + (size_t)L * 64 * D;
                { pg8::Gemm g{XB, Wt, MP, INW, D}; pg8::StaticOrder S; S.init(MP, INW, G, bid);
                  pg8::EpiProj E{PROJ, INW, ssq_in, 32};
                  pg8::gemm_phase<pg8::EpiProj, pg8::StaticOrder, true, true>(lds, g, S, E, tid); }
                const float* al = a_log + L * 32; const float* dtb = dt_bias + L * 32;
                BUILD_RINVS(ssqs_in);
                for (int su = bid; su < 384 + 1 + 256; su += G) {
                    if (su < 384) {
                        skinny_unit<false>(XSB, D, Wt + (size_t)su * 32 * D, nullptr, D, D, red, wid, lane, tid,
                            [&](int m, int n, float v0, float) { PROJS[(size_t)m * INDIM + su * 32 + n] = v0 * RINVS[m]; });
                    } else if (su == 384) {
                        skinny_unit<true>(XSB, D, Wba, Wba + 32 * D, D, D, red, wid, lane, tid,
                            [&](int m, int n, float v0, float v1) { const float ri = RINVS[m]; PROJS[(size_t)m * INDIM + INW + n] = v0 * ri; PROJS[(size_t)m * INDIM + INW + 32 + n] = v1 * ri; });
                    } else {
                        const int u = su - 385;
                        skinny_unit<true>(XB + (size_t)u * 32 * D, D, Wba, Wba + 32 * D, D, D, red, wid, lane, tid,
                            [&](int m, int n, float v0, float v1) { const int row = 32 * u + m; const float ri = rinv_row_full(ssq_in, row);
                                const float braw = v0 * ri, xx = v1 * ri + dtb[n];
                                BETA[(size_t)row * 32 + n] = sigmoid_f(braw); GG[(size_t)row * 32 + n] = -fast_exp(al[n]) * softplus_f(xx); });
                    }
                }
            } else if (EN(2) && !isA) {
                const bf16_t* Wt = j == 0 ? WQKV_T : WQ1_T; const int N = j == 0 ? 2560 : 2048;
                { pg8::Gemm g{XB, Wt, MP, N, D}; pg8::StaticOrder S; S.init(MP, N, G, bid);
                  pg8::EpiQKVT<false> E{QB, KB, VT, out + O_KP, out + O_VP, ssq_in};
                  pg8::gemm_phase<pg8::EpiQKVT<false>, pg8::StaticOrder, true, true>(lds, g, S, E, tid); }
                BUILD_RINVS(ssqs_in);
                for (int su = bid; su < N / 32; su += G) {
                    skinny_unit<false>(XSB, D, Wt + (size_t)su * 32 * D, nullptr, D, D, red, wid, lane, tid,
                        [&](int m, int n, float v0, float) { const float v = v0 * RINVS[m]; const int c = su * 32 + n;
                            if (c < 2048) QS[(size_t)m * D + c] = v;
                            else { KVS[(size_t)m * 512 + (c - 2048)] = v;
                                   if (c < 2304) out[O_KS + ((size_t)m * 128 + 127) * 256 + (c - 2048)] = v; else out[O_VS + ((size_t)m * 128 + 127) * 256 + (c - 2304)] = v; } });
                }
                if (j == 0) {
                    const int nwg_ = (MP / 256) * (N / 256), rounds = (nwg_ + G - 1) / G, nidle = rounds * G - nwg_;
                    if (nidle > 0 && bid >= G - nidle) {
                        __syncthreads();
                        convert_range(kp, ws, 2, CV_KV + CV_Q, CV_B0 - (CV_KV + CV_Q), (bid - (G - nidle)) * NWAVES + wid, nidle * NWAVES, (LAS float*)(lds + wid * 16640), lane);
                    }
                }
            }
            SEAM(isA ? pb + 1 : pb + 2);
        }
        if (EN(3) && isA && IN(pb + 1)) {
            PH_LOCALS
            PrepArgs P{PROJ, BETA, GG, conv_w + (size_t)L * 4 * CONVD, ws + WS_PREPA, ws + WS_PREPU, (float*)(ws + WS_EGL), out + O_CP + (size_t)L * BATCH * 3 * CONVD, args.pad};
            for (int u = bid; u < BATCH * 16 * NCH; u += G) { const int n = u & 31, kh = (u >> 5) & 15, b = u >> 9; prep_unit(P, lds, b, kh, n, tid, wid, lane); }
            SConvArgs SP{PROJS, state_conv + (size_t)L * SB * 3 * CONVD, conv_w + (size_t)L * 4 * CONVD, a_log + L * 32, dt_bias + L * 32, QKVS, BETAS, GS, out + O_CS + (size_t)L * SB * 3 * CONVD};
            for (int it = gw; it < SB * 64; it += NGW) sconv_item(SP, it >> 6, it & 63, lane);
            SEAM(pb + 2);
        }
        if (IN(pb + 2)) {
            PH_LOCALS
            if (EN(4) && isA) {
                ScanArgs P{ws + WS_PREPA, ws + WS_PREPU, (const float*)(ws + WS_EGL), PROJ, gnorm + L * 128, (args.pad & 4) ? MID : OG, (args.pad & 4) ? (float*)QB : out + O_DP + (size_t)L * BATCH * 32 * 128 * 128, args.pad};
                if (!(args.pad & 1)) for (int u = bid; u < BATCH * 32; u += G) scan_unit(P, lds, u >> 5, u & 31, tid, wid, lane);
                SRecArgs R{QKVS, BETAS, GS, PROJS, gnorm + L * 128, state_delta + (size_t)L * SB * 32 * 128 * 128, out + O_DS + (size_t)L * SB * 32 * 128 * 128, OGS};
                const int base = G > 128 ? 128 : 0, nb = G > 128 ? G - 128 : G;
                if (!(args.pad & 2) && bid >= base) for (int su = bid - base; su < SB * 32; su += nb) srec_unit(R, lds, su >> 5, su & 31, tid);
                if (G > 128 && bid >= 128) {
                    __syncthreads();
                    convert_range(kp, ws, L, CV_IN + CV_BA, CV_A - (CV_IN + CV_BA), (bid - 128) * NWAVES + wid, (G - 128) * NWAVES, (LAS float*)(lds + wid * 16640), lane);
                }
            } else if (EN(5) && !isA) {
                LAS float* bias2 = (LAS float*)lds;
                for (int i = tid; i < 32 * 128; i += NTHR) { const int h = i >> 7, dist = i & 127; bias2[i] = rel_bias[t5_bucket(dist) * 32 + h] * LOG2E; }
                __syncthreads();
                AttnArgs P{QB, KB, VT, AO, sinks + j * 32};
                if (!(args.pad & 64)) for (int u = gw; u < BATCH * 32 * 64; u += NGW) { const int g8 = u & 7, qb = (u >> 3) & 63, kvh = (u >> 9) & 3, b = u >> 11; attn_unit(P, bias2, b, kvh * 8 + g8, qb, lane, wid); }
                SAttnArgs SP{QS, KVS, cache_k, cache_v, sinks + j * 32, AOS};
                if (!(args.pad & 32)) for (int u = gw; u < SB * 32; u += NGW) sattn_unit(SP, bias2, u >> 5, u & 31, lane);
                __syncthreads();
            }
            SEAM(pb + 3);
        }
        if (EN(6) && IN(pb + 3)) {
            PH_LOCALS
            const bf16_t* A = isA ? OG : AO; const int K = isA ? VALD : D;
            const bf16_t* Wt = isA ? WOUT_T + (size_t)L * D * VALD : WO_T + (size_t)j * D * D;
            const float* base = L == 0 ? x_prompt : nullptr; const float* bases = L == 0 ? x_sample : XS;
            { pg8::Gemm g{A, Wt, MP, D, K}; pg8::StaticOrder S; S.init(MP, D, G, bid);
              pg8::EpiRes E{base, XB, ssq_mid};
              pg8::gemm_phase<pg8::EpiRes, pg8::StaticOrder, true, true>(lds, g, S, E, tid); }
            const bf16_t* As = isA ? OGS : AOS;
            for (int su = bid; su < 64; su += G) {
                skinny_unit<false>(As, K, Wt + (size_t)su * 32 * K, nullptr, K, K, red, wid, lane, tid,
                    [&](int m, int n, float v0, float) { const size_t o = (size_t)m * D + su * 32 + n; const float v = bases[o] + v0; XS[o] = v; XSB[o] = f2bf(v);
                        float s = v * v; s += __shfl_xor(s, 1); s += __shfl_xor(s, 2); s += __shfl_xor(s, 4); s += __shfl_xor(s, 8); s += __shfl_xor(s, 16);
                        if (n == 0) ssqs_mid[m * 64 + su] = s; });
            }
            SEAM(pb + 4);
        }
        if (EN(7) && IN(pb + 4)) {
            PH_LOCALS
            const bf16_t* Wt = WGU_T + (size_t)L * GU * D;
            { pg8::Gemm g{XB, Wt, MP, GU, D}; pg8::StaticOrder S; S.init(MP, GU, G, bid);
              pg8::EpiSwigluT<false> E{MID, ssq_mid};
              pg8::gemm_phase<pg8::EpiSwigluT<false>, pg8::StaticOrder, true, true>(lds, g, S, E, tid); }
            BUILD_RINVS(ssqs_mid);
            for (int su = bid; su < FF / 32; su += G) {
                const int t = su >> 2, s4 = su & 3;
                skinny_unit<true>(XSB, D, Wt + (size_t)(256 * t + 32 * s4) * D, Wt + (size_t)(256 * t + 128 + 32 * s4) * D, D, D, red, wid, lane, tid,
                    [&](int m, int n, float v0, float v1) { const float ri = RINVS[m]; const float gt = v0 * ri, up = v1 * ri;
                        MIDS[(size_t)m * FF + su * 32 + n] = f2bf(silu_f(gt) * up); });
            }
            if (L < 3) {
                const int nwg_ = (MP / 256) * (GU / 256), rounds = (nwg_ + G - 1) / G, nidle = rounds * G - nwg_;
                if (nidle > 0 && bid >= G - nidle) {
                    __syncthreads();
                    const int cnt = L == 0 ? CV_IN + CV_BA : (L == 1 ? CV_KV + CV_Q : CV_B1);
                    convert_range(kp, ws, L + 1, 0, cnt, (bid - (G - nidle)) * NWAVES + wid, nidle * NWAVES, (LAS float*)(lds + wid * 16640), lane);
                }
            }
            SEAM(pb + 5);
        }
        if (EN(8) && IN(pb + 5)) {
            PH_LOCALS
            const bf16_t* Wt = WDN_T + (size_t)L * D * FF;
            { pg8::Gemm g{MID, Wt, MP, D, FF}; pg8::StaticOrder S; S.init(MP, D, G, bid);
              pg8::EpiRes E{nullptr, XB, ssq_out};
              pg8::gemm_phase<pg8::EpiRes, pg8::StaticOrder, true, true>(lds, g, S, E, tid); }
            for (int su = bid; su < 64; su += G) {
                skinny_unit<false>(MIDS, FF, Wt + (size_t)su * 32 * FF, nullptr, FF, FF, red, wid, lane, tid,
                    [&](int m, int n, float v0, float) { const size_t o = (size_t)m * D + su * 32 + n; const float v = XS[o] + v0; XS[o] = v; XSB[o] = f2bf(v);
                        float s = v * v; s += __shfl_xor(s, 1); s += __shfl_xor(s, 2); s += __shfl_xor(s, 4); s += __shfl_xor(s, 8); s += __shfl_xor(s, 16);
                        if (n == 0) ssqs_out[m * 64 + su] = s; });
            }
            SEAM(L == 3 ? PH_FINAL : pb + 6);
        }
    }
    if (EN(9) && IN(PH_FINAL)) {
        PH_LOCALS
        const float* sq = ssq + (size_t)8 * MP * 32; const float* sqs = ssqs + 8 * SB * 64;
        for (int m = gw; m < MP + SB; m += NGW) {
            const bool sp = m >= MP; const int r = sp ? m - MP : m;
            const float ri = rinv_of(wave_sum(sp ? sqs[r * 64 + lane] : (lane < 32 ? sq[(size_t)r * 32 + lane] : 0.f)));
            f32x4* yr = (f32x4*)(out + (sp ? O_YS : O_Y) + (size_t)r * D) + lane; const f32x4* gr = (const f32x4*)norm_final + lane;
            if (sp) { const f32x4* xr = (const f32x4*)(XS + (size_t)r * D) + lane;
#pragma unroll
                for (int q = 0; q < 8; ++q) yr[64 * q] = xr[64 * q] * ri * gr[64 * q];
            } else { const u32x2* xr = (const u32x2*)(XB + (size_t)r * D) + lane;
#pragma unroll
                for (int q = 0; q < 8; ++q) { const u32x2 w = xr[64 * q];
                    const f32x4 xv = (f32x4){__uint_as_float(w.x << 16), __uint_as_float(w.x & 0xffff0000u), __uint_as_float(w.y << 16), __uint_as_float(w.y & 0xffff0000u)};
                    yr[64 * q] = xv * ri * gr[64 * q]; }
            }
        }
    }
#undef IN
#undef SEAM
}
#undef RINVS
#undef CV_SPLIT
#undef BUILD_RINVS
#undef x_prompt
#undef x_sample
#undef state_delta
#undef state_conv
#undef cache_k
#undef cache_v
#undef norm_mix
#undef norm_ffn
#undef w_in
#undef conv_w
#undef a_log
#undef dt_bias
#undef gnorm
#undef w_out
#undef norm_kv
#undef w_kv
#undef w_q
#undef w_o
#undef sinks
#undef rel_bias
#undef w_gu
#undef w_dn
#undef norm_final
#undef WIN_T
#undef WBA_T
#undef WOUT_T
#undef WGU_T
#undef WDN_T
#undef WQKV_T
#undef WQ1_T
#undef WO_T
#undef X
#undef XB
#undef PROJ
#undef BETA
#undef GG
#undef OG
#undef MID
#undef QB
#undef KB
#undef VT
#undef AO
#undef XS
#undef XSB
#undef PROJS
#undef QKVS
#undef BETAS
#undef GS
#undef OGS
#undef MIDS
#undef QS
#undef KVS
#undef AOS
#undef ssq_in
#undef ssqs_in
#undef ssq_mid
#undef ssqs_mid
#undef ssq_out
#undef ssqs_out
#undef PH_LOCALS
#undef KARG

#ifndef MK_PER_PHASE
#define MK_PER_PHASE 0
#endif
static int mk_grid = 0;
static bool mk_setup(int n_in, size_t ws_size) {
    if (mk_grid == 0) {
        if (n_in != 23 || ws_size < WS_END) { fprintf(stderr, "kernel_launch: unexpected inputs (%d) or workspace (%zu < %zu)\n", n_in, ws_size, (size_t)WS_END); mk_grid = -1; return false; }
        int dev = 0, cus = 0, per_cu = 0;
        if (hipGetDevice(&dev) != hipSuccess || hipDeviceGetAttribute(&cus, hipDeviceAttributeMultiprocessorCount, dev) != hipSuccess) { mk_grid = -1; return false; }
        if (hipFuncSetAttribute((const void*)mk_fwd, hipFuncAttributeMaxDynamicSharedMemorySize, LDS_BYTES) != hipSuccess) { fprintf(stderr, "kernel_launch: hipFuncSetAttribute failed\n"); mk_grid = -1; return false; }
        if (hipOccupancyMaxActiveBlocksPerMultiprocessor(&per_cu, (const void*)mk_fwd, NTHR, LDS_BYTES) != hipSuccess || per_cu < 1) { fprintf(stderr, "kernel_launch: occupancy query says %d\n", per_cu); }
        (void)hipGetLastError();
        mk_grid = cus;
    }
    return mk_grid > 0;
}
static void mk_run(void* const* d_in, void* d_out, void* d_ws, hipStream_t stream, int p_lo, int p_hi, bool per_phase, int flags = 0) {
    (void)hipMemsetAsync((char*)d_ws + WS_CTL, 0, CTL_ZERO_BYTES, stream);
    Args a{};
    for (int i = 0; i < 23; ++i) a.in[i] = (const float*)d_in[i];
    a.out = (float*)d_out; a.ws = (unsigned char*)d_ws; a.pad = flags;
    if (per_phase) {
        int li = 0;
        for (int p = p_lo; p < p_hi; ++p) {
            if (p >= 14 && p <= 24 && ((p - 1) % 6) == 1) continue;
            a.ph_lo = p; a.ph_hi = p + 1; a.li = li++;
            hipLaunchKernelGGL(mk_fwd, dim3(mk_grid), dim3(NTHR), LDS_BYTES, stream, a);
        }
    } else {
        a.ph_lo = p_lo; a.ph_hi = p_hi; a.li = 0;
        hipLaunchKernelGGL(mk_fwd, dim3(mk_grid), dim3(NTHR), LDS_BYTES, stream, a);
    }
}
#ifndef MK_NO_ENTRY
extern "C" void kernel_launch(void* const* d_in, const int* in_sizes, int n_in, void* d_out, int out_size, void* d_ws, size_t ws_size, hipStream_t stream) {
    if (!mk_setup(n_in, ws_size)) return;
    mk_run(d_in, d_out, d_ws, stream, 0, N_PHASES, MK_PER_PHASE != 0);
}
#endif
```
